# Optimizing an MI355X kernel written in HIP

```python
import jax, jax.numpy as jnp
from jax import lax
import numpy as np

D_MODEL = 1024
BATCH = 8
SEQ = 2048
DEPTH = 4

N_META = 16
GRID_W = 64
CHUNK = 64
META_PAD = CHUNK - N_META

M_HEADS = 4
M_WIDTH = D_MODEL // 2
M_HEAD_DIM = M_WIDTH // M_HEADS
M_CONV = 5
R_HEADS = 4
R_WIDTH = D_MODEL // 2
R_HEAD_DIM = R_WIDTH // R_HEADS
ROPE_BASE = 10000.0
EVEN_IN = 4 * M_WIDTH + 4 * M_HEADS + 4 * R_WIDTH
EVEN_MIX = M_WIDTH + R_WIDTH

NA_HEAD_DIM = 64
NA_HEADS = D_MODEL // NA_HEAD_DIM
NA_WIDTH = NA_HEADS * NA_HEAD_DIM
NA_WIN_ROWS = 8
NA_WIN_COLS = 16
ODD_IN = 3 * NA_WIDTH

N_EXPERTS = 16
EC_CAPACITY_FACTOR = 2
EXPERT_FF = D_MODEL

N_EVEN = (DEPTH + 1) // 2
N_ODD = DEPTH // 2
EPS = 1e-6

kernel_name = 'hybrid_mlstm_retention_natten_ecmoe_encoder'


def rms_norm(x, g):
    xf = x.astype(jnp.float32)
    y = xf * lax.rsqrt(jnp.mean(xf * xf, axis=-1, keepdims=True) + EPS)
    return (y * g.astype(jnp.float32)).astype(x.dtype)


def centred_depthwise_conv(x, w):
    k = w.shape[0]
    return lax.conv_general_dilated(
        x, w[:, None, :].astype(x.dtype), window_strides=(1,),
        padding=[((k - 1) // 2, k // 2)], dimension_numbers=('NWC', 'WIO', 'NWC'),
        feature_group_count=x.shape[-1])


def rotary(x, pos):
    half = x.shape[-1] // 2
    inv = ROPE_BASE ** (-jnp.arange(half, dtype=jnp.float32) / half)
    ang = pos.astype(jnp.float32)[:, None] * inv[None, :]
    cos, sin = jnp.cos(ang)[:, None, :], jnp.sin(ang)[:, None, :]
    x1, x2 = x[..., :half], x[..., half:]
    return jnp.concatenate([x1 * cos - x2 * sin, x2 * cos + x1 * sin], axis=-1)


def to_scan_order(x, reverse):
    meta, real = x[:, :N_META], x[:, N_META:]
    if reverse:
        real = jnp.flip(real, axis=1)
    pad = jnp.zeros((x.shape[0], META_PAD) + x.shape[2:], x.dtype)
    return jnp.concatenate([pad, meta, real], axis=1)


def from_scan_order(y, reverse):
    meta, real = y[:, META_PAD:CHUNK], y[:, CHUNK:]
    if reverse:
        real = jnp.flip(real, axis=1)
    return jnp.concatenate([meta, real], axis=1)


def to_chunks(x):
    b, lp = x.shape[:2]
    x = x.reshape((b, lp // CHUNK, CHUNK) + x.shape[2:])
    return jnp.moveaxis(x, (1, 3), (0, 2))


def from_chunks(y):
    y = jnp.moveaxis(y, (0, 2), (1, 3))
    return y.reshape((y.shape[0], y.shape[1] * y.shape[2]) + y.shape[3:])


def mlstm_scan(q, k, v, log_i, log_f):
    bsz, _, nh, dh = q.shape
    causal = jnp.tril(jnp.ones((CHUNK, CHUNK), bool))

    def step(carry, inp):
        c_st, n_st, m_prev = carry
        qt, kt, vt, it, ft = inp
        b = jnp.cumsum(ft, axis=-1)
        a = it - b
        m = b + jnp.maximum(m_prev[..., None], lax.cummax(a, axis=2))
        log_d = b[..., :, None] + a[..., None, :] - m[..., :, None]
        dmat = jnp.exp(jnp.where(causal, log_d, -jnp.inf))
        w_inter = jnp.exp(b + m_prev[..., None] - m)
        s = jnp.einsum('bhqd,bhkd->bhqk', qt, kt) * dmat
        num = (w_inter[..., None] * jnp.einsum('bhqd,bhde->bhqe', qt, c_st)
               + jnp.einsum('bhqk,bhke->bhqe', s, vt))
        den = w_inter * jnp.einsum('bhqd,bhd->bhq', qt, n_st) + s.sum(-1)
        out = num / jnp.maximum(jnp.abs(den), jnp.exp(-m))[..., None]
        m_new = m[..., -1]
        w_state = jnp.exp(b[..., -1] + m_prev - m_new)
        kw = kt * jnp.exp(b[..., -1:] + a - m_new[..., None])[..., None]
        c_new = w_state[..., None, None] * c_st + jnp.einsum('bhkd,bhke->bhde', kw, vt)
        n_new = w_state[..., None] * n_st + kw.sum(2)
        return (c_new, n_new, m_new), out

    init = (jnp.zeros((bsz, nh, dh, dh), jnp.float32), jnp.zeros((bsz, nh, dh), jnp.float32),
            jnp.zeros((bsz, nh), jnp.float32))
    _, ys = lax.scan(step, init, (to_chunks(q), to_chunks(k), to_chunks(v),
                                  to_chunks(log_i), to_chunks(log_f)))
    return from_chunks(ys)


def retention_scan(q, k, v, log_gamma):
    bsz, _, nh, dh = q.shape
    pos = jnp.arange(CHUNK, dtype=jnp.float32)
    causal = jnp.tril(jnp.ones((CHUNK, CHUNK), bool))
    rel = (pos[:, None] - pos[None, :])[None] * log_gamma[:, None, None]
    decay_intra = jnp.exp(jnp.where(causal[None], rel, -jnp.inf))
    decay_q = jnp.exp((pos + 1.0)[None, :] * log_gamma[:, None])
    decay_k = jnp.exp((CHUNK - 1.0 - pos)[None, :] * log_gamma[:, None])
    decay_chunk = jnp.exp(CHUNK * log_gamma)

    def step(r_st, inp):
        qt, kt, vt = inp
        s = jnp.einsum('bhqd,bhkd->bhqk', qt, kt) * decay_intra
        out = (jnp.einsum('bhqk,bhke->bhqe', s, vt)
               + decay_q[..., None] * jnp.einsum('bhqd,bhde->bhqe', qt, r_st))
        r_new = (decay_chunk[:, None, None] * r_st
                 + jnp.einsum('bhkd,bhke->bhde', kt * decay_k[..., None], vt))
        return r_new, out

    _, ys = lax.scan(step, jnp.zeros((bsz, nh, dh, dh), jnp.float32),
                     (to_chunks(q), to_chunks(k), to_chunks(v)))
    return from_chunks(ys)


def even_mixer(u, w_in, conv_w, gate_b, m_norm_g, ret_decay_logit, r_norm_g, w_out):
    f32 = jnp.float32
    bsz, seq_len, _ = u.shape
    sizes = [M_WIDTH] * 4 + [4 * M_HEADS] + [R_WIDTH] * 4
    cuts = np.cumsum(sizes)[:-1].tolist()
    mq, mk, mv, mo, gates, rq, rk, rv, rg = jnp.split(u @ w_in, cuts, axis=-1)

    def heads(t, nh):
        return t.reshape(bsz, seq_len, nh, -1).astype(f32)

    qk = jax.nn.silu(centred_depthwise_conv(jnp.concatenate([mq, mk], axis=-1), conv_w))
    mq, mk = jnp.split(qk, 2, axis=-1)
    q, k, v = heads(mq, M_HEADS), heads(mk, M_HEADS) * M_HEAD_DIM ** -0.5, heads(mv, M_HEADS)
    g = gates.astype(f32) + gate_b.astype(f32)
    i_fw, f_fw, i_bw, f_bw = jnp.split(g, 4, axis=-1)
    h_m = jnp.zeros_like(v)
    for reverse, ig, fg in ((False, i_fw, f_fw), (True, i_bw, f_bw)):
        o = mlstm_scan(to_scan_order(q, reverse), to_scan_order(k, reverse),
                       to_scan_order(v, reverse), to_scan_order(ig, reverse),
                       to_scan_order(jax.nn.log_sigmoid(fg), reverse))
        h_m = h_m + from_scan_order(o, reverse)
    m_out = (jax.nn.sigmoid(mo.astype(f32))
             * rms_norm(h_m, m_norm_g.reshape(M_HEADS, M_HEAD_DIM)).reshape(bsz, seq_len, M_WIDTH))

    pos = jnp.arange(seq_len)
    rq_h = rotary(heads(rq, R_HEADS), pos)
    rk_h = rotary(heads(rk, R_HEADS), pos) * R_HEAD_DIM ** -0.5
    rv_h = heads(rv, R_HEADS)
    log_gamma = jax.nn.log_sigmoid(ret_decay_logit.astype(f32))
    h_r = jnp.zeros_like(rv_h)
    for d_idx, reverse in ((0, False), (1, True)):
        o = retention_scan(to_scan_order(rq_h, reverse), to_scan_order(rk_h, reverse),
                           to_scan_order(rv_h, reverse), log_gamma[d_idx])
        h_r = h_r + from_scan_order(o, reverse)
    r_out = (jax.nn.silu(rg.astype(f32))
             * rms_norm(h_r, r_norm_g.reshape(R_HEADS, R_HEAD_DIM)).reshape(bsz, seq_len, R_WIDTH))

    mix = jnp.concatenate([m_out, r_out], axis=-1).astype(u.dtype)
    return mix @ w_out


def odd_mixer(u, w_in, q_norm_g, k_norm_g, rpb, w_out):
    f32 = jnp.float32
    bsz, seq_len, _ = u.shape
    n_tok = seq_len - N_META
    rows = n_tok // GRID_W
    wr = min(NA_WIN_ROWS, rows)
    z = (u @ w_in).reshape(bsz, seq_len, 3, NA_HEADS, NA_HEAD_DIM)
    q = rms_norm(z[:, :, 0], q_norm_g) * NA_HEAD_DIM ** -0.5
    k = rms_norm(z[:, :, 1], k_norm_g)
    v = z[:, :, 2]
    qm, km, vm = q[:, :N_META], k[:, :N_META], v[:, :N_META]
    grid = (bsz, rows, GRID_W, NA_HEADS, NA_HEAD_DIM)
    qg, kg, vg = (t[:, N_META:].reshape(grid) for t in (q, k, v))

    col = jnp.arange(GRID_W)
    col_start = jnp.clip(col - NA_WIN_COLS // 2, 0, GRID_W - NA_WIN_COLS)
    col_in = (col[None, :] >= col_start[:, None]) & (col[None, :] < col_start[:, None] + NA_WIN_COLS)
    dc_idx = jnp.clip(col[None, :] - col[:, None], -(NA_WIN_COLS - 1), NA_WIN_COLS - 1) + NA_WIN_COLS - 1
    rpb_cols = rpb.astype(f32)[:, :, dc_idx]

    p_meta = jax.nn.softmax(jnp.einsum('bqhd,bkhd->bhqk', qm, km).astype(f32), axis=-1)
    out_meta = jnp.einsum('bhqk,bkhd->bqhd', p_meta.astype(v.dtype), vm)

    def row_block(r):
        rs = jnp.clip(r - wr // 2, 0, rows - wr)
        q_row = lax.dynamic_index_in_dim(qg, r, axis=1, keepdims=False)
        k_band = lax.dynamic_slice_in_dim(kg, rs, wr, axis=1)
        v_band = lax.dynamic_slice_in_dim(vg, rs, wr, axis=1)
        s_band = jnp.einsum('bqhd,brkhd->bhqrk', q_row, k_band).astype(f32)
        dr_idx = rs + jnp.arange(wr) - r + NA_WIN_ROWS - 1
        bias = jnp.transpose(jnp.take(rpb_cols, dr_idx, axis=1), (0, 2, 1, 3))
        s_band = jnp.where(col_in[:, None, :], s_band + bias, -jnp.inf)
        s_band = s_band.reshape(bsz, NA_HEADS, GRID_W, wr * GRID_W)
        s_meta = jnp.einsum('bqhd,bkhd->bhqk', q_row, km).astype(f32)
        p = jax.nn.softmax(jnp.concatenate([s_meta, s_band], axis=-1), axis=-1).astype(v.dtype)
        v_flat = v_band.reshape(bsz, wr * GRID_W, NA_HEADS, NA_HEAD_DIM)
        return (jnp.einsum('bhqk,bkhd->bqhd', p[..., :N_META], vm)
                + jnp.einsum('bhqk,bkhd->bqhd', p[..., N_META:], v_flat))

    out_rows = lax.map(row_block, jnp.arange(rows))
    out_real = jnp.moveaxis(out_rows, 0, 1).reshape(bsz, n_tok, NA_WIDTH)
    out = jnp.concatenate([out_meta.reshape(bsz, N_META, NA_WIDTH), out_real], axis=1)
    return out @ w_out


def expert_choice_ffn(u, w_router, w_gate, w_up, w_down):
    bsz, seq_len, _ = u.shape
    cap = EC_CAPACITY_FACTOR * seq_len // N_EXPERTS
    aff = jax.nn.softmax((u @ w_router).astype(jnp.float32), axis=-1)
    gate, idx = lax.top_k(jnp.swapaxes(aff, 1, 2), cap)
    bidx = jnp.arange(bsz)[:, None, None]
    xs = u[bidx, idx]
    hdn = jax.nn.silu(jnp.einsum('becd,edf->becf', xs, w_gate)) * jnp.einsum('becd,edf->becf', xs, w_up)
    ys = jnp.einsum('becf,efd->becd', hdn, w_down) * gate[..., None].astype(u.dtype)
    return jnp.zeros_like(u).at[bidx, idx].add(ys)


def setup_inputs(seed: int = 0) -> dict:
    key = jax.random.key(seed)
    ks = iter(jax.random.split(key, 32))
    n = lambda shape: jax.random.normal(next(ks), shape, jnp.float32)
    fb = jnp.linspace(3.0, 6.0, M_HEADS)
    gate_b = jnp.concatenate([0.1 * n((N_EVEN, M_HEADS)), fb + 0.1 * n((N_EVEN, M_HEADS)),
                              0.1 * n((N_EVEN, M_HEADS)), fb + 0.1 * n((N_EVEN, M_HEADS))], axis=-1)
    base_logit = jnp.log(2.0 ** (5.0 + jnp.arange(R_HEADS, dtype=jnp.float32)) - 1.0)
    return {
        'x': n((BATCH, SEQ, D_MODEL)),
        'meta_tokens': n((N_META, D_MODEL)),
        'attn_norm_g': 1.0 + 0.02 * n((DEPTH, D_MODEL)),
        'ffn_norm_g': 1.0 + 0.02 * n((DEPTH, D_MODEL)),
        'even_w_in': n((N_EVEN, D_MODEL, EVEN_IN)) * D_MODEL ** -0.5,
        'even_conv_w': n((N_EVEN, M_CONV, 2 * M_WIDTH)) * M_CONV ** -0.5,
        'even_gate_b': gate_b,
        'even_m_norm_g': 1.0 + 0.02 * n((N_EVEN, M_WIDTH)),
        'even_ret_decay_logit': base_logit + 0.1 * n((N_EVEN, 2, R_HEADS)),
        'even_r_norm_g': 1.0 + 0.02 * n((N_EVEN, R_WIDTH)),
        'even_w_out': n((N_EVEN, EVEN_MIX, D_MODEL)) * EVEN_MIX ** -0.5,
        'odd_w_in': n((N_ODD, D_MODEL, ODD_IN)) * D_MODEL ** -0.5,
        'odd_q_norm_g': 1.0 + 0.02 * n((N_ODD, NA_HEAD_DIM)),
        'odd_k_norm_g': 1.0 + 0.02 * n((N_ODD, NA_HEAD_DIM)),
        'odd_rpb': 0.1 * n((N_ODD, NA_HEADS, 2 * NA_WIN_ROWS - 1, 2 * NA_WIN_COLS - 1)),
        'odd_w_out': n((N_ODD, NA_WIDTH, D_MODEL)) * NA_WIDTH ** -0.5,
        'router_w': n((DEPTH, D_MODEL, N_EXPERTS)) * D_MODEL ** -0.5,
        'expert_w_gate': n((DEPTH, N_EXPERTS, D_MODEL, EXPERT_FF)) * D_MODEL ** -0.5,
        'expert_w_up': n((DEPTH, N_EXPERTS, D_MODEL, EXPERT_FF)) * D_MODEL ** -0.5,
        'expert_w_down': n((DEPTH, N_EXPERTS, EXPERT_FF, D_MODEL)) * EXPERT_FF ** -0.5,
    }


def reference(x, meta_tokens, attn_norm_g, ffn_norm_g, even_w_in, even_conv_w, even_gate_b,
              even_m_norm_g, even_ret_decay_logit, even_r_norm_g, even_w_out, odd_w_in,
              odd_q_norm_g, odd_k_norm_g, odd_rpb, odd_w_out, router_w, expert_w_gate,
              expert_w_up, expert_w_down):
    bsz = x.shape[0]
    meta = jnp.broadcast_to(meta_tokens.astype(x.dtype)[None], (bsz, N_META, x.shape[-1]))
    h = jnp.concatenate([meta, x], axis=1)
    for layer in range(DEPTH):
        j = layer // 2
        u = rms_norm(h, attn_norm_g[layer])
        if layer % 2 == 0:
            h = h + even_mixer(u, even_w_in[j], even_conv_w[j], even_gate_b[j], even_m_norm_g[j],
                               even_ret_decay_logit[j], even_r_norm_g[j], even_w_out[j])
        else:
            h = h + odd_mixer(u, odd_w_in[j], odd_q_norm_g[j], odd_k_norm_g[j], odd_rpb[j], odd_w_out[j])
        h = h + expert_choice_ffn(rms_norm(h, ffn_norm_g[layer]), router_w[layer],
                                  expert_w_gate[layer], expert_w_up[layer], expert_w_down[layer])
    return h[:, N_META:]
```

```cpp
#include <hip/hip_runtime.h>
#include <stdint.h>
#include <string.h>

#define B_ 8
#define L_ 2064
#define T_ (B_ * L_)
#define D_ 1024
#define NM 16
#define EVEN_IN 4112
#define ODD_IN 3072
#define NE 16
#define CAP 258
#define NG (B_ * NE)

__device__ __forceinline__ float block_sum256(float v, float* red) {
    for (int o = 32; o > 0; o >>= 1) v += __shfl_xor(v, o);
    __syncthreads();
    if ((threadIdx.x & 63) == 0) red[threadIdx.x >> 6] = v;
    __syncthreads();
    return red[0] + red[1] + red[2] + red[3];
}
__device__ __forceinline__ float sigmoidf_(float x) { return 1.f / (1.f + expf(-x)); }
__device__ __forceinline__ float siluf_(float x) { return x / (1.f + expf(-x)); }
__device__ __forceinline__ float logsigmoidf_(float x) { return fminf(x, 0.f) - log1pf(expf(-fabsf(x))); }

__global__ void k_init_h(const float* __restrict__ x, const float* __restrict__ meta, float* __restrict__ h) {
    int tok = blockIdx.x; int b = tok / L_, t = tok % L_;
    const float* src = t < NM ? meta + (size_t)t * D_ : x + ((size_t)b * 2048 + (t - NM)) * D_;
    ((float4*)(h + (size_t)tok * D_))[threadIdx.x] = ((const float4*)src)[threadIdx.x];
}
__global__ void k_final(const float* __restrict__ h, float* __restrict__ out) {
    int r = blockIdx.x; int b = r / 2048, t = r % 2048;
    ((float4*)(out + (size_t)r * D_))[threadIdx.x] = ((const float4*)(h + ((size_t)b * L_ + NM + t) * D_))[threadIdx.x];
}

__global__ void k_rmsnorm(const float* __restrict__ h, const float* __restrict__ g, float* __restrict__ u) {
    __shared__ float red[4];
    int tok = blockIdx.x;
    float4 v = ((const float4*)(h + (size_t)tok * D_))[threadIdx.x];
    float s = v.x * v.x + v.y * v.y + v.z * v.z + v.w * v.w;
    s = block_sum256(s, red);
    float r = rsqrtf(s * (1.f / D_) + 1e-6f);
    float4 gg = ((const float4*)g)[threadIdx.x];
    float4 o; o.x = v.x * r * gg.x; o.y = v.y * r * gg.y; o.z = v.z * r * gg.z; o.w = v.w * r * gg.w;
    ((float4*)(u + (size_t)tok * D_))[threadIdx.x] = o;
}

struct GemmP {
    const float* A; int lda; long A_bs; const int* arow; long arow_bs;
    const float* Bm; int ldb; long B_bs; int bmod;
    float* C; int ldc; long C_bs;
    int M, N, K; int acc;
};
__global__ void __launch_bounds__(256) k_gemm(GemmP p) {
    __shared__ float As[16][68];
    __shared__ float Bs[16][68];
    const int z = blockIdx.z;
    const float* A = p.A + (size_t)z * p.A_bs;
    const int* arow = p.arow ? p.arow + (size_t)z * p.arow_bs : nullptr;
    const float* Bm = p.Bm + (size_t)(z % p.bmod) * p.B_bs;
    float* C = p.C + (size_t)z * p.C_bs;
    const int m0 = blockIdx.y * 64, n0 = blockIdx.x * 64;
    const int tid = threadIdx.x, tx = tid & 15, ty = tid >> 4;
    const int ar = tid >> 2, ak = (tid & 3) * 4;
    int am = m0 + ar; if (am >= p.M) am = p.M - 1;
    const long arow_g = arow ? (long)arow[am] : (long)am;
    const float* Ap = A + arow_g * p.lda + ak;
    const int bk = tid >> 4, bn = (tid & 15) * 4;
    const bool bvalid = (n0 + bn) < p.N;
    const float* Bp = Bm + (size_t)bk * p.ldb + n0 + bn;
    float acc[4][4];
#pragma unroll
    for (int i = 0; i < 4; ++i)
#pragma unroll
        for (int j = 0; j < 4; ++j) acc[i][j] = 0.f;
    for (int k0 = 0; k0 < p.K; k0 += 16) {
        float4 av = *(const float4*)(Ap + k0);
        float4 bv = bvalid ? *(const float4*)(Bp + (size_t)k0 * p.ldb) : make_float4(0.f, 0.f, 0.f, 0.f);
        __syncthreads();
        As[ak + 0][ar] = av.x; As[ak + 1][ar] = av.y; As[ak + 2][ar] = av.z; As[ak + 3][ar] = av.w;
        *(float4*)&Bs[bk][bn] = bv;
        __syncthreads();
#pragma unroll
        for (int k = 0; k < 16; ++k) {
            float4 a = *(const float4*)&As[k][ty * 4];
            float4 b = *(const float4*)&Bs[k][tx * 4];
            float aa[4] = {a.x, a.y, a.z, a.w}, bb[4] = {b.x, b.y, b.z, b.w};
#pragma unroll
            for (int i = 0; i < 4; ++i)
#pragma unroll
                for (int j = 0; j < 4; ++j) acc[i][j] += aa[i] * bb[j];
        }
    }
#pragma unroll
    for (int i = 0; i < 4; ++i) {
        int m = m0 + ty * 4 + i; if (m >= p.M) continue;
        int n = n0 + tx * 4; if (n >= p.N) continue;
        float* cp = C + (size_t)m * p.ldc + n;
        float4 o = make_float4(acc[i][0], acc[i][1], acc[i][2], acc[i][3]);
        if (p.acc) { float4 c = *(float4*)cp; o.x += c.x; o.y += c.y; o.z += c.z; o.w += c.w; }
        *(float4*)cp = o;
    }
}

__global__ void k_conv(const float* __restrict__ z, const float* __restrict__ w, float* __restrict__ qk) {
    int tok = blockIdx.x; int b = tok / L_, t = tok % L_;
    for (int c = threadIdx.x; c < 1024; c += 256) {
        float s = 0.f;
#pragma unroll
        for (int j = 0; j < 5; ++j) {
            int tt = t + j - 2;
            if (tt >= 0 && tt < L_) s += w[j * 1024 + c] * z[((size_t)b * L_ + tt) * EVEN_IN + c];
        }
        qk[(size_t)tok * 1024 + c] = siluf_(s);
    }
}
__global__ void k_rotary(float* __restrict__ z) {
    int tok = blockIdx.x; int t = tok % L_;
    int tid = threadIdx.x;
    int hh = tid >> 6, i = tid & 63;
    float inv = powf(10000.f, -(float)i / 64.f);
    float ang = (float)t * inv;
    float c = cosf(ang), s = sinf(ang);
    float* q = z + (size_t)tok * EVEN_IN + 2064 + hh * 128;
    float* k = z + (size_t)tok * EVEN_IN + 2576 + hh * 128;
    float q1 = q[i], q2 = q[i + 64];
    q[i] = q1 * c - q2 * s; q[i + 64] = q2 * c + q1 * s;
    float k1 = k[i], k2 = k[i + 64];
    const float sc = 0.08838834764831845f;
    k[i] = (k1 * c - k2 * s) * sc; k[i + 64] = (k2 * c + k1 * s) * sc;
}
__global__ void __launch_bounds__(256) k_mlstm(const float* __restrict__ qk, const float* __restrict__ z, const float* __restrict__ gate_b, float* __restrict__ hm) {
    const int b = blockIdx.x >> 3, hh = (blockIdx.x >> 1) & 3, dir = blockIdx.x & 1;
    const int tid = threadIdx.x, e = tid & 127, dh = tid >> 7;
    __shared__ float sq[128], sk[128], sn[128], spart[256];
    float C[64];
#pragma unroll
    for (int d = 0; d < 64; ++d) C[d] = 0.f;
    if (tid < 128) sn[tid] = 0.f;
    float m = 0.f;
    const float gbi = gate_b[dir * 8 + hh], gbf = gate_b[dir * 8 + 4 + hh];
    __syncthreads();
    for (int s = 0; s < L_; ++s) {
        const int t = s < NM ? s : (dir ? NM + (2047 - (s - NM)) : s);
        const size_t tok = (size_t)b * L_ + t;
        const float li = z[tok * EVEN_IN + 2048 + dir * 8 + hh] + gbi;
        const float lf = logsigmoidf_(z[tok * EVEN_IN + 2048 + dir * 8 + 4 + hh] + gbf);
        const float mn = fmaxf(lf + m, li);
        const float wf = expf(lf + m - mn), wi = expf(li - mn);
        if (tid < 128) { sq[tid] = qk[tok * 1024 + hh * 128 + tid]; sk[tid] = qk[tok * 1024 + 512 + hh * 128 + tid] * 0.08838834764831845f; }
        const float ve = z[tok * EVEN_IN + 1024 + hh * 128 + e];
        __syncthreads();
        if (tid < 128) sn[tid] = wf * sn[tid] + wi * sk[tid];
        float part = 0.f;
#pragma unroll
        for (int d = 0; d < 64; ++d) { const int dd = dh * 64 + d; C[d] = wf * C[d] + wi * sk[dd] * ve; part += sq[dd] * C[d]; }
        spart[tid] = part;
        __syncthreads();
        if (tid < 128) {
            float den = 0.f;
            for (int d = 0; d < 128; ++d) den += sq[d] * sn[d];
            const float num = spart[tid] + spart[tid + 128];
            hm[((size_t)dir * T_ + tok) * 512 + hh * 128 + tid] = num / fmaxf(fabsf(den), expf(-mn));
        }
        m = mn;
        __syncthreads();
    }
}
__global__ void __launch_bounds__(256) k_retention(const float* __restrict__ z, const float* __restrict__ decay_logit, float* __restrict__ hr) {
    const int b = blockIdx.x >> 3, hh = (blockIdx.x >> 1) & 3, dir = blockIdx.x & 1;
    const int tid = threadIdx.x, e = tid & 127, dh = tid >> 7;
    __shared__ float sq[128], sk[128], spart[256];
    float R[64];
#pragma unroll
    for (int d = 0; d < 64; ++d) R[d] = 0.f;
    const float gamma = expf(logsigmoidf_(decay_logit[dir * 4 + hh]));
    for (int s = 0; s < L_; ++s) {
        const int t = s < NM ? s : (dir ? NM + (2047 - (s - NM)) : s);
        const size_t tok = (size_t)b * L_ + t;
        if (tid < 128) { sq[tid] = z[tok * EVEN_IN + 2064 + hh * 128 + tid]; sk[tid] = z[tok * EVEN_IN + 2576 + hh * 128 + tid]; }
        const float ve = z[tok * EVEN_IN + 3088 + hh * 128 + e];
        __syncthreads();
        float part = 0.f;
#pragma unroll
        for (int d = 0; d < 64; ++d) { const int dd = dh * 64 + d; R[d] = gamma * R[d] + sk[dd] * ve; part += sq[dd] * R[d]; }
        spart[tid] = part;
        __syncthreads();
        if (tid < 128) hr[((size_t)dir * T_ + tok) * 512 + hh * 128 + tid] = spart[tid] + spart[tid + 128];
        __syncthreads();
    }
}
__global__ void k_mixfin(const float* __restrict__ hm, const float* __restrict__ hr, const float* __restrict__ z,
                         const float* __restrict__ mg, const float* __restrict__ rg, float* __restrict__ mix) {
    const int tok = blockIdx.x, tid = threadIdx.x;
    float v[4], gate[4], g[4];
#pragma unroll
    for (int j = 0; j < 4; ++j) {
        const int f = tid * 4 + j;
        if (f < 512) {
            v[j] = hm[(size_t)tok * 512 + f] + hm[((size_t)T_ + tok) * 512 + f];
            gate[j] = sigmoidf_(z[(size_t)tok * EVEN_IN + 1536 + f]);
            g[j] = mg[f];
        } else {
            const int f2 = f - 512;
            v[j] = hr[(size_t)tok * 512 + f2] + hr[((size_t)T_ + tok) * 512 + f2];
            gate[j] = siluf_(z[(size_t)tok * EVEN_IN + 3600 + f2]);
            g[j] = rg[f2];
        }
    }
    float ss = v[0] * v[0] + v[1] * v[1] + v[2] * v[2] + v[3] * v[3];
    for (int o = 16; o > 0; o >>= 1) ss += __shfl_xor(ss, o);
    const float r = rsqrtf(ss * (1.f / 128.f) + 1e-6f);
#pragma unroll
    for (int j = 0; j < 4; ++j) mix[(size_t)tok * 1024 + tid * 4 + j] = gate[j] * (v[j] * r * g[j]);
}

__global__ void k_qknorm(float* __restrict__ z, const float* __restrict__ qg, const float* __restrict__ kg) {
    const int tok = blockIdx.x, tid = threadIdx.x;
#pragma unroll
    for (int which = 0; which < 2; ++which) {
        float* p = z + (size_t)tok * ODD_IN + which * 1024 + tid * 4;
        float4 v = *(float4*)p;
        float ss = v.x * v.x + v.y * v.y + v.z * v.z + v.w * v.w;
        for (int o = 8; o > 0; o >>= 1) ss += __shfl_xor(ss, o);
        const float r = rsqrtf(ss * (1.f / 64.f) + 1e-6f);
        const float* g = which ? kg : qg;
        const int d = (tid * 4) & 63;
        const float sc = which ? 1.f : 0.125f;
        v.x = v.x * r * g[d] * sc; v.y = v.y * r * g[d + 1] * sc; v.z = v.z * r * g[d + 2] * sc; v.w = v.w * r * g[d + 3] * sc;
        *(float4*)p = v;
    }
}
__global__ void __launch_bounds__(64) k_natten(const float* __restrict__ z, const float* __restrict__ rpb, float* __restrict__ att) {
    const int tok = blockIdx.x, head = blockIdx.y, tid = threadIdx.x;
    const int b = tok / L_, t = tok % L_;
    __shared__ float sq[64], sp[144]; __shared__ int skt[144];
    sq[tid] = z[(size_t)tok * ODD_IN + head * 64 + tid];
    int nkeys, r = 0, c = 0, rs = 0, cs = 0;
    if (t < NM) nkeys = 16;
    else { nkeys = 144; const int g = t - NM; r = g >> 6; c = g & 63; rs = min(max(r - 4, 0), 24); cs = min(max(c - 8, 0), 48); }
    __syncthreads();
    for (int j = tid; j < nkeys; j += 64) {
        int kt; float bias = 0.f;
        if (j < 16) kt = j;
        else {
            const int jj = j - 16; const int kr = rs + (jj >> 4), kc = cs + (jj & 15);
            kt = NM + kr * 64 + kc;
            const int dr = kr - r + 7; int dc = kc - c; dc = min(max(dc, -15), 15) + 15;
            bias = rpb[(head * 15 + dr) * 31 + dc];
        }
        const float* kp = z + ((size_t)b * L_ + kt) * ODD_IN + 1024 + head * 64;
        float s = 0.f;
        for (int d = 0; d < 64; ++d) s += sq[d] * kp[d];
        sp[j] = s + bias; skt[j] = kt;
    }
    __syncthreads();
    float mx = -3.0e38f;
    for (int j = 0; j < nkeys; ++j) mx = fmaxf(mx, sp[j]);
    float sum = 0.f;
    for (int j = 0; j < nkeys; ++j) sum += expf(sp[j] - mx);
    float o = 0.f;
    for (int j = 0; j < nkeys; ++j) o += expf(sp[j] - mx) * z[((size_t)b * L_ + skt[j]) * ODD_IN + 2048 + head * 64 + tid];
    att[(size_t)tok * 1024 + head * 64 + tid] = o / sum;
}

__global__ void k_router(const float* __restrict__ h, const float* __restrict__ g, const float* __restrict__ wr,
                         float* __restrict__ u2, float* __restrict__ aff) {
    __shared__ float red[4]; __shared__ float part[4][16];
    const int tok = blockIdx.x, tid = threadIdx.x;
    float4 v = ((const float4*)(h + (size_t)tok * D_))[tid];
    float s = v.x * v.x + v.y * v.y + v.z * v.z + v.w * v.w;
    s = block_sum256(s, red);
    const float r = rsqrtf(s * (1.f / D_) + 1e-6f);
    float4 gg = ((const float4*)g)[tid];
    float uu[4] = {v.x * r * gg.x, v.y * r * gg.y, v.z * r * gg.z, v.w * r * gg.w};
    ((float4*)(u2 + (size_t)tok * D_))[tid] = make_float4(uu[0], uu[1], uu[2], uu[3]);
    float lg[16];
#pragma unroll
    for (int e = 0; e < 16; ++e) lg[e] = 0.f;
#pragma unroll
    for (int j = 0; j < 4; ++j) {
        const float* w = wr + (size_t)(tid * 4 + j) * 16;
#pragma unroll
        for (int e = 0; e < 16; ++e) lg[e] += uu[j] * w[e];
    }
#pragma unroll
    for (int e = 0; e < 16; ++e) { float x = lg[e]; for (int o = 32; o > 0; o >>= 1) x += __shfl_xor(x, o); lg[e] = x; }
    if ((tid & 63) == 0) {
#pragma unroll
        for (int e = 0; e < 16; ++e) part[tid >> 6][e] = lg[e];
    }
    __syncthreads();
    if (tid == 0) {
        float l[16]; float mx = -3.0e38f;
        for (int e = 0; e < 16; ++e) { l[e] = part[0][e] + part[1][e] + part[2][e] + part[3][e]; mx = fmaxf(mx, l[e]); }
        float sum = 0.f;
        for (int e = 0; e < 16; ++e) { l[e] = expf(l[e] - mx); sum += l[e]; }
        for (int e = 0; e < 16; ++e) aff[(size_t)tok * 16 + e] = l[e] / sum;
    }
}
__global__ void __launch_bounds__(256) k_topk(const float* __restrict__ aff, int* __restrict__ idx, float* __restrict__ gate, int* __restrict__ sel) {
    __shared__ float sa[L_];
    const int g = blockIdx.x, b = g >> 4, e = g & 15, tid = threadIdx.x;
    for (int i = tid; i < L_; i += 256) sa[i] = aff[((size_t)b * L_ + i) * 16 + e];
    __syncthreads();
    for (int i = tid; i < L_; i += 256) {
        const float a = sa[i]; int rank = 0;
        for (int j = 0; j < L_; ++j) { const float x = sa[j]; rank += (x > a || (x == a && j < i)) ? 1 : 0; }
        if (rank < CAP) { idx[g * CAP + rank] = b * L_ + i; gate[g * CAP + rank] = a; }
        sel[((size_t)b * L_ + i) * 16 + e] = rank < CAP ? rank : -1;
    }
}
__global__ void k_silumul(float* __restrict__ a, const float* __restrict__ bsrc, size_t n4) {
    size_t i = (size_t)blockIdx.x * 256 + threadIdx.x;
    if (i >= n4) return;
    float4 x = ((float4*)a)[i], y = ((const float4*)bsrc)[i];
    x.x = siluf_(x.x) * y.x; x.y = siluf_(x.y) * y.y; x.z = siluf_(x.z) * y.z; x.w = siluf_(x.w) * y.w;
    ((float4*)a)[i] = x;
}
__global__ void k_combine(float* __restrict__ h, const float* __restrict__ ys, const float* __restrict__ gate, const int* __restrict__ sel) {
    const int tok = blockIdx.x, tid = threadIdx.x, b = tok / L_;
    float4 acc = make_float4(0.f, 0.f, 0.f, 0.f);
    for (int e = 0; e < 16; ++e) {
        const int s = sel[(size_t)tok * 16 + e];
        if (s >= 0) {
            const size_t slot = (size_t)(b * 16 + e) * CAP + s;
            const float gt = gate[slot];
            float4 y = ((const float4*)(ys + slot * D_))[tid];
            acc.x += y.x * gt; acc.y += y.y * gt; acc.z += y.z * gt; acc.w += y.w * gt;
        }
    }
    float4* hp = (float4*)(h + (size_t)tok * D_) + tid;
    float4 hv = *hp; hv.x += acc.x; hv.y += acc.y; hv.z += acc.z; hv.w += acc.w; *hp = hv;
}

static void gemm(hipStream_t st, const float* A, int lda, long A_bs, const int* arow, long arow_bs, const float* Bm, int ldb, long B_bs, int bmod,
                 float* C, int ldc, long C_bs, int M, int N, int K, int acc, int batch) {
    GemmP p; memset(&p, 0, sizeof(p)); p.A = A; p.lda = lda; p.A_bs = A_bs; p.arow = arow; p.arow_bs = arow_bs; p.Bm = Bm; p.ldb = ldb; p.B_bs = B_bs; p.bmod = bmod;
    p.C = C; p.ldc = ldc; p.C_bs = C_bs; p.M = M; p.N = N; p.K = K; p.acc = acc;
    dim3 grid((N + 63) / 64, (M + 63) / 64, batch);
    hipLaunchKernelGGL(k_gemm, grid, dim3(256), 0, st, p);
}

extern "C" void kernel_launch(void* const* d_in, const int* in_sizes, int n_in, void* d_out, int out_size, void* d_ws, size_t ws_size, hipStream_t stream) {
    const float* x = (const float*)d_in[0];
    const float* meta = (const float*)d_in[1];
    const float* attn_norm_g = (const float*)d_in[2];
    const float* ffn_norm_g = (const float*)d_in[3];
    const float* even_w_in = (const float*)d_in[4];
    const float* even_conv_w = (const float*)d_in[5];
    const float* even_gate_b = (const float*)d_in[6];
    const float* even_m_norm_g = (const float*)d_in[7];
    const float* even_decay = (const float*)d_in[8];
    const float* even_r_norm_g = (const float*)d_in[9];
    const float* even_w_out = (const float*)d_in[10];
    const float* odd_w_in = (const float*)d_in[11];
    const float* odd_q_norm_g = (const float*)d_in[12];
    const float* odd_k_norm_g = (const float*)d_in[13];
    const float* odd_rpb = (const float*)d_in[14];
    const float* odd_w_out = (const float*)d_in[15];
    const float* router_w = (const float*)d_in[16];
    const float* w_gate = (const float*)d_in[17];
    const float* w_up = (const float*)d_in[18];
    const float* w_down = (const float*)d_in[19];
    float* out = (float*)d_out;

    float* ws = (float*)d_ws;
    size_t o = 0;
    float* h = ws + o;   o += (size_t)T_ * D_;
    float* u = ws + o;   o += (size_t)T_ * D_;
    float* qk = ws + o;  o += (size_t)T_ * D_;
    float* hm = ws + o;  o += (size_t)T_ * D_;
    float* hr = ws + o;  o += (size_t)T_ * D_;
    float* z = ws + o;   o += (size_t)T_ * EVEN_IN;
    float* aff = ws + o; o += (size_t)T_ * 16;
    float* gate = ws + o; o += (size_t)NG * CAP + 64;
    int* idx = (int*)(ws + o); o += (size_t)NG * CAP + 64;
    int* sel = (int*)(ws + o); o += (size_t)T_ * 16;
    float* mix = qk;
    float* hdn = z;
    float* ys = z + (size_t)NG * CAP * D_;

    hipLaunchKernelGGL(k_init_h, dim3(T_), dim3(256), 0, stream, x, meta, h);
    for (int layer = 0; layer < 4; ++layer) {
        const int j = layer >> 1;
        hipLaunchKernelGGL(k_rmsnorm, dim3(T_), dim3(256), 0, stream, h, attn_norm_g + layer * D_, u);
        if ((layer & 1) == 0) {
            gemm(stream, u, D_, 0, nullptr, 0, even_w_in + (size_t)j * D_ * EVEN_IN, EVEN_IN, 0, 1, z, EVEN_IN, 0, T_, EVEN_IN, D_, 0, 1);
            hipLaunchKernelGGL(k_conv, dim3(T_), dim3(256), 0, stream, z, even_conv_w + (size_t)j * 5 * 1024, qk);
            hipLaunchKernelGGL(k_rotary, dim3(T_), dim3(256), 0, stream, z);
            hipLaunchKernelGGL(k_mlstm, dim3(64), dim3(256), 0, stream, qk, z, even_gate_b + j * 16, hm);
            hipLaunchKernelGGL(k_retention, dim3(64), dim3(256), 0, stream, z, even_decay + j * 8, hr);
            hipLaunchKernelGGL(k_mixfin, dim3(T_), dim3(256), 0, stream, hm, hr, z, even_m_norm_g + j * 512, even_r_norm_g + j * 512, mix);
            gemm(stream, mix, D_, 0, nullptr, 0, even_w_out + (size_t)j * D_ * D_, D_, 0, 1, h, D_, 0, T_, D_, D_, 1, 1);
        } else {
            gemm(stream, u, D_, 0, nullptr, 0, odd_w_in + (size_t)j * D_ * ODD_IN, ODD_IN, 0, 1, z, ODD_IN, 0, T_, ODD_IN, D_, 0, 1);
            hipLaunchKernelGGL(k_qknorm, dim3(T_), dim3(256), 0, stream, z, odd_q_norm_g + j * 64, odd_k_norm_g + j * 64);
            hipLaunchKernelGGL(k_natten, dim3(T_, 16), dim3(64), 0, stream, z, odd_rpb + (size_t)j * 16 * 15 * 31, mix);
            gemm(stream, mix, D_, 0, nullptr, 0, odd_w_out + (size_t)j * D_ * D_, D_, 0, 1, h, D_, 0, T_, D_, D_, 1, 1);
        }
        hipLaunchKernelGGL(k_router, dim3(T_), dim3(256), 0, stream, h, ffn_norm_g + layer * D_, router_w + (size_t)layer * D_ * 16, u, aff);
        hipLaunchKernelGGL(k_topk, dim3(NG), dim3(256), 0, stream, aff, idx, gate, sel);
        const size_t wofs = (size_t)layer * NE * D_ * D_;
        gemm(stream, u, D_, 0, idx, CAP, w_gate + wofs, D_, (long)D_ * D_, NE, hdn, D_, (long)CAP * D_, CAP, D_, D_, 0, NG);
        gemm(stream, u, D_, 0, idx, CAP, w_up + wofs, D_, (long)D_ * D_, NE, ys, D_, (long)CAP * D_, CAP, D_, D_, 0, NG);
        {
            size_t n4 = (size_t)NG * CAP * D_ / 4;
            hipLaunchKernelGGL(k_silumul, dim3((unsigned)((n4 + 255) / 256)), dim3(256), 0, stream, hdn, ys, n4);
        }
        gemm(stream, hdn, D_, (long)CAP * D_, nullptr, 0, w_down + wofs, D_, (long)D_ * D_, NE, ys, D_, (long)CAP * D_, CAP, D_, D_, 0, NG);
        hipLaunchKernelGGL(k_combine, dim3(T_), dim3(256), 0, stream, h, ys, gate, sel);
    }
    hipLaunchKernelGGL(k_final, dim3(B_ * 2048), dim3(256), 0, stream, h, out);
}
```

```cpp
#include <hip/hip_runtime.h>
#include <stdint.h>
#include <string.h>

#define B_ 8
#define L_ 2064
#define T_ (B_ * L_)
#define D_ 1024
#define NM 16
#define EVEN_IN 4112
#define ODD_IN 3072
#define NE 16
#define CAP 258
#define NG (B_ * NE)

__device__ __forceinline__ float block_sum256(float v, float* red) {
    for (int o = 32; o > 0; o >>= 1) v += __shfl_xor(v, o);
    __syncthreads();
    if ((threadIdx.x & 63) == 0) red[threadIdx.x >> 6] = v;
    __syncthreads();
    return red[0] + red[1] + red[2] + red[3];
}
__device__ __forceinline__ float sigmoidf_(float x) { return 1.f / (1.f + expf(-x)); }
__device__ __forceinline__ float siluf_(float x) { return x / (1.f + expf(-x)); }
__device__ __forceinline__ float logsigmoidf_(float x) { return fminf(x, 0.f) - log1pf(expf(-fabsf(x))); }


typedef unsigned short bf16_t;
typedef short bf16x8 __attribute__((ext_vector_type(8)));
typedef float f32x4 __attribute__((ext_vector_type(4)));
typedef unsigned u32x4 __attribute__((ext_vector_type(4)));
typedef unsigned u32x2 __attribute__((ext_vector_type(2)));

#define NTHR 256
#define ESLOTS 2064
#define LDS_BYTES (72 * 1024)

__device__ __forceinline__ unsigned f2bf(float f) { unsigned u = __builtin_bit_cast(unsigned, f); return (u + 0x7fffu + ((u >> 16) & 1u)) >> 16; }
__device__ __forceinline__ unsigned pk2(float lo, float hi) { return f2bf(lo) | (f2bf(hi) << 16); }
__device__ __forceinline__ float bf2f(unsigned short b) { return __builtin_bit_cast(float, (unsigned)b << 16); }
__device__ __forceinline__ float bflo(unsigned w) { return __builtin_bit_cast(float, w << 16); }
__device__ __forceinline__ float bfhi(unsigned w) { return __builtin_bit_cast(float, w & 0xffff0000u); }

struct P {
    const float *x, *meta, *attn_g, *ffn_g, *e_win, *e_conv, *e_gb, *e_mg, *e_decay, *e_rg, *e_wout, *o_win, *o_qg, *o_kg, *o_rpb, *o_wout, *router_w, *w_gate, *w_up, *w_down;
    float* out;
    bf16_t *Wgu, *Wd, *WinE, *WinO, *WoutE, *WoutO;
    float* h;
    bf16_t* u;
    float* aff;
    float* gate;
    int* idx;
    int* sel;
    bf16_t* hdn;
    bf16_t* ys;
    bf16_t* zo;
    bf16_t* vT;
    bf16_t* mix;
    bf16_t* ze;
    bf16_t* qc;
    float* gts;
    bf16_t* osc;
    float* costab;
    float* sintab;
    unsigned* bar;
    int pad_;
};

__device__ __forceinline__ void conv_desc(const P& p, int rt, const float*& src_base, size_t& le_off, int& ld, bf16_t*& dst, int& kind, int& n0) {
    le_off = 0;
    if (rt < 2048) { const int le = rt >> 5, t = rt & 31; kind = 1; ld = 1024; src_base = p.w_gate; le_off = (size_t)le * 1024 * 1024; dst = p.Wgu + (size_t)le * 2048 * 1024; n0 = t * 64; return; }
    rt -= 2048;
    if (rt < 1024) { const int le = rt >> 4, t = rt & 15; kind = 0; ld = 1024; src_base = p.w_down + (size_t)le * 1024 * 1024; dst = p.Wd + (size_t)le * 1024 * 1024; n0 = t * 64; return; }
    rt -= 1024;
    if (rt < 128) { const int j = rt >> 6, t = rt & 63; kind = 2; ld = EVEN_IN; src_base = p.e_win + (size_t)j * 1024 * EVEN_IN; dst = p.WinE + (size_t)j * 4096 * 1024; n0 = t * 64; return; }
    rt -= 128;
    if (rt < 96) { const int j = rt / 48, t = rt % 48; kind = 0; ld = ODD_IN; src_base = p.o_win + (size_t)j * 1024 * ODD_IN; dst = p.WinO + (size_t)j * 3072 * 1024; n0 = t * 64; return; }
    rt -= 96;
    if (rt < 32) { const int j = rt >> 4, t = rt & 15; kind = 0; ld = 1024; src_base = p.e_wout + (size_t)j * 1024 * 1024; dst = p.WoutE + (size_t)j * 1024 * 1024; n0 = t * 64; return; }
    rt -= 32;
    { const int j = rt >> 4, t = rt & 15; kind = 0; ld = 1024; src_base = p.o_wout + (size_t)j * 1024 * 1024; dst = p.WoutO + (size_t)j * 1024 * 1024; n0 = t * 64; return; }
}
#define N_CONV_ROWTILES 3360
__device__ void phase_convert(const P& p, unsigned char* lds, int bid, int nb, int rt_begin, int rt_end) {
    float* tile = (float*)lds;
    const int tid = threadIdx.x;
    const int tn4 = tid & 15, tk = tid >> 4;
    const int ntiles = (rt_end - rt_begin) * 16;
    for (int it = bid; it < ntiles; it += nb) {
        const int rt = rt_begin + (it >> 4), k0 = (it & 15) * 64;
        const float* src_base; size_t le_off; int ld, kind, n0; bf16_t* dst;
        conv_desc(p, rt, src_base, le_off, ld, dst, kind, n0);
        const int n = n0 + tn4 * 4;
        const float* sp;
        if (kind == 0) sp = src_base + n;
        else if (kind == 1) {
            const int tn = n >> 7, r = n & 127, wc = r >> 6, nn = (r >> 4) & 3, i = r & 15;
            const int col = 64 * tn + 32 * wc + 16 * (nn & 1) + i;
            sp = ((nn < 2) ? p.w_gate : p.w_up) + le_off + col;
        } else {
            const int seg = n >> 9, j = n & 511;
            const int base = seg < 4 ? seg * 512 : 2064 + (seg - 4) * 512;
            int col = j;
            if (seg == 4 || seg == 5) {
                const int head = j >> 7, r = j & 127, wc = r >> 6, nn = (r >> 4) & 3, i = r & 15;
                col = head * 128 + (nn & 1) * 64 + 32 * wc + 16 * (nn >> 1) + i;
            }
            sp = src_base + base + col;
        }
        __syncthreads();
#pragma unroll
        for (int i = 0; i < 4; ++i) {
            const int kk = tk + 16 * i;
            const float4 v = *(const float4*)(sp + (size_t)(k0 + kk) * ld);
            tile[(tn4 * 4 + 0) * 65 + kk] = v.x; tile[(tn4 * 4 + 1) * 65 + kk] = v.y; tile[(tn4 * 4 + 2) * 65 + kk] = v.z; tile[(tn4 * 4 + 3) * 65 + kk] = v.w;
        }
        __syncthreads();
        const int row = tid >> 2, sg = tid & 3;
        const float* tr = tile + row * 65 + sg * 16;
        u32x4 w0, w1;
        w0.x = pk2(tr[0], tr[1]); w0.y = pk2(tr[2], tr[3]); w0.z = pk2(tr[4], tr[5]); w0.w = pk2(tr[6], tr[7]);
        w1.x = pk2(tr[8], tr[9]); w1.y = pk2(tr[10], tr[11]); w1.z = pk2(tr[12], tr[13]); w1.w = pk2(tr[14], tr[15]);
        bf16_t* dp = dst + (size_t)(n0 + row) * 1024 + k0 + sg * 16;
        *(u32x4*)dp = w0; *(u32x4*)(dp + 8) = w1;
    }
}

template <bool SWAP>
__device__ __forceinline__ void gemm_tile(const bf16_t* ap0, const bf16_t* ap1, const bf16_t* ap2, const bf16_t* ap3,
                                          const bf16_t* bp, int ldb, int K, unsigned char* lds, f32x4 (&acc)[4][4]) {
    const int tid = threadIdx.x, lane = tid & 63, wid = tid >> 6, wr = wid >> 1, wc = wid & 1, fr = lane & 15, fq = lane >> 4;
    const int lrow = tid >> 3, lch = tid & 7;
    const int wofs = lrow * 128 + ((lch ^ ((lrow >> 1) & 7)) << 4);
    const int sw = (fr >> 1) & 7;
    const int aofs = (wr * 64 + fr) * 128, bofs = 16384 + (wc * 64 + fr) * 128;
    const int c0 = ((0 + fq) ^ sw) << 4, c1 = ((4 + fq) ^ sw) << 4;
    const bf16_t* bp1 = bp + (size_t)32 * ldb; const bf16_t* bp2 = bp + (size_t)64 * ldb; const bf16_t* bp3 = bp + (size_t)96 * ldb;
#pragma unroll
    for (int m = 0; m < 4; ++m)
#pragma unroll
        for (int n = 0; n < 4; ++n) acc[m][n] = (f32x4){0.f, 0.f, 0.f, 0.f};
    u32x4 ra0, ra1, ra2, ra3, rb0, rb1, rb2, rb3;
    ra0 = *(const u32x4*)ap0; ra1 = *(const u32x4*)ap1; ra2 = *(const u32x4*)ap2; ra3 = *(const u32x4*)ap3;
    rb0 = *(const u32x4*)bp;  rb1 = *(const u32x4*)bp1; rb2 = *(const u32x4*)bp2; rb3 = *(const u32x4*)bp3;
    {
        unsigned char* w = lds + wofs;
        *(u32x4*)(w) = ra0; *(u32x4*)(w + 4096) = ra1; *(u32x4*)(w + 8192) = ra2; *(u32x4*)(w + 12288) = ra3;
        *(u32x4*)(w + 16384) = rb0; *(u32x4*)(w + 16384 + 4096) = rb1; *(u32x4*)(w + 16384 + 8192) = rb2; *(u32x4*)(w + 16384 + 12288) = rb3;
    }
    __syncthreads();
    const int nk = K >> 6;
    for (int kt = 0; kt < nk; ++kt) {
        const int cur = kt & 1;
        const bool more = (kt + 1) < nk;
        if (more) {
            const int ko = (kt + 1) * 64;
            ra0 = *(const u32x4*)(ap0 + ko); ra1 = *(const u32x4*)(ap1 + ko); ra2 = *(const u32x4*)(ap2 + ko); ra3 = *(const u32x4*)(ap3 + ko);
            rb0 = *(const u32x4*)(bp + ko);  rb1 = *(const u32x4*)(bp1 + ko); rb2 = *(const u32x4*)(bp2 + ko); rb3 = *(const u32x4*)(bp3 + ko);
        }
        const unsigned char* sA = lds + cur * 32768 + aofs;
        const unsigned char* sB = lds + cur * 32768 + bofs;
#pragma unroll
        for (int kk = 0; kk < 2; ++kk) {
            const int cc = kk ? c1 : c0;
            bf16x8 af[4], bf[4];
#pragma unroll
            for (int m = 0; m < 4; ++m) af[m] = *(const bf16x8*)(sA + m * 2048 + cc);
#pragma unroll
            for (int n = 0; n < 4; ++n) bf[n] = *(const bf16x8*)(sB + n * 2048 + cc);
#pragma unroll
            for (int m = 0; m < 4; ++m)
#pragma unroll
                for (int n = 0; n < 4; ++n) {
                    if (SWAP) acc[m][n] = __builtin_amdgcn_mfma_f32_16x16x32_bf16(af[m], bf[n], acc[m][n], 0, 0, 0);
                    else      acc[m][n] = __builtin_amdgcn_mfma_f32_16x16x32_bf16(bf[n], af[m], acc[m][n], 0, 0, 0);
                }
        }
        if (more) {
            unsigned char* w = lds + (cur ^ 1) * 32768 + wofs;
            *(u32x4*)(w) = ra0; *(u32x4*)(w + 4096) = ra1; *(u32x4*)(w + 8192) = ra2; *(u32x4*)(w + 12288) = ra3;
            *(u32x4*)(w + 16384) = rb0; *(u32x4*)(w + 16384 + 4096) = rb1; *(u32x4*)(w + 16384 + 8192) = rb2; *(u32x4*)(w + 16384 + 12288) = rb3;
        }
        __syncthreads();
    }
}

__device__ void phase_router(const P& p, int layer, unsigned char* lds, int bid, int nb) {
    float* red = (float*)lds;
    float* part = (float*)lds + 16;
    const int tid = threadIdx.x;
    const float* g = p.ffn_g + layer * D_;
    const float* wr = p.router_w + (size_t)layer * D_ * 16;
    const float4 gg = ((const float4*)g)[tid];
    for (int tok = bid; tok < T_; tok += nb) {
        const float4 v = ((const float4*)(p.h + (size_t)tok * D_))[tid];
        float s = v.x * v.x + v.y * v.y + v.z * v.z + v.w * v.w;
        s = block_sum256(s, red);
        const float r = rsqrtf(s * (1.f / D_) + 1e-6f);
        const float uu[4] = {v.x * r * gg.x, v.y * r * gg.y, v.z * r * gg.z, v.w * r * gg.w};
        u32x2 pk; pk.x = pk2(uu[0], uu[1]); pk.y = pk2(uu[2], uu[3]);
        *(u32x2*)(p.u + (size_t)tok * D_ + tid * 4) = pk;
        float lg[16];
#pragma unroll
        for (int e = 0; e < 16; ++e) lg[e] = 0.f;
#pragma unroll
        for (int j = 0; j < 4; ++j) {
            const float4* w = (const float4*)(wr + (size_t)(tid * 4 + j) * 16);
#pragma unroll
            for (int e4 = 0; e4 < 4; ++e4) { const float4 ww = w[e4]; lg[e4 * 4 + 0] += uu[j] * ww.x; lg[e4 * 4 + 1] += uu[j] * ww.y; lg[e4 * 4 + 2] += uu[j] * ww.z; lg[e4 * 4 + 3] += uu[j] * ww.w; }
        }
#pragma unroll
        for (int e = 0; e < 16; ++e) { float x = lg[e]; for (int o = 32; o > 0; o >>= 1) x += __shfl_xor(x, o); lg[e] = x; }
        if ((tid & 63) == 0) {
#pragma unroll
            for (int e = 0; e < 16; ++e) part[(tid >> 6) * 16 + e] = lg[e];
        }
        __syncthreads();
        if (tid < 16) {
            const float l = part[tid] + part[16 + tid] + part[32 + tid] + part[48 + tid];
            float mx = l;
            for (int o = 8; o > 0; o >>= 1) mx = fmaxf(mx, __shfl_xor(mx, o));
            const float ex = expf(l - mx);
            float sum = ex;
            for (int o = 8; o > 0; o >>= 1) sum += __shfl_xor(sum, o);
            p.aff[(size_t)tok * 16 + tid] = ex / sum;
        }
    }
}

__device__ void phase_topk(const P& p, unsigned char* lds, int bid, int nb) {
    float* sa = (float*)lds;
    const int tid = threadIdx.x;
    for (int it = bid; it < NG * 4; it += nb) {
        const int g = it >> 2, qtr = it & 3, b = g >> 4, e = g & 15;
        __syncthreads();
        for (int i = tid; i < L_; i += NTHR) sa[i] = p.aff[((size_t)b * L_ + i) * 16 + e];
        __syncthreads();
        for (int ii = tid; ii < 516; ii += NTHR) {
            const int i = qtr * 516 + ii;
            const float a = sa[i]; int rank = 0;
            for (int j = 0; j < L_; ++j) { const float x = sa[j]; rank += (x > a || (x == a && j < i)) ? 1 : 0; }
            if (rank < CAP) { const int slot = (e * B_ + b) * CAP + rank; p.idx[slot] = b * L_ + i; p.gate[slot] = a; }
            p.sel[((size_t)b * L_ + i) * 16 + e] = rank < CAP ? rank : -1;
        }
    }
}

__device__ void phase_gateup(const P& p, int layer, unsigned char* lds, int bid, int nb) {
    const int tid = threadIdx.x, lane = tid & 63, wid = tid >> 6, wr = wid >> 1, wc = wid & 1, fr = lane & 15, fq = lane >> 4;
    const int lrow = tid >> 3, lch = tid & 7;
    const int x = bid & 7, l = bid >> 3, nbx = nb >> 3;
    for (int s = l; s < 544; s += nbx) {
        const int e = 2 * x + s / 272, s2 = s % 272, grp = s2 / 136, r = s2 % 136, mt = r >> 3, nt = grp * 8 + (r & 7);
        const bf16_t* ap[4];
#pragma unroll
        for (int i = 0; i < 4; ++i) {
            int srow = mt * 128 + lrow + 32 * i; if (srow > ESLOTS - 1) srow = ESLOTS - 1;
            const int tokrow = p.idx[e * ESLOTS + srow];
            ap[i] = p.u + (size_t)tokrow * D_ + lch * 8;
        }
        const bf16_t* bp = p.Wgu + ((size_t)(layer * 16 + e) * 2048 + nt * 128 + lrow) * 1024 + lch * 8;
        f32x4 acc[4][4];
        gemm_tile<false>(ap[0], ap[1], ap[2], ap[3], bp, 1024, 1024, lds, acc);
#pragma unroll
        for (int m = 0; m < 4; ++m) {
            const int srow = mt * 128 + wr * 64 + m * 16 + fr;
            if (srow < ESLOTS) {
#pragma unroll
                for (int n = 0; n < 2; ++n) {
                    const int col = nt * 64 + wc * 32 + n * 16 + fq * 4;
                    const f32x4 gv = acc[m][n], uv = acc[m][n + 2];
                    float o[4];
#pragma unroll
                    for (int j = 0; j < 4; ++j) o[j] = gv[j] / (1.f + __expf(-gv[j])) * uv[j];
                    u32x2 pk; pk.x = pk2(o[0], o[1]); pk.y = pk2(o[2], o[3]);
                    *(u32x2*)(p.hdn + ((size_t)e * ESLOTS + srow) * D_ + col) = pk;
                }
            }
        }
    }
}

__device__ void phase_down(const P& p, int layer, unsigned char* lds, int bid, int nb) {
    const int tid = threadIdx.x, lane = tid & 63, wid = tid >> 6, wr = wid >> 1, wc = wid & 1, fr = lane & 15, fq = lane >> 4;
    const int lrow = tid >> 3, lch = tid & 7;
    const int x = bid & 7, l = bid >> 3, nbx = nb >> 3;
    for (int s = l; s < 272; s += nbx) {
        const int e = 2 * x + s / 136, s2 = s % 136, mt = s2 >> 3, nt = s2 & 7;
        const bf16_t* ap[4];
#pragma unroll
        for (int i = 0; i < 4; ++i) {
            int srow = mt * 128 + lrow + 32 * i; if (srow > ESLOTS - 1) srow = ESLOTS - 1;
            ap[i] = p.hdn + ((size_t)e * ESLOTS + srow) * D_ + lch * 8;
        }
        const bf16_t* bp = p.Wd + ((size_t)(layer * 16 + e) * 1024 + nt * 128 + lrow) * 1024 + lch * 8;
        f32x4 acc[4][4];
        gemm_tile<false>(ap[0], ap[1], ap[2], ap[3], bp, 1024, 1024, lds, acc);
#pragma unroll
        for (int m = 0; m < 4; ++m) {
            const int srow = mt * 128 + wr * 64 + m * 16 + fr;
            if (srow < ESLOTS) {
                const float gt = p.gate[e * ESLOTS + srow];
#pragma unroll
                for (int n = 0; n < 4; ++n) {
                    const int col = nt * 128 + wc * 64 + n * 16 + fq * 4;
                    const f32x4 v = acc[m][n];
                    u32x2 pk; pk.x = pk2(v[0] * gt, v[1] * gt); pk.y = pk2(v[2] * gt, v[3] * gt);
                    *(u32x2*)(p.ys + ((size_t)e * ESLOTS + srow) * D_ + col) = pk;
                }
            }
        }
    }
}

__device__ void phase_combine(const P& p, unsigned char* lds, int bid, int nb) {
    const int tid = threadIdx.x;
    for (int tok = bid; tok < T_; tok += nb) {
        const int b = tok / L_;
        float4 acc = make_float4(0.f, 0.f, 0.f, 0.f);
        for (int e = 0; e < 16; ++e) {
            const int s = p.sel[(size_t)tok * 16 + e];
            if (s >= 0) {
                const size_t slot = (size_t)(e * B_ + b) * CAP + s;
                const u32x2 y = *(const u32x2*)(p.ys + slot * D_ + tid * 4);
                acc.x += bflo(y.x); acc.y += bfhi(y.x); acc.z += bflo(y.y); acc.w += bfhi(y.y);
            }
        }
        float4* hp = (float4*)(p.h + (size_t)tok * D_) + tid;
        float4 hv = *hp; hv.x += acc.x; hv.y += acc.y; hv.z += acc.z; hv.w += acc.w; *hp = hv;
    }
}


__device__ void phase_norm(const P& p, int layer, unsigned char* lds, int bid, int nb) {
    float* red = (float*)lds;
    float* part = (float*)lds + 16;
    const int tid = threadIdx.x;
    const float4 gg = ((const float4*)(p.attn_g + layer * D_))[tid];
    const bool even = (layer & 1) == 0;
    const float* wg = p.e_win + (size_t)(layer >> 1) * D_ * EVEN_IN + 2048;
    const float* gb = p.e_gb + (layer >> 1) * 16;
    for (int tok = bid; tok < T_; tok += nb) {
        const float4 v = ((const float4*)(p.h + (size_t)tok * D_))[tid];
        float s = v.x * v.x + v.y * v.y + v.z * v.z + v.w * v.w;
        s = block_sum256(s, red);
        const float r = rsqrtf(s * (1.f / D_) + 1e-6f);
        const float uu[4] = {v.x * r * gg.x, v.y * r * gg.y, v.z * r * gg.z, v.w * r * gg.w};
        u32x2 pk; pk.x = pk2(uu[0], uu[1]); pk.y = pk2(uu[2], uu[3]);
        *(u32x2*)(p.u + (size_t)tok * D_ + tid * 4) = pk;
        if (even) {
            float lg[16];
#pragma unroll
            for (int e = 0; e < 16; ++e) lg[e] = 0.f;
#pragma unroll
            for (int j = 0; j < 4; ++j) {
                const float4* w = (const float4*)(wg + (size_t)(tid * 4 + j) * EVEN_IN);
#pragma unroll
                for (int e4 = 0; e4 < 4; ++e4) { const float4 ww = w[e4]; lg[e4 * 4 + 0] += uu[j] * ww.x; lg[e4 * 4 + 1] += uu[j] * ww.y; lg[e4 * 4 + 2] += uu[j] * ww.z; lg[e4 * 4 + 3] += uu[j] * ww.w; }
            }
#pragma unroll
            for (int e = 0; e < 16; ++e) { float x = lg[e]; for (int o = 32; o > 0; o >>= 1) x += __shfl_xor(x, o); lg[e] = x; }
            if ((tid & 63) == 0) {
#pragma unroll
                for (int e = 0; e < 16; ++e) part[(tid >> 6) * 16 + e] = lg[e];
            }
            __syncthreads();
            if (tid < 16) p.gts[(size_t)tok * 16 + tid] = part[tid] + part[16 + tid] + part[32 + tid] + part[48 + tid] + gb[tid];
        }
    }
}

__device__ void phase_odd_in(const P& p, int layer, unsigned char* lds, int bid, int nb) {
    const int tid = threadIdx.x, lane = tid & 63, wid = tid >> 6, wr = wid >> 1, wc = wid & 1, fr = lane & 15, fq = lane >> 4;
    const int lrow = tid >> 3, lch = tid & 7;
    const int x = bid & 7, l = bid >> 3, nbx = nb >> 3;
    const int j = layer >> 1;
    const bf16_t* W = p.WinO + (size_t)j * 3072 * 1024;
    for (int s = l; s < 129 * 3; s += nbx) {
        const int mt = s / 3, nt = 3 * x + (s % 3);
        const bf16_t* ap0 = p.u + ((size_t)mt * 128 + lrow) * D_ + lch * 8;
        const bf16_t* bp = W + ((size_t)nt * 128 + lrow) * 1024 + lch * 8;
        f32x4 acc[4][4];
        if (nt < 16) {
            gemm_tile<false>(ap0, ap0 + 32 * D_, ap0 + 64 * D_, ap0 + 96 * D_, bp, 1024, 1024, lds, acc);
            const bool isq = nt < 8;
            const float* g = isq ? (p.o_qg + j * 64) : (p.o_kg + j * 64);
            const float sc = isq ? 0.125f : 1.f;
            f32x4 gv[4];
#pragma unroll
            for (int n = 0; n < 4; ++n) gv[n] = *(const f32x4*)(g + n * 16 + fq * 4);
#pragma unroll
            for (int m = 0; m < 4; ++m) {
                float ss = 0.f;
#pragma unroll
                for (int n = 0; n < 4; ++n) { const f32x4 v = acc[m][n]; ss += v[0] * v[0] + v[1] * v[1] + v[2] * v[2] + v[3] * v[3]; }
                ss += __shfl_xor(ss, 16); ss += __shfl_xor(ss, 32);
                const float rinv = rsqrtf(ss * (1.f / 64.f) + 1e-6f) * sc;
                const size_t row = (size_t)mt * 128 + wr * 64 + m * 16 + fr;
#pragma unroll
                for (int n = 0; n < 4; ++n) {
                    const f32x4 v = acc[m][n];
                    u32x2 pk; pk.x = pk2(v[0] * rinv * gv[n][0], v[1] * rinv * gv[n][1]); pk.y = pk2(v[2] * rinv * gv[n][2], v[3] * rinv * gv[n][3]);
                    *(u32x2*)(p.zo + row * 2048 + nt * 128 + wc * 64 + n * 16 + fq * 4) = pk;
                }
            }
        } else {
            gemm_tile<true>(ap0, ap0 + 32 * D_, ap0 + 64 * D_, ap0 + 96 * D_, bp, 1024, 1024, lds, acc);
            const int head = (nt - 16) * 2 + wc;
#pragma unroll
            for (int m = 0; m < 4; ++m) {
                const int row = mt * 128 + wr * 64 + m * 16 + fq * 4;
                const int b = row / L_, t = row - b * L_;
#pragma unroll
                for (int n = 0; n < 4; ++n) {
                    const int d = n * 16 + fr;
                    const f32x4 v = acc[m][n];
                    u32x2 pk; pk.x = pk2(v[0], v[1]); pk.y = pk2(v[2], v[3]);
                    *(u32x2*)(p.vT + ((size_t)(b * 16 + head) * 64 + d) * L_ + t) = pk;
                }
            }
        }
    }
}

__device__ void phase_natten(const P& p, int layer, unsigned char* lds, int bid, int nb) {
    const int tid = threadIdx.x, lane = tid & 63, wid = tid >> 6, fr = lane & 15, fq = lane >> 4;
    const float* rpb = p.o_rpb + (size_t)(layer >> 1) * 16 * 15 * 31;
    const int nw = nb * 4, gw = bid * 4 + wid;
    const int NREAL = B_ * 32 * 16 * 4;
    for (int it = gw; it < NREAL + B_ * 16; it += nw) {
        if (it < NREAL) {
            const int w = it & 3, h = (it >> 2) & 15, r = (it >> 6) & 31, b = it >> 11;
            const int rs = min(max(r - 4, 0), 24);
            const int kc0 = (w == 0) ? 0 : (w == 1) ? 8 : (w == 2) ? 24 : 32;
            const size_t tokb = (size_t)b * L_;
            const int c = 16 * w + fr;
            const int cs = min(max(c - 8, 0), 48);
            const bf16_t* qp = p.zo + (tokb + NM + r * 64 + c) * 2048 + h * 64 + fq * 8;
            const bf16x8 qf0 = *(const bf16x8*)qp, qf1 = *(const bf16x8*)(qp + 32);
            f32x4 S[17];
#pragma unroll
            for (int n = 0; n < 17; ++n) {
                size_t tk;
                if (n < 16) tk = tokb + NM + (size_t)(rs + (n >> 1)) * 64 + kc0 + 8 * (fr >> 2) + 4 * (n & 1) + (fr & 3);
                else tk = tokb + fr;
                const bf16_t* kp = p.zo + tk * 2048 + 1024 + h * 64 + fq * 8;
                const bf16x8 kf0 = *(const bf16x8*)kp, kf1 = *(const bf16x8*)(kp + 32);
                f32x4 a = (f32x4){0.f, 0.f, 0.f, 0.f};
                a = __builtin_amdgcn_mfma_f32_16x16x32_bf16(kf0, qf0, a, 0, 0, 0);
                a = __builtin_amdgcn_mfma_f32_16x16x32_bf16(kf1, qf1, a, 0, 0, 0);
                S[n] = a;
            }
            float mx = -3.0e38f;
#pragma unroll
            for (int n = 0; n < 16; ++n) {
                const int dr = rs + (n >> 1) - r + 7;
                const float* bp = rpb + (h * 15 + dr) * 31;
#pragma unroll
                for (int jj = 0; jj < 4; ++jj) {
                    const int kc = kc0 + 8 * fq + 4 * (n & 1) + jj;
                    const bool valid = (kc >= cs) && (kc < cs + 16);
                    const int dc = min(max(kc - c + 15, 0), 30);
                    const float sv = valid ? S[n][jj] + bp[dc] : -3.0e38f;
                    S[n][jj] = sv; mx = fmaxf(mx, sv);
                }
            }
#pragma unroll
            for (int jj = 0; jj < 4; ++jj) mx = fmaxf(mx, S[16][jj]);
            mx = fmaxf(mx, __shfl_xor(mx, 16)); mx = fmaxf(mx, __shfl_xor(mx, 32));
            float sum = 0.f;
#pragma unroll
            for (int n = 0; n < 17; ++n)
#pragma unroll
                for (int jj = 0; jj < 4; ++jj) { const float e = __expf(S[n][jj] - mx); S[n][jj] = e; sum += e; }
            sum += __shfl_xor(sum, 16); sum += __shfl_xor(sum, 32);
            const float rinv = 1.f / sum;
            f32x4 O[4];
#pragma unroll
            for (int nd = 0; nd < 4; ++nd) O[nd] = (f32x4){0.f, 0.f, 0.f, 0.f};
            const bf16_t* vb = p.vT + ((size_t)(b * 16 + h) * 64 + fr) * L_;
#pragma unroll
            for (int t = 0; t < 8; ++t) {
                u32x4 pw; pw.x = pk2(S[2 * t][0], S[2 * t][1]); pw.y = pk2(S[2 * t][2], S[2 * t][3]); pw.z = pk2(S[2 * t + 1][0], S[2 * t + 1][1]); pw.w = pk2(S[2 * t + 1][2], S[2 * t + 1][3]);
                const bf16x8 pf = __builtin_bit_cast(bf16x8, pw);
                const int tt = NM + (rs + t) * 64 + kc0 + 8 * fq;
#pragma unroll
                for (int nd = 0; nd < 4; ++nd) {
                    const bf16x8 vf = *(const bf16x8*)(vb + (size_t)nd * 16 * L_ + tt);
                    O[nd] = __builtin_amdgcn_mfma_f32_16x16x32_bf16(vf, pf, O[nd], 0, 0, 0);
                }
            }
            {
                u32x4 pw; pw.x = pk2(S[16][0], S[16][1]); pw.y = pk2(S[16][2], S[16][3]); pw.z = 0u; pw.w = 0u;
                const bf16x8 pf = __builtin_bit_cast(bf16x8, pw);
#pragma unroll
                for (int nd = 0; nd < 4; ++nd) {
                    const u32x2 v2 = *(const u32x2*)(vb + (size_t)nd * 16 * L_ + 4 * fq);
                    u32x4 vw; vw.x = v2.x; vw.y = v2.y; vw.z = 0u; vw.w = 0u;
                    O[nd] = __builtin_amdgcn_mfma_f32_16x16x32_bf16(__builtin_bit_cast(bf16x8, vw), pf, O[nd], 0, 0, 0);
                }
            }
            bf16_t* op = p.mix + (tokb + NM + r * 64 + c) * D_ + h * 64 + fq * 4;
#pragma unroll
            for (int nd = 0; nd < 4; ++nd) {
                u32x2 pk; pk.x = pk2(O[nd][0] * rinv, O[nd][1] * rinv); pk.y = pk2(O[nd][2] * rinv, O[nd][3] * rinv);
                *(u32x2*)(op + nd * 16) = pk;
            }
        } else {
            const int mi = it - NREAL, h = mi & 15, b = mi >> 4;
            const size_t tokb = (size_t)b * L_;
            const bf16_t* qp = p.zo + (tokb + fr) * 2048 + h * 64 + fq * 8;
            const bf16x8 qf0 = *(const bf16x8*)qp, qf1 = *(const bf16x8*)(qp + 32);
            const bf16_t* kp = qp + 1024;
            const bf16x8 kf0 = *(const bf16x8*)kp, kf1 = *(const bf16x8*)(kp + 32);
            f32x4 a = (f32x4){0.f, 0.f, 0.f, 0.f};
            a = __builtin_amdgcn_mfma_f32_16x16x32_bf16(kf0, qf0, a, 0, 0, 0);
            a = __builtin_amdgcn_mfma_f32_16x16x32_bf16(kf1, qf1, a, 0, 0, 0);
            float mx = fmaxf(fmaxf(a[0], a[1]), fmaxf(a[2], a[3]));
            mx = fmaxf(mx, __shfl_xor(mx, 16)); mx = fmaxf(mx, __shfl_xor(mx, 32));
            float sum = 0.f;
#pragma unroll
            for (int jj = 0; jj < 4; ++jj) { a[jj] = __expf(a[jj] - mx); sum += a[jj]; }
            sum += __shfl_xor(sum, 16); sum += __shfl_xor(sum, 32);
            const float rinv = 1.f / sum;
            u32x4 pw; pw.x = pk2(a[0], a[1]); pw.y = pk2(a[2], a[3]); pw.z = 0u; pw.w = 0u;
            const bf16x8 pf = __builtin_bit_cast(bf16x8, pw);
            const bf16_t* vb = p.vT + ((size_t)(b * 16 + h) * 64 + fr) * L_;
            bf16_t* op = p.mix + (tokb + fr) * D_ + h * 64 + fq * 4;
#pragma unroll
            for (int nd = 0; nd < 4; ++nd) {
                const u32x2 v2 = *(const u32x2*)(vb + (size_t)nd * 16 * L_ + 4 * fq);
                u32x4 vw; vw.x = v2.x; vw.y = v2.y; vw.z = 0u; vw.w = 0u;
                f32x4 o = (f32x4){0.f, 0.f, 0.f, 0.f};
                o = __builtin_amdgcn_mfma_f32_16x16x32_bf16(__builtin_bit_cast(bf16x8, vw), pf, o, 0, 0, 0);
                u32x2 pk; pk.x = pk2(o[0] * rinv, o[1] * rinv); pk.y = pk2(o[2] * rinv, o[3] * rinv);
                *(u32x2*)(op + nd * 16) = pk;
            }
        }
    }
}

__device__ void phase_outproj(const P& p, const bf16_t* W, unsigned char* lds, int bid, int nb) {
    const int tid = threadIdx.x, lane = tid & 63, wid = tid >> 6, wr = wid >> 1, wc = wid & 1, fr = lane & 15, fq = lane >> 4;
    const int lrow = tid >> 3, lch = tid & 7;
    const int x = bid & 7, l = bid >> 3, nbx = nb >> 3;
    for (int s = l; s < 129; s += nbx) {
        const int mt = s, nt = x;
        const bf16_t* ap0 = p.mix + ((size_t)mt * 128 + lrow) * D_ + lch * 8;
        const bf16_t* bp = W + ((size_t)nt * 128 + lrow) * 1024 + lch * 8;
        f32x4 acc[4][4];
        gemm_tile<false>(ap0, ap0 + 32 * D_, ap0 + 64 * D_, ap0 + 96 * D_, bp, 1024, 1024, lds, acc);
#pragma unroll
        for (int m = 0; m < 4; ++m) {
            const size_t row = (size_t)mt * 128 + wr * 64 + m * 16 + fr;
#pragma unroll
            for (int n = 0; n < 4; ++n) {
                f32x4* hp = (f32x4*)(p.h + row * D_ + nt * 128 + wc * 64 + n * 16 + fq * 4);
                *hp = *hp + acc[m][n];
            }
        }
    }
}

__device__ void phase_tables(const P& p, int bid, int nb) {
    for (int i = bid * NTHR + threadIdx.x; i < L_ * 64; i += nb * NTHR) {
        const int pos = i >> 6, k = i & 63;
        const float inv = powf(10000.f, -(float)k / 64.f);
        const float ang = (float)pos * inv;
        p.costab[i] = cosf(ang); p.sintab[i] = sinf(ang);
    }
}

__device__ void phase_even_in(const P& p, int layer, unsigned char* lds, int bid, int nb) {
    const int tid = threadIdx.x, lane = tid & 63, wid = tid >> 6, wr = wid >> 1, wc = wid & 1, fr = lane & 15, fq = lane >> 4;
    const int lrow = tid >> 3, lch = tid & 7;
    const int x = bid & 7, l = bid >> 3, nbx = nb >> 3;
    const int j = layer >> 1;
    const bf16_t* W = p.WinE + (size_t)j * 4096 * 1024;
    for (int s = l; s < 129 * 4; s += nbx) {
        const int mt = s >> 2, nt = 4 * x + (s & 3);
        const bf16_t* ap0 = p.u + ((size_t)mt * 128 + lrow) * D_ + lch * 8;
        const bf16_t* bp = W + ((size_t)nt * 128 + lrow) * 1024 + lch * 8;
        f32x4 acc[4][4];
        gemm_tile<false>(ap0, ap0 + 32 * D_, ap0 + 64 * D_, ap0 + 96 * D_, bp, 1024, 1024, lds, acc);
        const int seg = nt >> 2;
        if (seg == 4 || seg == 5) {
            const float sc = (seg == 5) ? 0.08838834764831845f : 1.f;
#pragma unroll
            for (int m = 0; m < 4; ++m) {
                const int row = mt * 128 + wr * 64 + m * 16 + fr;
                const int pos = row % L_;
#pragma unroll
                for (int pp = 0; pp < 2; ++pp) {
                    const int idx = 32 * wc + 16 * pp + 4 * fq;
                    const f32x4 cv = *(const f32x4*)(p.costab + pos * 64 + idx), sv = *(const f32x4*)(p.sintab + pos * 64 + idx);
                    const f32x4 x1 = acc[m][2 * pp], x2 = acc[m][2 * pp + 1];
                    const f32x4 y1 = (x1 * cv - x2 * sv) * sc, y2 = (x2 * cv + x1 * sv) * sc;
                    u32x2 k1, k2; k1.x = pk2(y1[0], y1[1]); k1.y = pk2(y1[2], y1[3]); k2.x = pk2(y2[0], y2[1]); k2.y = pk2(y2[2], y2[3]);
                    bf16_t* zp = p.ze + (size_t)row * 4096 + nt * 128 + idx;
                    *(u32x2*)zp = k1; *(u32x2*)(zp + 64) = k2;
                }
            }
        } else {
#pragma unroll
            for (int m = 0; m < 4; ++m) {
                const size_t row = (size_t)mt * 128 + wr * 64 + m * 16 + fr;
#pragma unroll
                for (int n = 0; n < 4; ++n) {
                    const f32x4 v = acc[m][n];
                    u32x2 pk; pk.x = pk2(v[0], v[1]); pk.y = pk2(v[2], v[3]);
                    *(u32x2*)(p.ze + row * 4096 + nt * 128 + wc * 64 + n * 16 + fq * 4) = pk;
                }
            }
        }
    }
}

__device__ void phase_conv(const P& p, int layer, int bid, int nb) {
    const int tid = threadIdx.x, cg = tid & 127, th = tid >> 7;
    const int c0 = cg * 8;
    const float* w = p.e_conv + (size_t)(layer >> 1) * 5 * 1024 + c0;
    float wv[5][8];
#pragma unroll
    for (int jj = 0; jj < 5; ++jj) { const float4 a = *(const float4*)(w + jj * 1024), b2 = *(const float4*)(w + jj * 1024 + 4);
        wv[jj][0] = a.x; wv[jj][1] = a.y; wv[jj][2] = a.z; wv[jj][3] = a.w; wv[jj][4] = b2.x; wv[jj][5] = b2.y; wv[jj][6] = b2.z; wv[jj][7] = b2.w; }
    const float sc = (c0 >= 512) ? 0.08838834764831845f : 1.f;
    for (int it = bid; it < T_ / 16; it += nb) {
        const int tok0 = it * 16 + th * 8;
        const int b = tok0 / L_, t0 = tok0 - b * L_;
        float win[5][8];
#pragma unroll
        for (int r = 0; r < 4; ++r) {
            const int tt = t0 - 2 + r;
            u32x4 raw = (u32x4){0u, 0u, 0u, 0u};
            if (tt >= 0 && tt < L_) raw = *(const u32x4*)(p.ze + ((size_t)b * L_ + tt) * 4096 + c0);
            win[r + 1][0] = bflo(raw.x); win[r + 1][1] = bfhi(raw.x); win[r + 1][2] = bflo(raw.y); win[r + 1][3] = bfhi(raw.y);
            win[r + 1][4] = bflo(raw.z); win[r + 1][5] = bfhi(raw.z); win[r + 1][6] = bflo(raw.w); win[r + 1][7] = bfhi(raw.w);
        }
#pragma unroll
        for (int i = 0; i < 8; ++i) {
#pragma unroll
            for (int r = 0; r < 4; ++r)
#pragma unroll
                for (int c = 0; c < 8; ++c) win[r][c] = win[r + 1][c];
            const int tt = t0 + i + 2;
            u32x4 raw = (u32x4){0u, 0u, 0u, 0u};
            if (tt < L_) raw = *(const u32x4*)(p.ze + ((size_t)b * L_ + tt) * 4096 + c0);
            win[4][0] = bflo(raw.x); win[4][1] = bfhi(raw.x); win[4][2] = bflo(raw.y); win[4][3] = bfhi(raw.y);
            win[4][4] = bflo(raw.z); win[4][5] = bfhi(raw.z); win[4][6] = bflo(raw.w); win[4][7] = bfhi(raw.w);
            float o[8];
#pragma unroll
            for (int c = 0; c < 8; ++c) {
                float s = 0.f;
#pragma unroll
                for (int jj = 0; jj < 5; ++jj) s += wv[jj][c] * win[jj][c];
                o[c] = s / (1.f + __expf(-s)) * sc;
            }
            u32x4 pk; pk.x = pk2(o[0], o[1]); pk.y = pk2(o[2], o[3]); pk.z = pk2(o[4], o[5]); pk.w = pk2(o[6], o[7]);
            *(u32x4*)(p.qc + (size_t)(tok0 + i) * 1024 + c0) = pk;
        }
    }
}

#define SC_QS 0
#define SC_KS 17408
#define SC_KT 34816
#define SC_VT 53248
#define SC_VW 57856
#define SC_CT 62464
#define SC_NS 71168
#define SC_KW 71680
template <bool RET>
__device__ void scan_item(const P& p, int layer, unsigned char* lds, int b, int hh, int dir, int eq) {
    const int tid = threadIdx.x, lane = tid & 63, w = tid >> 6, fr = lane & 15, fq = lane >> 4;
    const size_t tokb = (size_t)b * L_;
    const bf16_t* qsrc = RET ? (p.ze + 2048 + hh * 128) : (p.qc + hh * 128);
    const bf16_t* ksrc = RET ? (p.ze + 2560 + hh * 128) : (p.qc + 512 + hh * 128);
    const bf16_t* vsrc = p.ze + (RET ? 3072 : 1024) + hh * 128 + eq * 32;
    const int qld = RET ? 4096 : 1024;
    const float lgam = RET ? logsigmoidf_(p.e_decay[(layer >> 1) * 8 + dir * 4 + hh]) : 0.f;
    const int lr = tid >> 4, lc = tid & 15;
    const int vr = tid >> 2, vc = tid & 3;
    u32x4 rq[4], rk[4], rv; float rli = 0.f, rlf = 0.f;
    auto tok_of = [&](int n, int pp) -> int {
        if (n == 0) return pp < 48 ? -1 : pp - 48;
        const int rr = 64 * (n - 1) + pp;
        return NM + (dir ? 2047 - rr : rr);
    };
    auto load_chunk = [&](int n) {
#pragma unroll
        for (int i = 0; i < 4; ++i) {
            const int t = tok_of(n, lr + 16 * i);
            rq[i] = (u32x4){0u, 0u, 0u, 0u}; rk[i] = (u32x4){0u, 0u, 0u, 0u};
            if (t >= 0) { rq[i] = *(const u32x4*)(qsrc + (tokb + t) * qld + lc * 8); rk[i] = *(const u32x4*)(ksrc + (tokb + t) * qld + lc * 8); }
        }
        { const int t = tok_of(n, vr); rv = (u32x4){0u, 0u, 0u, 0u}; if (t >= 0) rv = *(const u32x4*)(vsrc + (tokb + t) * 4096 + vc * 8); }
        if (!RET) {
            const int t = tok_of(n, lane); rli = 0.f; rlf = 0.f;
            if (t >= 0) { const float* gp = p.gts + (tokb + t) * 16 + dir * 8 + hh; rli = gp[0]; rlf = logsigmoidf_(gp[4]); }
        }
    };
    f32x4 Cacc[2][2];
#pragma unroll
    for (int a = 0; a < 2; ++a)
#pragma unroll
        for (int c = 0; c < 2; ++c) Cacc[a][c] = (f32x4){0.f, 0.f, 0.f, 0.f};
    float m_prev = 0.f, w_state = 0.f, nsum = 0.f;
    load_chunk(0);
    for (int n = 0; n < 33; ++n) {
        float a_, bm_, winter_, kw_, em_, m_new;
        {
            const float lf = RET ? lgam : rlf, li = RET ? 0.f : rli;
            float bb = lf;
#pragma unroll
            for (int o = 1; o < 64; o <<= 1) { const float t = __shfl_up(bb, o); if (lane >= o) bb += t; }
            a_ = li - bb;
            float mm;
            if (RET) { mm = 0.f; }
            else {
                float cm = a_;
#pragma unroll
                for (int o = 1; o < 64; o <<= 1) { const float t = __shfl_up(cm, o); if (lane >= o) cm = fmaxf(cm, t); }
                mm = bb + fmaxf(m_prev, cm);
            }
            const float b63 = __shfl(bb, 63); m_new = __shfl(mm, 63);
            bm_ = bb - mm; winter_ = __expf(bb + m_prev - mm); kw_ = __expf(b63 + a_ - m_new); em_ = __expf(-mm);
#pragma unroll
            for (int mt = 0; mt < 2; ++mt)
#pragma unroll
                for (int ne = 0; ne < 2; ++ne) {
                    const f32x4 v = Cacc[mt][ne];
                    u32x2 pk; pk.x = pk2(v[0], v[1]); pk.y = pk2(v[2], v[3]);
                    *(u32x2*)(lds + SC_CT + (16 * ne + fr) * 272 + (32 * w + 16 * mt + 4 * fq) * 2) = pk;
                }
            if ((tid & 1) == 0) { float* ns = (float*)(lds + SC_NS) + (tid >> 1); *ns = (n == 0) ? 0.f : (w_state * *ns + nsum); }
            w_state = __expf(b63 + m_prev - m_new);
#pragma unroll
            for (int i = 0; i < 4; ++i) {
                const int row = lr + 16 * i;
                *(u32x4*)(lds + SC_QS + row * 272 + lc * 16) = rq[i];
                *(u32x4*)(lds + SC_KS + row * 272 + lc * 16) = rk[i];
                const unsigned kwv[4] = {rk[i].x, rk[i].y, rk[i].z, rk[i].w};
#pragma unroll
                for (int c = 0; c < 4; ++c) {
                    *(bf16_t*)(lds + SC_KT + (lc * 8 + 2 * c) * 144 + row * 2) = (bf16_t)(kwv[c] & 0xffffu);
                    *(bf16_t*)(lds + SC_KT + (lc * 8 + 2 * c + 1) * 144 + row * 2) = (bf16_t)(kwv[c] >> 16);
                }
            }
            {
                const float kwr = __shfl(kw_, vr & 63);
                const unsigned vv[4] = {rv.x, rv.y, rv.z, rv.w};
#pragma unroll
                for (int c = 0; c < 4; ++c) {
                    const float lo = bflo(vv[c]), hi = bfhi(vv[c]);
                    const int e0 = vc * 8 + 2 * c;
                    *(bf16_t*)(lds + SC_VT + e0 * 144 + vr * 2) = (bf16_t)(vv[c] & 0xffffu);
                    *(bf16_t*)(lds + SC_VT + (e0 + 1) * 144 + vr * 2) = (bf16_t)(vv[c] >> 16);
                    *(bf16_t*)(lds + SC_VW + e0 * 144 + vr * 2) = (bf16_t)f2bf(lo * kwr);
                    *(bf16_t*)(lds + SC_VW + (e0 + 1) * 144 + vr * 2) = (bf16_t)f2bf(hi * kwr);
                }
                if (w == 0) ((float*)(lds + SC_KW))[lane] = kw_;
            }
        }
        __syncthreads();
        if (n + 1 < 33) load_chunk(n + 1);
        const int qrow = 16 * w + fr;
        bf16x8 qf[4];
#pragma unroll
        for (int ks = 0; ks < 4; ++ks) qf[ks] = *(const bf16x8*)(lds + SC_QS + qrow * 272 + (32 * ks + 8 * fq) * 2);
        f32x4 S[4];
#pragma unroll
        for (int nn = 0; nn < 4; ++nn) {
            const int krow = 32 * (nn >> 1) + 8 * (fr >> 2) + 4 * (nn & 1) + (fr & 3);
            f32x4 acc = (f32x4){0.f, 0.f, 0.f, 0.f};
#pragma unroll
            for (int ks = 0; ks < 4; ++ks) {
                const bf16x8 kf = *(const bf16x8*)(lds + SC_KS + krow * 272 + (32 * ks + 8 * fq) * 2);
                acc = __builtin_amdgcn_mfma_f32_16x16x32_bf16(kf, qf[ks], acc, 0, 0, 0);
            }
            S[nn] = acc;
        }
        const float bm_q = __shfl(bm_, qrow), winter_q = __shfl(winter_, qrow), em_q = __shfl(em_, qrow);
        float rsum = 0.f;
#pragma unroll
        for (int nn = 0; nn < 4; ++nn)
#pragma unroll
            for (int jj = 0; jj < 4; ++jj) {
                const int key = 32 * (nn >> 1) + 8 * fq + 4 * (nn & 1) + jj;
                const float ak = __shfl(a_, key);
                const float dv = __expf(bm_q + ak);
                const float sv = (key <= qrow) ? S[nn][jj] * dv : 0.f;
                S[nn][jj] = sv; rsum += sv;
            }
        f32x4 O[2], OC[2];
#pragma unroll
        for (int ne = 0; ne < 2; ++ne) { O[ne] = (f32x4){0.f, 0.f, 0.f, 0.f}; OC[ne] = (f32x4){0.f, 0.f, 0.f, 0.f}; }
#pragma unroll
        for (int t = 0; t < 2; ++t) {
            u32x4 pw; pw.x = pk2(S[2 * t][0], S[2 * t][1]); pw.y = pk2(S[2 * t][2], S[2 * t][3]); pw.z = pk2(S[2 * t + 1][0], S[2 * t + 1][1]); pw.w = pk2(S[2 * t + 1][2], S[2 * t + 1][3]);
            const bf16x8 pf = __builtin_bit_cast(bf16x8, pw);
#pragma unroll
            for (int ne = 0; ne < 2; ++ne) {
                const bf16x8 vf = *(const bf16x8*)(lds + SC_VT + (16 * ne + fr) * 144 + (32 * t + 8 * fq) * 2);
                O[ne] = __builtin_amdgcn_mfma_f32_16x16x32_bf16(vf, pf, O[ne], 0, 0, 0);
            }
        }
#pragma unroll
        for (int ks = 0; ks < 4; ++ks)
#pragma unroll
            for (int ne = 0; ne < 2; ++ne) {
                const bf16x8 cf = *(const bf16x8*)(lds + SC_CT + (16 * ne + fr) * 272 + (32 * ks + 8 * fq) * 2);
                OC[ne] = __builtin_amdgcn_mfma_f32_16x16x32_bf16(cf, qf[ks], OC[ne], 0, 0, 0);
            }
        float scC = winter_q, scS = 1.f;
        if (!RET) {
            float qn = 0.f;
#pragma unroll
            for (int ks = 0; ks < 4; ++ks) {
                const f32x4 n0 = *(const f32x4*)(lds + SC_NS + (32 * ks + 8 * fq) * 4), n1 = *(const f32x4*)(lds + SC_NS + (32 * ks + 8 * fq + 4) * 4);
                const u32x4 qw = __builtin_bit_cast(u32x4, qf[ks]);
                qn += bflo(qw.x) * n0[0] + bfhi(qw.x) * n0[1] + bflo(qw.y) * n0[2] + bfhi(qw.y) * n0[3]
                    + bflo(qw.z) * n1[0] + bfhi(qw.z) * n1[1] + bflo(qw.w) * n1[2] + bfhi(qw.w) * n1[3];
            }
            qn += __shfl_xor(qn, 16); qn += __shfl_xor(qn, 32);
            rsum += __shfl_xor(rsum, 16); rsum += __shfl_xor(rsum, 32);
            const float den = winter_q * qn + rsum;
            const float rden = 1.f / fmaxf(fabsf(den), em_q);
            scC = winter_q * rden; scS = rden;
        }
        {
            const int t = tok_of(n, qrow);
            if (t >= 0) {
                bf16_t* op = p.osc + ((size_t)dir * T_ + tokb + t) * 1024 + (RET ? 512 : 0) + hh * 128 + eq * 32 + 4 * fq;
#pragma unroll
                for (int ne = 0; ne < 2; ++ne) {
                    const f32x4 o = OC[ne] * scC + O[ne] * scS;
                    u32x2 pk; pk.x = pk2(o[0], o[1]); pk.y = pk2(o[2], o[3]);
                    *(u32x2*)(op + 16 * ne) = pk;
                }
            }
        }
#pragma unroll
        for (int mt = 0; mt < 2; ++mt)
#pragma unroll
            for (int ne = 0; ne < 2; ++ne) Cacc[mt][ne] = Cacc[mt][ne] * w_state;
#pragma unroll
        for (int t = 0; t < 2; ++t) {
            bf16x8 kf[2], vf[2];
#pragma unroll
            for (int mt = 0; mt < 2; ++mt) kf[mt] = *(const bf16x8*)(lds + SC_KT + (32 * w + 16 * mt + fr) * 144 + (32 * t + 8 * fq) * 2);
#pragma unroll
            for (int ne = 0; ne < 2; ++ne) vf[ne] = *(const bf16x8*)(lds + SC_VW + (16 * ne + fr) * 144 + (32 * t + 8 * fq) * 2);
#pragma unroll
            for (int mt = 0; mt < 2; ++mt)
#pragma unroll
                for (int ne = 0; ne < 2; ++ne) Cacc[mt][ne] = __builtin_amdgcn_mfma_f32_16x16x32_bf16(kf[mt], vf[ne], Cacc[mt][ne], 0, 0, 0);
        }
        if (!RET) {
            const int d = tid >> 1, half = tid & 1;
            float s = 0.f;
#pragma unroll
            for (int i = 0; i < 4; ++i) {
                const u32x4 kk = *(const u32x4*)(lds + SC_KT + d * 144 + (32 * half + 8 * i) * 2);
                const f32x4 w0 = *(const f32x4*)(lds + SC_KW + (32 * half + 8 * i) * 4), w1 = *(const f32x4*)(lds + SC_KW + (32 * half + 8 * i + 4) * 4);
                s += bflo(kk.x) * w0[0] + bfhi(kk.x) * w0[1] + bflo(kk.y) * w0[2] + bfhi(kk.y) * w0[3]
                   + bflo(kk.z) * w1[0] + bfhi(kk.z) * w1[1] + bflo(kk.w) * w1[2] + bfhi(kk.w) * w1[3];
            }
            s += __shfl_xor(s, 1);
            nsum = s;
        }
        m_prev = m_new;
        __syncthreads();
    }
}
__device__ void phase_scan(const P& p, int layer, unsigned char* lds, int bid, int nb) {
    for (int it = bid; it < 512; it += nb) {
        const int x = it & 7, y = it >> 3;
        const int ch = (y >> 2) * 8 + x, eq = y & 3;
        const int type = ch >> 6, b = (ch >> 3) & 7, hh = (ch >> 1) & 3, dir = ch & 1;
        if (type == 0) scan_item<false>(p, layer, lds, b, hh, dir, eq);
        else scan_item<true>(p, layer, lds, b, hh, dir, eq);
    }
}

__device__ void phase_mixfin(const P& p, int layer, int bid, int nb) {
    const int tid = threadIdx.x, j = layer >> 1;
    const int f = tid * 4;
    const bool ism = f < 512;
    const float4 g = ism ? *(const float4*)(p.e_mg + j * 512 + f) : *(const float4*)(p.e_rg + j * 512 + (f - 512));
    const int gcol = ism ? (1536 + f) : (3584 + (f - 512));
    for (int tok = bid; tok < T_; tok += nb) {
        const u32x2 a = *(const u32x2*)(p.osc + (size_t)tok * 1024 + f), c = *(const u32x2*)(p.osc + ((size_t)T_ + tok) * 1024 + f);
        const u32x2 gz = *(const u32x2*)(p.ze + (size_t)tok * 4096 + gcol);
        float v[4] = {bflo(a.x) + bflo(c.x), bfhi(a.x) + bfhi(c.x), bflo(a.y) + bflo(c.y), bfhi(a.y) + bfhi(c.y)};
        const float gzv[4] = {bflo(gz.x), bfhi(gz.x), bflo(gz.y), bfhi(gz.y)};
        float ss = v[0] * v[0] + v[1] * v[1] + v[2] * v[2] + v[3] * v[3];
        for (int o = 16; o > 0; o >>= 1) ss += __shfl_xor(ss, o);
        const float r = rsqrtf(ss * (1.f / 128.f) + 1e-6f);
        const float gv[4] = {g.x, g.y, g.z, g.w};
        float o4[4];
#pragma unroll
        for (int c2 = 0; c2 < 4; ++c2) {
            const float sg = 1.f / (1.f + __expf(-gzv[c2]));
            const float gate = ism ? sg : gzv[c2] * sg;
            o4[c2] = gate * (v[c2] * r * gv[c2]);
        }
        u32x2 pk; pk.x = pk2(o4[0], o4[1]); pk.y = pk2(o4[2], o4[3]);
        *(u32x2*)(p.mix + (size_t)tok * 1024 + f) = pk;
    }
}

__device__ void phase_cn(const P& p, int nl, unsigned char* lds, int bid, int nb) {
    float* red = (float*)lds;
    float* part = (float*)lds + 16;
    const int tid = threadIdx.x;
    const bool even = (nl & 1) == 0;
    const float4 gg = (nl < 4) ? ((const float4*)(p.attn_g + nl * D_))[tid] : make_float4(0.f, 0.f, 0.f, 0.f);
    const float* wg = p.e_win + (size_t)(nl >> 1) * D_ * EVEN_IN + 2048;
    const float* gb = p.e_gb + (nl >> 1) * 16;
    for (int tok = bid; tok < T_; tok += nb) {
        const int b = tok / L_, t = tok - b * L_;
        float4 v;
        if (nl == 0) {
            const float* src = t < NM ? p.meta + (size_t)t * D_ : p.x + ((size_t)b * 2048 + (t - NM)) * D_;
            v = ((const float4*)src)[tid];
        } else {
            v = ((const float4*)(p.h + (size_t)tok * D_))[tid];
            for (int e = 0; e < 16; ++e) {
                const int s = p.sel[(size_t)tok * 16 + e];
                if (s >= 0) {
                    const size_t slot = (size_t)(e * B_ + b) * CAP + s;
                    const u32x2 y = *(const u32x2*)(p.ys + slot * D_ + tid * 4);
                    v.x += bflo(y.x); v.y += bfhi(y.x); v.z += bflo(y.y); v.w += bfhi(y.y);
                }
            }
        }
        if (nl == 4) {
            if (t >= NM) ((float4*)(p.out + ((size_t)b * 2048 + (t - NM)) * D_))[tid] = v;
            continue;
        }
        ((float4*)(p.h + (size_t)tok * D_))[tid] = v;
        float s = v.x * v.x + v.y * v.y + v.z * v.z + v.w * v.w;
        s = block_sum256(s, red);
        const float r = rsqrtf(s * (1.f / D_) + 1e-6f);
        const float uu[4] = {v.x * r * gg.x, v.y * r * gg.y, v.z * r * gg.z, v.w * r * gg.w};
        u32x2 pk; pk.x = pk2(uu[0], uu[1]); pk.y = pk2(uu[2], uu[3]);
        *(u32x2*)(p.u + (size_t)tok * D_ + tid * 4) = pk;
        if (even) {
            float lg[16];
#pragma unroll
            for (int e = 0; e < 16; ++e) lg[e] = 0.f;
#pragma unroll
            for (int j = 0; j < 4; ++j) {
                const float4* w = (const float4*)(wg + (size_t)(tid * 4 + j) * EVEN_IN);
#pragma unroll
                for (int e4 = 0; e4 < 4; ++e4) { const float4 ww = w[e4]; lg[e4 * 4 + 0] += uu[j] * ww.x; lg[e4 * 4 + 1] += uu[j] * ww.y; lg[e4 * 4 + 2] += uu[j] * ww.z; lg[e4 * 4 + 3] += uu[j] * ww.w; }
            }
#pragma unroll
            for (int e = 0; e < 16; ++e) { float x = lg[e]; for (int o = 32; o > 0; o >>= 1) x += __shfl_xor(x, o); lg[e] = x; }
            if ((tid & 63) == 0) {
#pragma unroll
                for (int e = 0; e < 16; ++e) part[(tid >> 6) * 16 + e] = lg[e];
            }
            __syncthreads();
            if (tid < 16) p.gts[(size_t)tok * 16 + tid] = part[tid] + part[16 + tid] + part[32 + tid] + part[48 + tid] + gb[tid];
        }
    }
}

enum { PH_CONVERT = 0, PH_ROUTER, PH_TOPK, PH_GATEUP, PH_DOWN, PH_COMBINE, PH_NORM, PH_ODD_IN, PH_NATTEN, PH_OUT_ODD, PH_OUT_EVEN, PH_EVEN_IN, PH_CONV, PH_SCAN, PH_MIXFIN, PH_CN };
__global__ void __launch_bounds__(NTHR, 2) k_phase(P p, int phase, int layer, int a0, int a1) {
    extern __shared__ __attribute__((aligned(16))) unsigned char lds[];
    const int bid = blockIdx.x, nb = gridDim.x;
    switch (phase) {
        case PH_CONVERT: phase_tables(p, bid, nb); phase_convert(p, lds, bid, nb, a0, a1); break;
        case PH_ROUTER:  phase_router(p, layer, lds, bid, nb); break;
        case PH_TOPK:    phase_topk(p, lds, bid, nb); break;
        case PH_GATEUP:  phase_gateup(p, layer, lds, bid, nb); break;
        case PH_DOWN:    phase_down(p, layer, lds, bid, nb); break;
        case PH_COMBINE: phase_combine(p, lds, bid, nb); break;
        case PH_NORM:    phase_norm(p, layer, lds, bid, nb); break;
        case PH_ODD_IN:  phase_odd_in(p, layer, lds, bid, nb); break;
        case PH_NATTEN:  phase_natten(p, layer, lds, bid, nb); break;
        case PH_OUT_ODD: phase_outproj(p, p.WoutO + (size_t)(layer >> 1) * 1024 * 1024, lds, bid, nb); break;
        case PH_OUT_EVEN: phase_outproj(p, p.WoutE + (size_t)(layer >> 1) * 1024 * 1024, lds, bid, nb); break;
        case PH_EVEN_IN: phase_even_in(p, layer, lds, bid, nb); break;
        case PH_CONV:    phase_conv(p, layer, bid, nb); break;
        case PH_SCAN:    phase_scan(p, layer, lds, bid, nb); break;
        case PH_MIXFIN:  phase_mixfin(p, layer, bid, nb); break;
        case PH_CN:      phase_cn(p, layer, lds, bid, nb); break;
        default: break;
    }
}

static inline size_t al256(size_t x) { return (x + 255) & ~(size_t)255; }

extern "C" void kernel_launch(void* const* d_in, const int* in_sizes, int n_in, void* d_out, int out_size, void* d_ws, size_t ws_size, hipStream_t stream) {
    P p; memset(&p, 0, sizeof(p));
    p.x = (const float*)d_in[0]; p.meta = (const float*)d_in[1]; p.attn_g = (const float*)d_in[2]; p.ffn_g = (const float*)d_in[3];
    p.e_win = (const float*)d_in[4]; p.e_conv = (const float*)d_in[5]; p.e_gb = (const float*)d_in[6]; p.e_mg = (const float*)d_in[7];
    p.e_decay = (const float*)d_in[8]; p.e_rg = (const float*)d_in[9]; p.e_wout = (const float*)d_in[10]; p.o_win = (const float*)d_in[11];
    p.o_qg = (const float*)d_in[12]; p.o_kg = (const float*)d_in[13]; p.o_rpb = (const float*)d_in[14]; p.o_wout = (const float*)d_in[15];
    p.router_w = (const float*)d_in[16]; p.w_gate = (const float*)d_in[17]; p.w_up = (const float*)d_in[18]; p.w_down = (const float*)d_in[19];
    p.out = (float*)d_out;

    unsigned char* wb = (unsigned char*)d_ws;
    size_t o = 0;
    p.bar = (unsigned*)(wb + o); o += 16384;
    p.Wgu = (bf16_t*)(wb + o); o += al256((size_t)4 * 16 * 2048 * 1024 * 2);
    p.Wd = (bf16_t*)(wb + o);  o += al256((size_t)4 * 16 * 1024 * 1024 * 2);
    p.WinE = (bf16_t*)(wb + o); o += al256((size_t)2 * 4096 * 1024 * 2);
    p.WinO = (bf16_t*)(wb + o); o += al256((size_t)2 * 3072 * 1024 * 2);
    p.WoutE = (bf16_t*)(wb + o); o += al256((size_t)2 * 1024 * 1024 * 2);
    p.WoutO = (bf16_t*)(wb + o); o += al256((size_t)2 * 1024 * 1024 * 2);
    p.h = (float*)(wb + o);    o += al256((size_t)T_ * D_ * 4);
    p.u = (bf16_t*)(wb + o);   o += al256((size_t)T_ * D_ * 2);
    p.ze = (bf16_t*)(wb + o);  o += al256((size_t)T_ * 4096 * 2);
    p.zo = p.ze;
    p.vT = p.ze + (size_t)T_ * 2048;
    p.qc = (bf16_t*)(wb + o);  o += al256((size_t)T_ * D_ * 2);
    p.osc = (bf16_t*)(wb + o); o += al256((size_t)2 * T_ * D_ * 2);
    p.hdn = p.osc;
    p.ys = p.ze;
    p.mix = (bf16_t*)(wb + o); o += al256((size_t)T_ * D_ * 2);
    p.gts = (float*)(wb + o);  o += al256((size_t)T_ * 16 * 4);
    p.aff = (float*)(wb + o);  o += al256((size_t)T_ * 16 * 4);
    p.gate = (float*)(wb + o); o += al256((size_t)NE * ESLOTS * 4);
    p.idx = (int*)(wb + o);    o += al256((size_t)NE * ESLOTS * 4);
    p.sel = (int*)(wb + o);    o += al256((size_t)T_ * 16 * 4);
    p.costab = (float*)(wb + o); o += al256((size_t)L_ * 64 * 4);
    p.sintab = (float*)(wb + o); o += al256((size_t)L_ * 64 * 4);
    if (o > ws_size) return;

    static bool attr_done = false;
    if (!attr_done) { (void)hipFuncSetAttribute((const void*)k_phase, hipFuncAttributeMaxDynamicSharedMemorySize, LDS_BYTES); attr_done = true; }
    const int NB = 512;
#define PHASE(ph, layer, a0, a1) hipLaunchKernelGGL(k_phase, dim3(NB), dim3(NTHR), LDS_BYTES, stream, p, (int)(ph), (int)(layer), (int)(a0), (int)(a1))

    PHASE(PH_CONVERT, 0, 0, N_CONV_ROWTILES);
    PHASE(PH_CN, 0, 0, 0);
    for (int layer = 0; layer < 4; ++layer) {
        if ((layer & 1) == 0) {
            PHASE(PH_EVEN_IN, layer, 0, 0);
            PHASE(PH_CONV, layer, 0, 0);
            PHASE(PH_SCAN, layer, 0, 0);
            PHASE(PH_MIXFIN, layer, 0, 0);
            PHASE(PH_OUT_EVEN, layer, 0, 0);
        } else {
            PHASE(PH_ODD_IN, layer, 0, 0);
            PHASE(PH_NATTEN, layer, 0, 0);
            PHASE(PH_OUT_ODD, layer, 0, 0);
        }
        PHASE(PH_ROUTER, layer, 0, 0);
        PHASE(PH_TOPK, layer, 0, 0);
        PHASE(PH_GATEUP, layer, 0, 0);
        PHASE(PH_DOWN, layer, 0, 0);
        PHASE(PH_CN, layer + 1, 0, 0);
    }
}
```

```cpp
#include <hip/hip_runtime.h>
#include <stdint.h>
#include <string.h>

#ifndef PROBE_GEMM
#define PROBE_GEMM 0
#endif
#ifndef PROBE_SCAN
#define PROBE_SCAN 0
#endif
#ifndef PROBE_CONVERT
#define PROBE_CONVERT 0
#endif
#ifndef PROBE_NATTEN
#define PROBE_NATTEN 0
#endif
#ifndef PROBE_MISC
#define PROBE_MISC 0
#endif
#ifndef PROBE_MIXFIN
#define PROBE_MIXFIN 0
#endif
#ifndef PROBE_ROUTER
#define PROBE_ROUTER 0
#endif
#ifndef PROBE_TOPK
#define PROBE_TOPK 0
#endif
#ifndef PROBE_BARRIER
#define PROBE_BARRIER 0
#endif
#ifndef PROBE_CN
#define PROBE_CN 0
#endif
#ifndef PROBE_DMA
#define PROBE_DMA 0
#endif
#ifndef PROBE_STAGE
#define PROBE_STAGE 0
#endif
#ifndef PROBE_KLOOP
#define PROBE_KLOOP 0
#endif
#ifndef PROBE_EPI
#define PROBE_EPI 0
#endif
#define B_ 8
#define L_ 2064
#define T_ (B_ * L_)
#define D_ 1024
#define NM 16
#define EVEN_IN 4112
#define ODD_IN 3072
#define NE 16
#define CAP 258
#define NG (B_ * NE)

__device__ __forceinline__ float block_sum256(float v, float* red) {
    for (int o = 32; o > 0; o >>= 1) v += __shfl_xor(v, o);
    __syncthreads();
    if ((threadIdx.x & 63) == 0) red[threadIdx.x >> 6] = v;
    __syncthreads();
    return red[0] + red[1] + red[2] + red[3];
}
__device__ __forceinline__ float sigmoidf_(float x) { return 1.f / (1.f + expf(-x)); }
__device__ __forceinline__ float siluf_(float x) { return x / (1.f + expf(-x)); }
__device__ __forceinline__ float logsigmoidf_(float x) { return fminf(x, 0.f) - log1pf(expf(-fabsf(x))); }


typedef unsigned short bf16_t;
typedef short bf16x8 __attribute__((ext_vector_type(8)));
typedef float f32x4 __attribute__((ext_vector_type(4)));
typedef unsigned u32x4 __attribute__((ext_vector_type(4)));
typedef unsigned u32x2 __attribute__((ext_vector_type(2)));

#define NTHR 256
#define ESLOTS 2064
#define LDS_BYTES (80 * 1024)

__device__ __forceinline__ unsigned f2bf(float f) { unsigned u = __builtin_bit_cast(unsigned, f); return (u + 0x7fffu + ((u >> 16) & 1u)) >> 16; }
__device__ __forceinline__ unsigned pk2(float lo, float hi) { return f2bf(lo) | (f2bf(hi) << 16); }
__device__ __forceinline__ float bf2f(unsigned short b) { return __builtin_bit_cast(float, (unsigned)b << 16); }
__device__ __forceinline__ float bflo(unsigned w) { return __builtin_bit_cast(float, w << 16); }
__device__ __forceinline__ float bfhi(unsigned w) { return __builtin_bit_cast(float, w & 0xffff0000u); }

#define AL256(x) (((x) + 255) & ~(size_t)255)
constexpr size_t OFF_BAR = 0;
constexpr size_t OFF_WGU = 16384;
constexpr size_t OFF_WD = OFF_WGU + AL256((size_t)4 * 16 * 2048 * 1024 * 2);
constexpr size_t OFF_WINE = OFF_WD + AL256((size_t)4 * 16 * 1024 * 1024 * 2);
constexpr size_t OFF_WINO = OFF_WINE + AL256((size_t)2 * 4096 * 1024 * 2);
constexpr size_t OFF_WOUTE = OFF_WINO + AL256((size_t)2 * 3072 * 1024 * 2);
constexpr size_t OFF_WOUTO = OFF_WOUTE + AL256((size_t)2 * 1024 * 1024 * 2);
constexpr size_t OFF_H = OFF_WOUTO + AL256((size_t)2 * 1024 * 1024 * 2);
constexpr size_t OFF_U = OFF_H + AL256((size_t)T_ * D_ * 4);
constexpr size_t OFF_ZE = OFF_U + AL256((size_t)T_ * D_ * 2);
constexpr size_t OFF_QC = OFF_ZE + AL256((size_t)T_ * 4096 * 2);
constexpr size_t OFF_OSC = OFF_QC + AL256((size_t)T_ * D_ * 2);
constexpr size_t OFF_MIX = OFF_OSC + AL256((size_t)2 * T_ * D_ * 2);
constexpr size_t OFF_GTS = OFF_MIX + AL256((size_t)T_ * D_ * 2);
constexpr size_t OFF_AFF = OFF_GTS + AL256((size_t)T_ * 16 * 4);
constexpr size_t OFF_GATE = OFF_AFF + AL256((size_t)T_ * 16 * 4);
constexpr size_t OFF_IDX = OFF_GATE + AL256((size_t)NE * ESLOTS * 4);
constexpr size_t OFF_SEL = OFF_IDX + AL256((size_t)NE * ESLOTS * 4);
constexpr size_t OFF_COS = OFF_SEL + AL256((size_t)T_ * 16 * 4);
constexpr size_t OFF_SIN = OFF_COS + AL256((size_t)L_ * 64 * 4);
constexpr size_t WS_NEEDED = OFF_SIN + AL256((size_t)L_ * 64 * 4);

__device__ __forceinline__ int opaque_tid() { int t = threadIdx.x; asm volatile("" : "+v"(t)); return t; }

struct P {
    const float *x, *meta, *attn_g, *ffn_g, *e_win, *e_conv, *e_gb, *e_mg, *e_decay, *e_rg, *e_wout, *o_win, *o_qg, *o_kg, *o_rpb, *o_wout, *router_w, *w_gate, *w_up, *w_down;
    float* out;
    unsigned char* ws;
    __device__ __forceinline__ unsigned* bar() const { return (unsigned*)(ws + OFF_BAR); }
    __device__ __forceinline__ bf16_t* Wgu() const { return (bf16_t*)(ws + OFF_WGU); }
    __device__ __forceinline__ bf16_t* Wd() const { return (bf16_t*)(ws + OFF_WD); }
    __device__ __forceinline__ bf16_t* WinE() const { return (bf16_t*)(ws + OFF_WINE); }
    __device__ __forceinline__ bf16_t* WinO() const { return (bf16_t*)(ws + OFF_WINO); }
    __device__ __forceinline__ bf16_t* WoutE() const { return (bf16_t*)(ws + OFF_WOUTE); }
    __device__ __forceinline__ bf16_t* WoutO() const { return (bf16_t*)(ws + OFF_WOUTO); }
    __device__ __forceinline__ bf16_t* h() const { return (bf16_t*)(ws + OFF_H); }
    __device__ __forceinline__ bf16_t* u() const { return (bf16_t*)(ws + OFF_U); }
    __device__ __forceinline__ bf16_t* ze() const { return (bf16_t*)(ws + OFF_ZE); }
    __device__ __forceinline__ bf16_t* zo() const { return (bf16_t*)(ws + OFF_ZE); }
    __device__ __forceinline__ bf16_t* vT() const { return (bf16_t*)(ws + OFF_ZE) + (size_t)T_ * 2048; }
    __device__ __forceinline__ bf16_t* ys() const { return (bf16_t*)(ws + OFF_ZE); }
    __device__ __forceinline__ bf16_t* qc() const { return (bf16_t*)(ws + OFF_QC); }
    __device__ __forceinline__ bf16_t* osc() const { return (bf16_t*)(ws + OFF_OSC); }
    __device__ __forceinline__ bf16_t* hdn() const { return (bf16_t*)(ws + OFF_OSC); }
    __device__ __forceinline__ bf16_t* mix() const { return (bf16_t*)(ws + OFF_MIX); }
    __device__ __forceinline__ float* gts() const { return (float*)(ws + OFF_GTS); }
    __device__ __forceinline__ float* aff() const { return (float*)(ws + OFF_AFF); }
    __device__ __forceinline__ float* gate() const { return (float*)(ws + OFF_GATE); }
    __device__ __forceinline__ int* idx() const { return (int*)(ws + OFF_IDX); }
    __device__ __forceinline__ int* sel() const { return (int*)(ws + OFF_SEL); }
    __device__ __forceinline__ float* costab() const { return (float*)(ws + OFF_COS); }
    __device__ __forceinline__ float* sintab() const { return (float*)(ws + OFF_SIN); }
};

__device__ __forceinline__ void conv_desc(const P& p, int rt, const float*& src_base, size_t& le_off, int& ld, bf16_t*& dst, int& kind, int& n0) {
    le_off = 0;
    if (rt < 2048) { const int le = rt >> 5, t = rt & 31; kind = 1; ld = 1024; src_base = p.w_gate; le_off = (size_t)le * 1024 * 1024; dst = p.Wgu() + (size_t)le * 2048 * 1024; n0 = t * 64; return; }
    rt -= 2048;
    if (rt < 1024) { const int le = rt >> 4, t = rt & 15; kind = 3; ld = 1024; src_base = p.w_down + (size_t)le * 1024 * 1024; dst = p.Wd() + (size_t)le * 1024 * 1024; n0 = t * 64; return; }
    rt -= 1024;
    if (rt < 128) { const int j = rt >> 6, t = rt & 63; kind = 2; ld = EVEN_IN; src_base = p.e_win + (size_t)j * 1024 * EVEN_IN; dst = p.WinE() + (size_t)j * 4096 * 1024; n0 = t * 64; return; }
    rt -= 128;
    if (rt < 96) { const int j = rt / 48, t = rt % 48; kind = (t < 32) ? 3 : 0; ld = ODD_IN; src_base = p.o_win + (size_t)j * 1024 * ODD_IN; dst = p.WinO() + (size_t)j * 3072 * 1024; n0 = t * 64; return; }
    rt -= 96;
    if (rt < 32) { const int j = rt >> 4, t = rt & 15; kind = 3; ld = 1024; src_base = p.e_wout + (size_t)j * 1024 * 1024; dst = p.WoutE() + (size_t)j * 1024 * 1024; n0 = t * 64; return; }
    rt -= 32;
    { const int j = rt >> 4, t = rt & 15; kind = 3; ld = 1024; src_base = p.o_wout + (size_t)j * 1024 * 1024; dst = p.WoutO() + (size_t)j * 1024 * 1024; n0 = t * 64; return; }
}
#define N_CONV_ROWTILES 3360
struct ConvTile { bf16_t* dst; int n0, k0; };
__device__ __forceinline__ void conv_load(const P& p, int rt, int kt, int tid, float4 (&cv)[4], ConvTile& ct) {
    const int tn4 = tid & 15, tk = tid >> 4, k0 = kt * 64;
    const float* src_base; size_t le_off; int ld, kind, n0; bf16_t* dst;
    conv_desc(p, rt, src_base, le_off, ld, dst, kind, n0);
    const int n = n0 + tn4 * 4;
    const float* sp;
    if (kind == 0) sp = src_base + n;
    else if (kind == 3) {
        const int r = n & 31, nn = r >> 4, i = r & 15;
        sp = src_base + (n & ~31) + 8 * (i >> 2) + 4 * nn + (i & 3);
    }
    else if (kind == 1) {
        const int tn = n >> 7, r = n & 127, wc = r >> 6, nn = (r >> 4) & 3, i = r & 15;
        const int col = 64 * tn + 32 * wc + 8 * (i >> 2) + 4 * (nn & 1) + (i & 3);
        sp = ((nn < 2) ? p.w_gate : p.w_up) + le_off + col;
    } else {
        const int seg = n >> 9, j = n & 511;
        const int base = seg < 4 ? seg * 512 : 2064 + (seg - 4) * 512;
        int col;
        if (seg == 4 || seg == 5) {
            const int head = j >> 7, r = j & 127, wc = r >> 6, nn = (r >> 4) & 3, i = r & 15;
            col = head * 128 + (nn & 1) * 64 + 32 * wc + 8 * (i >> 2) + 4 * (nn >> 1) + (i & 3);
        } else {
            const int r = j & 31, nn = r >> 4, i = r & 15;
            col = (j & ~31) + 8 * (i >> 2) + 4 * nn + (i & 3);
        }
        sp = src_base + base + col;
    }
#pragma unroll
    for (int i = 0; i < 4; ++i) cv[i] = *(const float4*)(sp + (size_t)(k0 + tk + 16 * i) * ld);
    ct.dst = dst; ct.n0 = n0; ct.k0 = k0;
}
__device__ __forceinline__ void conv_lds(float* tile, const float4 (&cv)[4], int tid) {
    const int tn4 = tid & 15, tk = tid >> 4;
#pragma unroll
    for (int i = 0; i < 4; ++i) {
        const int kk = tk + 16 * i;
        tile[(tn4 * 4 + 0) * 65 + kk] = cv[i].x; tile[(tn4 * 4 + 1) * 65 + kk] = cv[i].y; tile[(tn4 * 4 + 2) * 65 + kk] = cv[i].z; tile[(tn4 * 4 + 3) * 65 + kk] = cv[i].w;
    }
}
__device__ __forceinline__ void conv_store(const float* tile, const ConvTile& ct, int tid) {
    const int row = tid >> 2, sg = tid & 3;
    const float* tr = tile + row * 65 + sg * 16;
    u32x4 w0, w1;
    w0.x = pk2(tr[0], tr[1]); w0.y = pk2(tr[2], tr[3]); w0.z = pk2(tr[4], tr[5]); w0.w = pk2(tr[6], tr[7]);
    w1.x = pk2(tr[8], tr[9]); w1.y = pk2(tr[10], tr[11]); w1.z = pk2(tr[12], tr[13]); w1.w = pk2(tr[14], tr[15]);
    bf16_t* dp = ct.dst + (size_t)(ct.n0 + row) * 1024 + ct.k0 + sg * 16;
    *(u32x4*)dp = w0; *(u32x4*)(dp + 8) = w1;
}
#define DEF_PER_LAYER 12288
#define DEF_PER_SCAN (33 * 512)
#define DEF_TOTAL (3 * DEF_PER_LAYER)
__device__ __forceinline__ void deferred_tile(int q, int& rt, int& kt) {
    const int layer = 1 + q / DEF_PER_LAYER, r = q % DEF_PER_LAYER, rtl = r >> 4;
    kt = r & 15;
    rt = (rtl < 512) ? (512 * layer + rtl) : (2048 + 256 * layer + (rtl - 512));
}
#define P0_RTS (512 + 256 + 288)
#define P0_TILES (P0_RTS * 16 + (DEF_TOTAL - 2 * DEF_PER_SCAN))
__device__ void phase_convert(const P& p, unsigned char* lds, int bid, int nb) {
    float* tile = (float*)lds;
    const int tid = opaque_tid();
    for (int it0 = 0; it0 < P0_TILES; it0 += nb) {
        const bool valid = it0 + bid < P0_TILES;
        const int it = valid ? it0 + bid : P0_TILES - 1;
        int rt, kt;
        if (it < P0_RTS * 16) { const int r = it >> 4; kt = it & 15; rt = r < 512 ? r : (r < 768 ? 2048 + (r - 512) : 3072 + (r - 768)); }
        else deferred_tile(2 * DEF_PER_SCAN + (it - P0_RTS * 16), rt, kt);
        float4 cv[4]; ConvTile ct;
        conv_load(p, rt, kt, tid, cv, ct);
        __syncthreads();
        conv_lds(tile, cv, tid);
        __syncthreads();
        if (valid) conv_store(tile, ct, tid);
    }
}

struct TileAddr { const char* ab; const char* bb; unsigned ao[6]; unsigned bo; };
typedef __attribute__((address_space(3))) unsigned LdsU;
typedef const __attribute__((address_space(1))) unsigned GlbU;
__device__ __forceinline__ unsigned gemm_chunk_off(int tid) { return (unsigned)(((tid & 7) ^ ((tid >> 4) & 7)) * 16); }
template <int MT>
__device__ __forceinline__ void gemm_stage(const TileAddr& t, unsigned char* lds, int st, int ko, int tid) {
    constexpr int ABYTES = 4096 * MT, SBYTES = ABYTES + 16384;
    const char* a_ = t.ab + ko * 2; const char* b_ = t.bb + ko * 2;
    LdsU* d_ = (LdsU*)(lds + st * SBYTES + tid * 16);
#pragma unroll
    for (int i = 0; i < MT; ++i) __builtin_amdgcn_global_load_lds((GlbU*)(a_ + (size_t)t.ao[i]), d_ + 1024 * i, 16, 0, 0);
    LdsU* e_ = d_ + ABYTES / 4;
#pragma unroll
    for (int i = 0; i < 4; ++i) __builtin_amdgcn_global_load_lds((GlbU*)(b_ + i * 65536 + (size_t)t.bo), e_ + 1024 * i, 16, 0, 0);
}
template <bool SWAP, int MT>
__device__ __forceinline__ void gemm_tile(const TileAddr& t, unsigned char* lds, f32x4 (&acc)[MT][4], int tid) {
    constexpr int K = 1024, ABYTES = 4096 * MT, SBYTES = ABYTES + 16384;
    const int lane = tid & 63, wid = tid >> 6, wr = wid >> 1, wc = wid & 1, fr = lane & 15, fq = lane >> 4;
    const int sw = (fr >> 1) & 7;
    const int aofs = (wr * 16 * MT + fr) * 128, bofs = ABYTES + (wc * 64 + fr) * 128;
    const int c0 = ((0 + fq) ^ sw) << 4, c1 = ((4 + fq) ^ sw) << 4;
#pragma unroll
    for (int m = 0; m < MT; ++m)
#pragma unroll
        for (int n = 0; n < 4; ++n) acc[m][n] = (f32x4){0.f, 0.f, 0.f, 0.f};
#define GT_COMPUTE(st) { const unsigned char* sA = lds + (st) * SBYTES + aofs; const unsigned char* sB = lds + (st) * SBYTES + bofs; \
        _Pragma("unroll") for (int kk = 0; kk < 2; ++kk) { const int cc = kk ? c1 : c0; bf16x8 af[MT], bf[4]; \
            _Pragma("unroll") for (int m = 0; m < MT; ++m) af[m] = *(const bf16x8*)(sA + m * 2048 + cc); \
            _Pragma("unroll") for (int n = 0; n < 4; ++n) bf[n] = *(const bf16x8*)(sB + n * 2048 + cc); \
            __builtin_amdgcn_s_setprio(1); \
            _Pragma("unroll") for (int m = 0; m < MT; ++m) _Pragma("unroll") for (int n = 0; n < 4; ++n) { \
                if (SWAP) acc[m][n] = __builtin_amdgcn_mfma_f32_16x16x32_bf16(af[m], bf[n], acc[m][n], 0, 0, 0); \
                else      acc[m][n] = __builtin_amdgcn_mfma_f32_16x16x32_bf16(bf[n], af[m], acc[m][n], 0, 0, 0); } \
            __builtin_amdgcn_s_setprio(0); \
            if (MT > 4) __builtin_amdgcn_sched_barrier(0); } }
    constexpr int nk = K >> 6;
    gemm_stage<MT>(t, lds, 0, 0, tid);
    __syncthreads();
#pragma unroll 1
    for (int kt = 0; kt < nk - 2; kt += 2) {
        gemm_stage<MT>(t, lds, 1, (kt + 1) * 64, tid);
        GT_COMPUTE(0);
        __syncthreads();
        gemm_stage<MT>(t, lds, 0, (kt + 2) * 64, tid);
        GT_COMPUTE(1);
        __syncthreads();
    }
    gemm_stage<MT>(t, lds, 1, (nk - 1) * 64, tid);
    GT_COMPUTE(0);
    __syncthreads();
    GT_COMPUTE(1);
    __syncthreads();
#undef GT_COMPUTE
}
template <int MT>
__device__ __forceinline__ void tile_addr_rows(TileAddr& t, const bf16_t* A, int row0, const bf16_t* W, int nt, int tid) {
    const int lrow = tid >> 3; const unsigned ch = gemm_chunk_off(tid);
    t.ab = (const char*)A; t.bb = (const char*)W; t.bo = (unsigned)(nt * 128 + lrow) * 2048u + ch;
#pragma unroll
    for (int i = 0; i < MT; ++i) t.ao[i] = (unsigned)(row0 + lrow + 32 * i) * 2048u + ch;
}

struct Row16 { float v[2][8]; };
__device__ __forceinline__ void ld_bf8(const bf16_t* q, float (&d)[8]) {
    const u32x4 w = *(const u32x4*)q;
    d[0] = bflo(w.x); d[1] = bfhi(w.x); d[2] = bflo(w.y); d[3] = bfhi(w.y); d[4] = bflo(w.z); d[5] = bfhi(w.z); d[6] = bflo(w.w); d[7] = bfhi(w.w);
}
__device__ __forceinline__ void st_bf8(bf16_t* q, const float (&d)[8]) {
    u32x4 w; w.x = pk2(d[0], d[1]); w.y = pk2(d[2], d[3]); w.z = pk2(d[4], d[5]); w.w = pk2(d[6], d[7]); *(u32x4*)q = w;
}
__device__ __forceinline__ void ld_f8(const float* q, float (&d)[8]) {
    const float4 a = *(const float4*)q, b = *(const float4*)(q + 4);
    d[0] = a.x; d[1] = a.y; d[2] = a.z; d[3] = a.w; d[4] = b.x; d[5] = b.y; d[6] = b.z; d[7] = b.w;
}
__device__ __forceinline__ void ld_row_bf(const bf16_t* row, int lane, Row16& r) { ld_bf8(row + 8 * lane, r.v[0]); ld_bf8(row + 512 + 8 * lane, r.v[1]); }
__device__ __forceinline__ float row_sumsq(const Row16& r) {
    float s = 0.f;
#pragma unroll
    for (int i = 0; i < 2; ++i)
#pragma unroll
        for (int c = 0; c < 8; ++c) s += r.v[i][c] * r.v[i][c];
    return s;
}
__device__ __forceinline__ void stage_proj16(unsigned char* lds, const float* W, int ldw, const float* g, int tid) {
#pragma unroll
    for (int r = 0; r < 4; ++r) {
        const int k = tid + 256 * r;
        const int i = k >> 9, ln = (k >> 3) & 63, c = k & 7;
        const int rho = 64 * (8 * i + c) + ln;
        const float gk = g[k];
        const float4* wp = (const float4*)(W + (size_t)k * ldw);
#pragma unroll
        for (int ch = 0; ch < 4; ++ch) {
            float4 w = wp[ch]; w.x *= gk; w.y *= gk; w.z *= gk; w.w *= gk;
            *(float4*)(lds + rho * 64 + ((ch ^ ((rho >> 2) & 3)) << 4)) = w;
        }
    }
}
__device__ __forceinline__ void proj16_accum(const unsigned char* lds, const Row16& h, int lane, float (&acc)[16]) {
#pragma unroll
    for (int e = 0; e < 16; ++e) acc[e] = 0.f;
#pragma unroll
    for (int i = 0; i < 2; ++i) {
#pragma unroll
        for (int c = 0; c < 8; ++c) {
            const int rho = 64 * (8 * i + c) + lane;
            const unsigned char* rp = lds + rho * 64;
            const int sw = (rho >> 2) & 3;
#pragma unroll
            for (int ch = 0; ch < 4; ++ch) {
                const float4 w = *(const float4*)(rp + ((ch ^ sw) << 4));
                acc[ch * 4 + 0] += h.v[i][c] * w.x; acc[ch * 4 + 1] += h.v[i][c] * w.y; acc[ch * 4 + 2] += h.v[i][c] * w.z; acc[ch * 4 + 3] += h.v[i][c] * w.w;
            }
            if (c == 3) __builtin_amdgcn_sched_barrier(0);
        }
        __builtin_amdgcn_sched_barrier(0);
    }
}
__device__ __forceinline__ void proj16_accum2(const unsigned char* lds, const Row16& ha, const Row16& hb, int lane, float (&acca)[16], float (&accb)[16]) {
#pragma unroll
    for (int e = 0; e < 16; ++e) { acca[e] = 0.f; accb[e] = 0.f; }
#pragma unroll
    for (int i = 0; i < 2; ++i) {
#pragma unroll
        for (int c = 0; c < 8; ++c) {
            const int rho = 64 * (8 * i + c) + lane;
            const unsigned char* rp = lds + rho * 64;
            const int sw = (rho >> 2) & 3;
#pragma unroll
            for (int ch = 0; ch < 4; ++ch) {
                const float4 w = *(const float4*)(rp + ((ch ^ sw) << 4));
                acca[ch * 4 + 0] += ha.v[i][c] * w.x; acca[ch * 4 + 1] += ha.v[i][c] * w.y; acca[ch * 4 + 2] += ha.v[i][c] * w.z; acca[ch * 4 + 3] += ha.v[i][c] * w.w;
                accb[ch * 4 + 0] += hb.v[i][c] * w.x; accb[ch * 4 + 1] += hb.v[i][c] * w.y; accb[ch * 4 + 2] += hb.v[i][c] * w.z; accb[ch * 4 + 3] += hb.v[i][c] * w.w;
            }
            if (c == 3) __builtin_amdgcn_sched_barrier(0);
        }
        __builtin_amdgcn_sched_barrier(0);
    }
}
__device__ __forceinline__ int e_of_lane(int lane) { return ((lane >> 5) & 1) * 8 + ((lane >> 4) & 1) * 4 + ((lane >> 3) & 1) * 2 + ((lane >> 2) & 1); }
__device__ __forceinline__ float reduce_scatter16(const float (&a)[16], int lane) {
    float b8[8], b4[4], b2[2];
    { const bool up = (lane & 32) != 0;
#pragma unroll
      for (int e = 0; e < 8; ++e) { const float keep = up ? a[e + 8] : a[e], send = up ? a[e] : a[e + 8]; b8[e] = keep + __shfl_xor(send, 32); } }
    { const bool up = (lane & 16) != 0;
#pragma unroll
      for (int e = 0; e < 4; ++e) { const float keep = up ? b8[e + 4] : b8[e], send = up ? b8[e] : b8[e + 4]; b4[e] = keep + __shfl_xor(send, 16); } }
    { const bool up = (lane & 8) != 0;
#pragma unroll
      for (int e = 0; e < 2; ++e) { const float keep = up ? b4[e + 2] : b4[e], send = up ? b4[e] : b4[e + 2]; b2[e] = keep + __shfl_xor(send, 8); } }
    float b1;
    { const bool up = (lane & 4) != 0; const float keep = up ? b2[1] : b2[0], send = up ? b2[0] : b2[1]; b1 = keep + __shfl_xor(send, 4); }
    b1 += __shfl_xor(b1, 2); b1 += __shfl_xor(b1, 1);
    return b1;
}
__device__ __forceinline__ float4 ld_bf4(const bf16_t* q) { const u32x2 w = *(const u32x2*)q; return make_float4(bflo(w.x), bfhi(w.x), bflo(w.y), bfhi(w.y)); }
__device__ __forceinline__ void st_bf4(bf16_t* q, float4 v) { u32x2 w; w.x = pk2(v.x, v.y); w.y = pk2(v.z, v.w); *(u32x2*)q = w; }
#define DPP_F(x, ctrl, rmask, oldv) __builtin_bit_cast(float, __builtin_amdgcn_update_dpp(__builtin_bit_cast(int, (float)(oldv)), __builtin_bit_cast(int, (x)), (ctrl), (rmask), 0xf, false))
__device__ __forceinline__ float wave_sum(float v) {
    v += DPP_F(v, 0x111, 0xf, 0.f); v += DPP_F(v, 0x112, 0xf, 0.f); v += DPP_F(v, 0x114, 0xf, 0.f); v += DPP_F(v, 0x118, 0xf, 0.f);
    v += DPP_F(v, 0x142, 0xa, 0.f);
    v += DPP_F(v, 0x143, 0xc, 0.f);
    return __builtin_bit_cast(float, __builtin_amdgcn_readlane(__builtin_bit_cast(int, v), 63));
}
__device__ __forceinline__ float wave_max(float v) {
    const float ninf = -3.0e38f;
    v = fmaxf(v, DPP_F(v, 0x111, 0xf, ninf)); v = fmaxf(v, DPP_F(v, 0x112, 0xf, ninf)); v = fmaxf(v, DPP_F(v, 0x114, 0xf, ninf)); v = fmaxf(v, DPP_F(v, 0x118, 0xf, ninf));
    v = fmaxf(v, DPP_F(v, 0x142, 0xa, ninf));
    v = fmaxf(v, DPP_F(v, 0x143, 0xc, ninf));
    return __builtin_bit_cast(float, __builtin_amdgcn_readlane(__builtin_bit_cast(int, v), 63));
}

__device__ void phase_router(const P& p, int layer, unsigned char* lds, int bid, int nb) {
    const int tid = opaque_tid(), lane = tid & 63, wid = tid >> 6;
    const float* g = p.ffn_g + layer * D_;
    __syncthreads();
    stage_proj16(lds, p.router_w + (size_t)layer * D_ * 16, 16, g, tid);
    __syncthreads();
    Row16 gg; ld_f8(g + 8 * lane, gg.v[0]); ld_f8(g + 512 + 8 * lane, gg.v[1]);
    const int eme = e_of_lane(lane);
    const int stride = nb * 4;
#pragma unroll 1
    for (int tok = bid * 4 + wid; tok < T_; tok += 2 * stride) {
        const int tokb = tok + stride, tbc = tokb < T_ ? tokb : T_ - 1;
        Row16 ha, hb;
        ld_row_bf(p.h() + (size_t)tok * D_, lane, ha); ld_row_bf(p.h() + (size_t)tbc * D_, lane, hb);
        const float ra = rsqrtf(wave_sum(row_sumsq(ha)) * (1.f / D_) + 1e-6f), rb = rsqrtf(wave_sum(row_sumsq(hb)) * (1.f / D_) + 1e-6f);
#pragma unroll
        for (int i = 0; i < 2; ++i) {
            float ua[8], ub[8];
#pragma unroll
            for (int c = 0; c < 8; ++c) { ua[c] = ha.v[i][c] * ra * gg.v[i][c]; ub[c] = hb.v[i][c] * rb * gg.v[i][c]; }
            st_bf8(p.u() + (size_t)tok * D_ + 512 * i + 8 * lane, ua);
            if (tokb < T_) st_bf8(p.u() + (size_t)tokb * D_ + 512 * i + 8 * lane, ub);
        }
        float acca[16], accb[16];
        proj16_accum2(lds, ha, hb, lane, acca, accb);
        const float la = reduce_scatter16(acca, lane) * ra, lb = reduce_scatter16(accb, lane) * rb;
        const float ma = wave_max(la), mb = wave_max(lb);
        const float ea = __expf(la - ma), eb = __expf(lb - mb);
        const float suma = wave_sum(ea) * 0.25f, sumb = wave_sum(eb) * 0.25f;
        if ((lane & 3) == 0) {
            { const int b = tok / L_, t = tok - b * L_; p.aff()[(size_t)(b * 16 + eme) * L_ + t] = ea / suma; }
            if (tokb < T_) { const int b = tokb / L_, t = tokb - b * L_; p.aff()[(size_t)(b * 16 + eme) * L_ + t] = eb / sumb; }
        }
    }
}

__device__ void phase_topk(const P& p, unsigned char* lds, int bid, int nb) {
    const int tid = opaque_tid(), lane = tid & 63, wid = tid >> 6;
    unsigned* wc = (unsigned*)lds;
#if PROBE_TOPK
    for (int rep = 0; rep < 4; ++rep)
#endif
    for (int g = bid; g < NG; g += nb) {
        const int b = g >> 4, e = g & 15;
        const float* ap = p.aff() + (size_t)g * L_;
        unsigned key[9];
#pragma unroll
        for (int m = 0; m < 9; ++m) { const int i = tid + 256 * m; key[m] = (i < L_) ? __builtin_bit_cast(unsigned, ap[i]) : 0u; }
        unsigned T = 0u;
        for (int bit = 31; bit >= 0; --bit) {
            const unsigned cand = T | (1u << bit);
            unsigned c = 0;
#pragma unroll
            for (int m = 0; m < 9; ++m) c += (unsigned)__popcll(__ballot(key[m] >= cand));
            unsigned* w = wc + (bit & 1) * 4;
            if (lane == 0) w[wid] = c;
            __syncthreads();
            const unsigned tot = w[0] + w[1] + w[2] + w[3];
            if (tot >= CAP) T = cand;
        }
        __syncthreads();
        unsigned cg = 0;
#pragma unroll
        for (int m = 0; m < 9; ++m) cg += (unsigned)__popcll(__ballot(key[m] > T));
        if (lane == 0) wc[wid] = cg;
        __syncthreads();
        const unsigned n_gt = wc[0] + wc[1] + wc[2] + wc[3];
        const unsigned need = CAP - n_gt;
        __syncthreads();
        unsigned base_sel = 0, base_tie = 0;
#pragma unroll
        for (int m = 0; m < 9; ++m) {
            const int i = tid + 256 * m;
            const bool gt = key[m] > T, tie = (key[m] == T) && (i < L_);
            const unsigned long long bt = __ballot(tie);
            const unsigned long long lower = (1ull << lane) - 1ull;
            if (lane == 0) { wc[8 + wid] = (unsigned)__popcll(bt); }
            __syncthreads();
            unsigned tie_before = base_tie + (unsigned)__popcll(bt & lower);
            for (int w2 = 0; w2 < wid; ++w2) tie_before += wc[8 + w2];
            const unsigned tie_row = wc[8] + wc[9] + wc[10] + wc[11];
            const bool take = gt || (tie && tie_before < need);
            const unsigned long long bs = __ballot(take);
            if (lane == 0) { wc[12 + wid] = (unsigned)__popcll(bs); }
            __syncthreads();
            unsigned slot = base_sel + (unsigned)__popcll(bs & lower);
            for (int w2 = 0; w2 < wid; ++w2) slot += wc[12 + w2];
            const unsigned sel_row = wc[12] + wc[13] + wc[14] + wc[15];
            if (i < L_) {
                if (take) { const int sl = (e * B_ + b) * CAP + (int)slot; p.idx()[sl] = b * L_ + i; p.gate()[sl] = __builtin_bit_cast(float, key[m]); }
                p.sel()[((size_t)b * L_ + i) * 16 + e] = take ? (int)slot : -1;
            }
            base_sel += sel_row; base_tie += tie_row;
            __syncthreads();
        }
    }
}

template <int MT>
__device__ __forceinline__ void gateup_unit(const P& p, int layer, unsigned char* lds, int e, int srow0, int nt, int tid) {
    const int lane = tid & 63, wid = tid >> 6, wr = wid >> 1, wc = wid & 1, fr = lane & 15, fq = lane >> 4, lrow = tid >> 3;
    TileAddr t;
#pragma unroll
    for (int i = 0; i < MT; ++i) { int srow = srow0 + lrow + 32 * i; if (srow > ESLOTS - 1) srow = ESLOTS - 1; t.ao[i] = (unsigned)p.idx()[e * ESLOTS + srow] * 2048u + gemm_chunk_off(tid); }
    t.ab = (const char*)p.u();
    t.bb = (const char*)(p.Wgu() + (size_t)(layer * 16 + e) * 2048 * 1024); t.bo = (unsigned)(nt * 128 + lrow) * 2048u + gemm_chunk_off(tid);
    f32x4 acc[MT][4];
    gemm_tile<false, MT>(t, lds, acc, tid);
#pragma unroll
    for (int m = 0; m < MT; ++m) {
        const int srow = srow0 + wr * 16 * MT + m * 16 + fr;
        if (srow < ESLOTS) {
            float o[8];
#pragma unroll
            for (int n = 0; n < 2; ++n) {
                const f32x4 gv = acc[m][n], uv = acc[m][n + 2];
#pragma unroll
                for (int j = 0; j < 4; ++j) o[4 * n + j] = gv[j] / (1.f + __expf(-gv[j])) * uv[j];
            }
            u32x4 pk; pk.x = pk2(o[0], o[1]); pk.y = pk2(o[2], o[3]); pk.z = pk2(o[4], o[5]); pk.w = pk2(o[6], o[7]);
            *(u32x4*)(p.hdn() + ((size_t)e * ESLOTS + srow) * D_ + nt * 64 + wc * 32 + fq * 8) = pk;
        }
    }
}
__device__ void phase_gateup(const P& p, int layer, unsigned char* lds, int bid, int nb) {
    const int tid = opaque_tid();
    const int x = bid & 7, l = bid >> 3, nbx = nb >> 3;
#if PROBE_GEMM
    for (int rep = 0; rep < 2; ++rep)
#endif
    for (int s = l; s < 320; s += nbx) {
        const int e = 2 * x + s / 160, s2 = s % 160, grp = s2 / 80, r = s2 % 80, mt = r >> 3, nt = grp * 8 + (r & 7);
        gateup_unit<6>(p, layer, lds, e, mt * 192, nt, tid);
    }
    for (int s = l; s < 64; s += nbx) {
        const int u = s & 31, e = 2 * x + (u >> 4), nt = u & 15;
        if (s < 32) gateup_unit<4>(p, layer, lds, e, 1920, nt, tid); else gateup_unit<1>(p, layer, lds, e, 2048, nt, tid);
    }
}

template <int MT>
__device__ __forceinline__ void down_unit(const P& p, int layer, unsigned char* lds, int e, int srow0, int nt, int tid) {
    const int lane = tid & 63, wid = tid >> 6, wr = wid >> 1, wc = wid & 1, fr = lane & 15, fq = lane >> 4, lrow = tid >> 3;
    TileAddr t;
#pragma unroll
    for (int i = 0; i < MT; ++i) { int srow = srow0 + lrow + 32 * i; if (srow > ESLOTS - 1) srow = ESLOTS - 1; t.ao[i] = (unsigned)srow * 2048u + gemm_chunk_off(tid); }
    t.ab = (const char*)(p.hdn() + (size_t)e * ESLOTS * D_);
    t.bb = (const char*)(p.Wd() + (size_t)(layer * 16 + e) * 1024 * 1024); t.bo = (unsigned)(nt * 128 + lrow) * 2048u + gemm_chunk_off(tid);
    f32x4 acc[MT][4];
    gemm_tile<false, MT>(t, lds, acc, tid);
#pragma unroll
    for (int m = 0; m < MT; ++m) {
        const int srow = srow0 + wr * 16 * MT + m * 16 + fr;
        if (srow < ESLOTS) {
            const float gt = p.gate()[e * ESLOTS + srow];
#pragma unroll
            for (int pr = 0; pr < 2; ++pr) {
                const f32x4 v0 = acc[m][2 * pr], v1 = acc[m][2 * pr + 1];
                u32x4 pk; pk.x = pk2(v0[0] * gt, v0[1] * gt); pk.y = pk2(v0[2] * gt, v0[3] * gt); pk.z = pk2(v1[0] * gt, v1[1] * gt); pk.w = pk2(v1[2] * gt, v1[3] * gt);
                *(u32x4*)(p.ys() + ((size_t)e * ESLOTS + srow) * D_ + nt * 128 + wc * 64 + pr * 32 + fq * 8) = pk;
            }
        }
        if (MT > 4) __builtin_amdgcn_sched_barrier(0);
    }
}
__device__ void phase_down(const P& p, int layer, unsigned char* lds, int bid, int nb) {
    const int tid = opaque_tid();
    const int x = bid & 7, l = bid >> 3, nbx = nb >> 3;
#if PROBE_GEMM
    for (int rep = 0; rep < 2; ++rep)
#endif
    for (int s = l; s < 160 + 32; s += nbx) {
        if (s < 160) {
            const int e = 2 * x + s / 80, s2 = s % 80, mt = s2 >> 3, nt = s2 & 7;
            down_unit<6>(p, layer, lds, e, mt * 192, nt, tid);
        } else {
            const int u = (s - 160) & 15, e = 2 * x + (u >> 3), nt = u & 7;
            if (s < 176) down_unit<4>(p, layer, lds, e, 1920, nt, tid); else down_unit<1>(p, layer, lds, e, 2048, nt, tid);
        }
    }
}


template <int MT>
__device__ __forceinline__ void odd_in_unit(const P& p, int j, const bf16_t* W, unsigned char* lds, int row0, int nt, int tid) {
    const int lane = tid & 63, wid = tid >> 6, wr = wid >> 1, wc = wid & 1, fr = lane & 15, fq = lane >> 4;
    TileAddr t; tile_addr_rows<MT>(t, p.u(), row0, W, nt, tid);
    f32x4 acc[MT][4];
    if (nt < 16) {
        gemm_tile<false, MT>(t, lds, acc, tid);
        const bool isq = nt < 8;
        const float* g = isq ? (p.o_qg + j * 64) : (p.o_kg + j * 64);
        const float sc = isq ? 0.125f : 1.f;
        f32x4 gv[4];
#pragma unroll
        for (int n = 0; n < 4; ++n) gv[n] = *(const f32x4*)(g + 32 * (n >> 1) + 8 * fq + 4 * (n & 1));
#pragma unroll
        for (int m = 0; m < MT; ++m) {
            float ss = 0.f;
#pragma unroll
            for (int n = 0; n < 4; ++n) { const f32x4 v = acc[m][n]; ss += v[0] * v[0] + v[1] * v[1] + v[2] * v[2] + v[3] * v[3]; }
            ss += __shfl_xor(ss, 16); ss += __shfl_xor(ss, 32);
            const float rinv = rsqrtf(ss * (1.f / 64.f) + 1e-6f) * sc;
            const size_t row = (size_t)row0 + wr * 16 * MT + m * 16 + fr;
#pragma unroll
            for (int pr = 0; pr < 2; ++pr) {
                const f32x4 v0 = acc[m][2 * pr], v1 = acc[m][2 * pr + 1], g0 = gv[2 * pr], g1 = gv[2 * pr + 1];
                u32x4 pk; pk.x = pk2(v0[0] * rinv * g0[0], v0[1] * rinv * g0[1]); pk.y = pk2(v0[2] * rinv * g0[2], v0[3] * rinv * g0[3]);
                pk.z = pk2(v1[0] * rinv * g1[0], v1[1] * rinv * g1[1]); pk.w = pk2(v1[2] * rinv * g1[2], v1[3] * rinv * g1[3]);
                *(u32x4*)(p.zo() + row * 2048 + nt * 128 + wc * 64 + pr * 32 + fq * 8) = pk;
            }
        }
    } else {
        gemm_tile<true, MT>(t, lds, acc, tid);
        const int head = (nt - 16) * 2 + wc;
#pragma unroll
        for (int m = 0; m < MT; ++m) {
            const int row = row0 + wr * 16 * MT + m * 16 + fq * 4;
            const int b = row / L_, tk = row - b * L_;
#pragma unroll
            for (int n = 0; n < 4; ++n) {
                const int d = n * 16 + fr;
                const f32x4 v = acc[m][n];
                u32x2 pk; pk.x = pk2(v[0], v[1]); pk.y = pk2(v[2], v[3]);
                *(u32x2*)(p.vT() + ((size_t)(b * 16 + head) * 64 + d) * L_ + tk) = pk;
            }
        }
    }
}
__device__ void phase_odd_in(const P& p, int layer, unsigned char* lds, int bid, int nb) {
    const int tid = opaque_tid();
    const int x = bid & 7, l = bid >> 3, nbx = nb >> 3;
    const int j = layer >> 1;
    const bf16_t* W = p.WinO() + (size_t)j * 3072 * 1024;
#if PROBE_GEMM
    for (int rep = 0; rep < 2; ++rep)
#endif
    for (int s = l; s < 246; s += nbx) odd_in_unit<6>(p, j, W, lds, (s / 3) * 192, 3 * x + (s % 3), tid);
    if (nbx == 64) { for (int s = l - 54; s >= 0 && s < 18; s += 10) odd_in_unit<4>(p, j, W, lds, 15744 + (s / 3) * 128, 3 * x + (s % 3), tid); }
    else           { for (int s = l; s < 18; s += nbx) odd_in_unit<4>(p, j, W, lds, 15744 + (s / 3) * 128, 3 * x + (s % 3), tid); }
}

#define NA_VSTRIDE 1072
#define NA_RPB 68608
__device__ __forceinline__ int na_key(int row) { return ((row >> 1) & 1) | ((row >> 2) & 6); }
__device__ void phase_natten(const P& p, int layer, unsigned char* lds, int bid, int nb) {
    const int tid = opaque_tid(), lane = tid & 63, wid = tid >> 6, fr = lane & 15, fq = lane >> 4;
    typedef __attribute__((address_space(3))) unsigned LdsU;
    typedef const __attribute__((address_space(1))) unsigned GlbU;
    const int h = bid & 15, jb = bid >> 4, njb = nb >> 4;
    const float* rpbh = p.o_rpb + ((size_t)(layer >> 1) * 16 + h) * 15 * 31;
    float* rtab = (float*)(lds + NA_RPB);
    __syncthreads();
    for (int i = tid; i < 15 * 31; i += NTHR) rtab[i] = rpbh[i];
    const int w = wid;
    const int kc0 = (w == 0) ? 0 : (w == 1) ? 8 : (w == 2) ? 24 : 32;
    const int c = 16 * w + fr;
    const int cs = min(max(c - 8, 0), 48);
    for (int pr = jb; pr < B_ * 32; pr += njb) {
        const int b = pr >> 5, r = pr & 31;
        const int rs = min(max(r - 4, 0), 24);
        const size_t tokb = (size_t)b * L_;
        __syncthreads();
        for (int q = w; q < 66; q += 4) {
            const int row = 8 * q + (lane >> 3), pc = lane & 7;
            const size_t tok = row < 512 ? tokb + NM + rs * 64 + row : tokb + (row - 512);
            const bf16_t* src = p.zo() + tok * 2048 + 1024 + h * 64 + ((pc ^ na_key(row)) << 3);
            __builtin_amdgcn_global_load_lds((GlbU*)src, (LdsU*)(lds + q * 1024 + lane * 16), 16, 0, 0);
        }
        const bf16_t* qp = p.zo() + (tokb + NM + r * 64 + c) * 2048 + h * 64 + fq * 8;
        const bf16x8 qf0 = *(const bf16x8*)qp, qf1 = *(const bf16x8*)(qp + 32);
        __syncthreads();
        f32x4 S[17];
#pragma unroll
        for (int n = 0; n < 17; ++n) {
            const int row = (n < 16) ? ((n >> 1) * 64 + kc0 + 8 * (fr >> 2) + 4 * (n & 1) + (fr & 3)) : (512 + fr);
            const int ky = na_key(row);
            const bf16x8 kf0 = *(const bf16x8*)(lds + row * 128 + (((0 + fq) ^ ky) << 4));
            const bf16x8 kf1 = *(const bf16x8*)(lds + row * 128 + (((4 + fq) ^ ky) << 4));
            f32x4 a = (f32x4){0.f, 0.f, 0.f, 0.f};
            a = __builtin_amdgcn_mfma_f32_16x16x32_bf16(kf0, qf0, a, 0, 0, 0);
            a = __builtin_amdgcn_mfma_f32_16x16x32_bf16(kf1, qf1, a, 0, 0, 0);
            S[n] = a;
        }
        __syncthreads();
        {
            const bf16_t* vsrc = p.vT() + (size_t)(b * 16 + h) * 64 * L_;
            for (int d = w; d < 64; d += 4)
                __builtin_amdgcn_global_load_lds((GlbU*)(vsrc + (size_t)d * L_ + NM + rs * 64 + lane * 8), (LdsU*)(lds + d * NA_VSTRIDE + lane * 16), 16, 0, 0);
            if (tid < 128) { const int d = tid >> 1, hf = tid & 1; *(u32x4*)(lds + d * NA_VSTRIDE + 1024 + hf * 16) = *(const u32x4*)(vsrc + (size_t)d * L_ + hf * 8); }
        }
        float mx = -3.0e38f;
#pragma unroll
        for (int n = 0; n < 16; ++n) {
            const int dr = rs + (n >> 1) - r + 7;
#pragma unroll
            for (int jj = 0; jj < 4; ++jj) {
                const int kc = kc0 + 8 * fq + 4 * (n & 1) + jj;
                const bool valid = (kc >= cs) && (kc < cs + 16);
                const int dc = min(max(kc - c + 15, 0), 30);
                const float sv = valid ? S[n][jj] + rtab[dr * 31 + dc] : -3.0e38f;
                S[n][jj] = sv; mx = fmaxf(mx, sv);
            }
        }
#pragma unroll
        for (int jj = 0; jj < 4; ++jj) mx = fmaxf(mx, S[16][jj]);
        mx = fmaxf(mx, __shfl_xor(mx, 16)); mx = fmaxf(mx, __shfl_xor(mx, 32));
        float sum = 0.f;
#pragma unroll
        for (int n = 0; n < 17; ++n)
#pragma unroll
            for (int jj = 0; jj < 4; ++jj) { const float e = __expf(S[n][jj] - mx); S[n][jj] = e; sum += e; }
        sum += __shfl_xor(sum, 16); sum += __shfl_xor(sum, 32);
        const float rinv = 1.f / sum;
        __syncthreads();
        f32x4 O[4];
#pragma unroll
        for (int nd = 0; nd < 4; ++nd) O[nd] = (f32x4){0.f, 0.f, 0.f, 0.f};
#pragma unroll
        for (int t = 0; t < 8; ++t) {
            u32x4 pw; pw.x = pk2(S[2 * t][0], S[2 * t][1]); pw.y = pk2(S[2 * t][2], S[2 * t][3]); pw.z = pk2(S[2 * t + 1][0], S[2 * t + 1][1]); pw.w = pk2(S[2 * t + 1][2], S[2 * t + 1][3]);
            const bf16x8 pf = __builtin_bit_cast(bf16x8, pw);
#pragma unroll
            for (int nd = 0; nd < 4; ++nd) {
                const bf16x8 vf = *(const bf16x8*)(lds + (16 * nd + fr) * NA_VSTRIDE + (t * 64 + kc0 + 8 * fq) * 2);
                O[nd] = __builtin_amdgcn_mfma_f32_16x16x32_bf16(vf, pf, O[nd], 0, 0, 0);
            }
        }
        {
            u32x4 pw; pw.x = pk2(S[16][0], S[16][1]); pw.y = pk2(S[16][2], S[16][3]); pw.z = 0u; pw.w = 0u;
            const bf16x8 pf = __builtin_bit_cast(bf16x8, pw);
#pragma unroll
            for (int nd = 0; nd < 4; ++nd) {
                const u32x2 v2 = *(const u32x2*)(lds + (16 * nd + fr) * NA_VSTRIDE + 1024 + 8 * fq);
                u32x4 vw; vw.x = v2.x; vw.y = v2.y; vw.z = 0u; vw.w = 0u;
                O[nd] = __builtin_amdgcn_mfma_f32_16x16x32_bf16(__builtin_bit_cast(bf16x8, vw), pf, O[nd], 0, 0, 0);
            }
        }
        bf16_t* op = p.mix() + (tokb + NM + r * 64 + c) * D_ + h * 64 + fq * 4;
#pragma unroll
        for (int nd = 0; nd < 4; ++nd) {
            u32x2 pk; pk.x = pk2(O[nd][0] * rinv, O[nd][1] * rinv); pk.y = pk2(O[nd][2] * rinv, O[nd][3] * rinv);
            *(u32x2*)(op + nd * 16) = pk;
        }
    }
    for (int mi = bid * 4 + wid; mi < B_ * 16; mi += nb * 4) {
        const int hm = mi & 15, b = mi >> 4;
        const size_t tokb = (size_t)b * L_;
        const bf16_t* qp = p.zo() + (tokb + fr) * 2048 + hm * 64 + fq * 8;
        const bf16x8 qf0 = *(const bf16x8*)qp, qf1 = *(const bf16x8*)(qp + 32);
        const bf16_t* kp = qp + 1024;
        const bf16x8 kf0 = *(const bf16x8*)kp, kf1 = *(const bf16x8*)(kp + 32);
        f32x4 a = (f32x4){0.f, 0.f, 0.f, 0.f};
        a = __builtin_amdgcn_mfma_f32_16x16x32_bf16(kf0, qf0, a, 0, 0, 0);
        a = __builtin_amdgcn_mfma_f32_16x16x32_bf16(kf1, qf1, a, 0, 0, 0);
        float mx = fmaxf(fmaxf(a[0], a[1]), fmaxf(a[2], a[3]));
        mx = fmaxf(mx, __shfl_xor(mx, 16)); mx = fmaxf(mx, __shfl_xor(mx, 32));
        float sum = 0.f;
#pragma unroll
        for (int jj = 0; jj < 4; ++jj) { a[jj] = __expf(a[jj] - mx); sum += a[jj]; }
        sum += __shfl_xor(sum, 16); sum += __shfl_xor(sum, 32);
        const float rinv = 1.f / sum;
        u32x4 pw; pw.x = pk2(a[0], a[1]); pw.y = pk2(a[2], a[3]); pw.z = 0u; pw.w = 0u;
        const bf16x8 pf = __builtin_bit_cast(bf16x8, pw);
        const bf16_t* vb = p.vT() + ((size_t)(b * 16 + hm) * 64 + fr) * L_;
        bf16_t* op = p.mix() + (tokb + fr) * D_ + hm * 64 + fq * 4;
#pragma unroll
        for (int nd = 0; nd < 4; ++nd) {
            const u32x2 v2 = *(const u32x2*)(vb + (size_t)nd * 16 * L_ + 4 * fq);
            u32x4 vw; vw.x = v2.x; vw.y = v2.y; vw.z = 0u; vw.w = 0u;
            f32x4 o = (f32x4){0.f, 0.f, 0.f, 0.f};
            o = __builtin_amdgcn_mfma_f32_16x16x32_bf16(__builtin_bit_cast(bf16x8, vw), pf, o, 0, 0, 0);
            u32x2 pk; pk.x = pk2(o[0] * rinv, o[1] * rinv); pk.y = pk2(o[2] * rinv, o[3] * rinv);
            *(u32x2*)(op + nd * 16) = pk;
        }
    }
}

template <int MT>
__device__ __forceinline__ void outproj_unit(const P& p, const bf16_t* W, unsigned char* lds, int row0, int nt, int tid) {
    const int lane = tid & 63, wid = tid >> 6, wr = wid >> 1, wc = wid & 1, fr = lane & 15, fq = lane >> 4;
    TileAddr t; tile_addr_rows<MT>(t, p.mix(), row0, W, nt, tid);
    f32x4 acc[MT][4];
    gemm_tile<false, MT>(t, lds, acc, tid);
#pragma unroll
    for (int m = 0; m < MT; ++m) {
        const size_t row = (size_t)row0 + wr * 16 * MT + m * 16 + fr;
#pragma unroll
        for (int pr = 0; pr < 2; ++pr) {
            bf16_t* hp = p.h() + row * D_ + nt * 128 + wc * 64 + pr * 32 + fq * 8;
            const u32x4 hw = *(const u32x4*)hp; const f32x4 a0 = acc[m][2 * pr], a1 = acc[m][2 * pr + 1];
            u32x4 ow;
            ow.x = pk2(bflo(hw.x) + a0[0], bfhi(hw.x) + a0[1]); ow.y = pk2(bflo(hw.y) + a0[2], bfhi(hw.y) + a0[3]);
            ow.z = pk2(bflo(hw.z) + a1[0], bfhi(hw.z) + a1[1]); ow.w = pk2(bflo(hw.w) + a1[2], bfhi(hw.w) + a1[3]);
            *(u32x4*)hp = ow;
        }
        if (MT > 4) __builtin_amdgcn_sched_barrier(0);
    }
}
__device__ void phase_outproj(const P& p, const bf16_t* W, unsigned char* lds, int bid, int nb) {
    const int tid = opaque_tid();
    const int x = bid & 7, l = bid >> 3, nbx = nb >> 3;
    for (int s = l; s < 64; s += nbx) outproj_unit<6>(p, W, lds, s * 192, x, tid);
    for (int s = l; s < 33; s += nbx) outproj_unit<4>(p, W, lds, 12288 + s * 128, x, tid);
}

__device__ void phase_tables(const P& p, int bid, int nb) {
    for (int i = bid * NTHR + opaque_tid(); i < L_ * 64; i += nb * NTHR) {
        const int pos = i >> 6, k = i & 63;
        const float inv = powf(10000.f, -(float)k / 64.f);
        const float ang = (float)pos * inv;
        p.costab()[i] = cosf(ang); p.sintab()[i] = sinf(ang);
    }
}

template <int MT>
__device__ __forceinline__ void even_in_unit(const P& p, const bf16_t* W, unsigned char* lds, int row0, int nt, int tid) {
    const int lane = tid & 63, wid = tid >> 6, wr = wid >> 1, wc = wid & 1, fr = lane & 15, fq = lane >> 4;
    TileAddr t; tile_addr_rows<MT>(t, p.u(), row0, W, nt, tid);
    f32x4 acc[MT][4];
    gemm_tile<false, MT>(t, lds, acc, tid);
    const int seg = nt >> 2;
    if (seg == 4 || seg == 5) {
        const float sc = (seg == 5) ? 0.08838834764831845f : 1.f;
#pragma unroll
        for (int m = 0; m < MT; ++m) {
            const int row = row0 + wr * 16 * MT + m * 16 + fr;
            const int pos = row % L_;
            const int idx = 32 * wc + 8 * fq;
            u32x4 k1, k2;
#pragma unroll
            for (int pp = 0; pp < 2; ++pp) {
                const f32x4 cv = *(const f32x4*)(p.costab() + pos * 64 + idx + 4 * pp), sv = *(const f32x4*)(p.sintab() + pos * 64 + idx + 4 * pp);
                const f32x4 x1 = acc[m][2 * pp], x2 = acc[m][2 * pp + 1];
                const f32x4 y1 = (x1 * cv - x2 * sv) * sc, y2 = (x2 * cv + x1 * sv) * sc;
                if (pp == 0) { k1.x = pk2(y1[0], y1[1]); k1.y = pk2(y1[2], y1[3]); k2.x = pk2(y2[0], y2[1]); k2.y = pk2(y2[2], y2[3]); }
                else         { k1.z = pk2(y1[0], y1[1]); k1.w = pk2(y1[2], y1[3]); k2.z = pk2(y2[0], y2[1]); k2.w = pk2(y2[2], y2[3]); }
            }
            bf16_t* zp = p.ze() + (size_t)row * 4096 + nt * 128 + idx;
            *(u32x4*)zp = k1; *(u32x4*)(zp + 64) = k2;
            if (MT > 4) __builtin_amdgcn_sched_barrier(0);
        }
    } else {
#pragma unroll
        for (int m = 0; m < MT; ++m) {
            const size_t row = (size_t)row0 + wr * 16 * MT + m * 16 + fr;
#pragma unroll
            for (int pr = 0; pr < 2; ++pr) {
                const f32x4 v0 = acc[m][2 * pr], v1 = acc[m][2 * pr + 1];
                u32x4 pk; pk.x = pk2(v0[0], v0[1]); pk.y = pk2(v0[2], v0[3]); pk.z = pk2(v1[0], v1[1]); pk.w = pk2(v1[2], v1[3]);
                *(u32x4*)(p.ze() + row * 4096 + nt * 128 + wc * 64 + pr * 32 + fq * 8) = pk;
            }
        }
    }
}
__device__ void phase_even_in(const P& p, int layer, unsigned char* lds, int bid, int nb) {
    const int tid = opaque_tid();
    const int x = bid & 7, l = bid >> 3, nbx = nb >> 3;
    const bf16_t* W = p.WinE() + (size_t)(layer >> 1) * 4096 * 1024;
#if PROBE_GEMM
    for (int rep = 0; rep < 2; ++rep)
#endif
    for (int s = l; s < 320; s += nbx) even_in_unit<6>(p, W, lds, (s >> 2) * 192, 4 * x + (s & 3), tid);
    for (int s = l; s < 36; s += nbx) even_in_unit<4>(p, W, lds, 15360 + (s >> 2) * 128, 4 * x + (s & 3), tid);
}

__device__ void phase_conv(const P& p, int layer, int bid, int nb) {
    const int tid = opaque_tid(), cg = tid & 127, th = tid >> 7;
    const int c0 = cg * 8;
    const float* w = p.e_conv + (size_t)(layer >> 1) * 5 * 1024 + c0;
    float wv[5][8];
#pragma unroll
    for (int jj = 0; jj < 5; ++jj) { const float4 a = *(const float4*)(w + jj * 1024), b2 = *(const float4*)(w + jj * 1024 + 4);
        wv[jj][0] = a.x; wv[jj][1] = a.y; wv[jj][2] = a.z; wv[jj][3] = a.w; wv[jj][4] = b2.x; wv[jj][5] = b2.y; wv[jj][6] = b2.z; wv[jj][7] = b2.w; }
    const float sc = (c0 >= 512) ? 0.08838834764831845f : 1.f;
    for (int it = bid; it < T_ / 16; it += nb) {
        const int tok0 = it * 16 + th * 8;
        const int b = tok0 / L_, t0 = tok0 - b * L_;
        float win[5][8];
#pragma unroll
        for (int r = 0; r < 4; ++r) {
            const int tt = t0 - 2 + r;
            u32x4 raw = (u32x4){0u, 0u, 0u, 0u};
            if (tt >= 0 && tt < L_) raw = *(const u32x4*)(p.ze() + ((size_t)b * L_ + tt) * 4096 + c0);
            win[r + 1][0] = bflo(raw.x); win[r + 1][1] = bfhi(raw.x); win[r + 1][2] = bflo(raw.y); win[r + 1][3] = bfhi(raw.y);
            win[r + 1][4] = bflo(raw.z); win[r + 1][5] = bfhi(raw.z); win[r + 1][6] = bflo(raw.w); win[r + 1][7] = bfhi(raw.w);
        }
#pragma unroll
        for (int i = 0; i < 8; ++i) {
#pragma unroll
            for (int r = 0; r < 4; ++r)
#pragma unroll
                for (int c = 0; c < 8; ++c) win[r][c] = win[r + 1][c];
            const int tt = t0 + i + 2;
            u32x4 raw = (u32x4){0u, 0u, 0u, 0u};
            if (tt < L_) raw = *(const u32x4*)(p.ze() + ((size_t)b * L_ + tt) * 4096 + c0);
            win[4][0] = bflo(raw.x); win[4][1] = bfhi(raw.x); win[4][2] = bflo(raw.y); win[4][3] = bfhi(raw.y);
            win[4][4] = bflo(raw.z); win[4][5] = bfhi(raw.z); win[4][6] = bflo(raw.w); win[4][7] = bfhi(raw.w);
            float o[8];
#pragma unroll
            for (int c = 0; c < 8; ++c) {
                float s = 0.f;
#pragma unroll
                for (int jj = 0; jj < 5; ++jj) s += wv[jj][c] * win[jj][c];
                o[c] = s / (1.f + __expf(-s)) * sc;
            }
            u32x4 pk; pk.x = pk2(o[0], o[1]); pk.y = pk2(o[2], o[3]); pk.z = pk2(o[4], o[5]); pk.w = pk2(o[6], o[7]);
            *(u32x4*)(p.qc() + (size_t)(tok0 + i) * 1024 + c0) = pk;
        }
    }
}

#define SC_QS 0
#define SC_KS 17408
#define SC_VS 34816
#define SC_VW 39936
#define SC_CT 45056
#define SC_NS 53760
#define SC_KW 54272
#define SC_AK 54528
#define SC_CONV 55296
__device__ __forceinline__ void tr_read8(unsigned a0, unsigned a1, unsigned a2, unsigned a3, unsigned a4, unsigned a5, unsigned a6, unsigned a7,
                                         u32x2& r0, u32x2& r1, u32x2& r2, u32x2& r3, u32x2& r4, u32x2& r5, u32x2& r6, u32x2& r7) {
    asm volatile("ds_read_b64_tr_b16 %0, %8\n\tds_read_b64_tr_b16 %1, %9\n\tds_read_b64_tr_b16 %2, %10\n\tds_read_b64_tr_b16 %3, %11\n\t"
                 "ds_read_b64_tr_b16 %4, %12\n\tds_read_b64_tr_b16 %5, %13\n\tds_read_b64_tr_b16 %6, %14\n\tds_read_b64_tr_b16 %7, %15\n\ts_waitcnt lgkmcnt(0)"
                 : "=&v"(r0), "=&v"(r1), "=&v"(r2), "=&v"(r3), "=&v"(r4), "=&v"(r5), "=&v"(r6), "=&v"(r7)
                 : "v"(a0), "v"(a1), "v"(a2), "v"(a3), "v"(a4), "v"(a5), "v"(a6), "v"(a7) : "memory");
}
__device__ __forceinline__ void tr_read4(unsigned a0, unsigned a1, unsigned a2, unsigned a3, u32x2& r0, u32x2& r1, u32x2& r2, u32x2& r3) {
    asm volatile("ds_read_b64_tr_b16 %0, %4\n\tds_read_b64_tr_b16 %1, %5\n\tds_read_b64_tr_b16 %2, %6\n\tds_read_b64_tr_b16 %3, %7\n\ts_waitcnt lgkmcnt(0)"
                 : "=&v"(r0), "=&v"(r1), "=&v"(r2), "=&v"(r3) : "v"(a0), "v"(a1), "v"(a2), "v"(a3) : "memory");
}
__device__ __forceinline__ bf16x8 cat8(u32x2 lo, u32x2 hi) { u32x4 w; w.x = lo.x; w.y = lo.y; w.z = hi.x; w.w = hi.y; return __builtin_bit_cast(bf16x8, w); }
template <bool RET>
__device__ void scan_item(const P& p, int layer, unsigned char* lds, int b, int hh, int dir, int eq, int conv_q0, int conv_stride) {
    const int tid = opaque_tid(), lane = tid & 63, w = tid >> 6, fr = lane & 15, fq = lane >> 4;
    const unsigned lbase = (unsigned)(size_t)lds;
    const size_t tokb = (size_t)b * L_;
    const bf16_t* qsrc = RET ? (p.ze() + 2048 + hh * 128) : (p.qc() + hh * 128);
    const bf16_t* ksrc = RET ? (p.ze() + 2560 + hh * 128) : (p.qc() + 512 + hh * 128);
    const bf16_t* vsrc = p.ze() + (RET ? 3072 : 1024) + hh * 128 + eq * 32;
    const int qld = RET ? 4096 : 1024;
    const float lgam = RET ? logsigmoidf_(p.e_decay[(layer >> 1) * 8 + dir * 4 + hh]) : 0.f;
    const int lr = tid >> 4, lc = tid & 15;
    const int vr = tid >> 2, vc = tid & 3;
    u32x4 rq[4], rk[4], rv; float rli = 0.f, rlf = 0.f;
    auto tok_of = [&](int n, int pp) -> int {
        if (n == 0) return pp < 48 ? -1 : pp - 48;
        const int rr = 64 * (n - 1) + pp;
        return NM + (dir ? 2047 - rr : rr);
    };
    auto load_chunk = [&](int n) {
#pragma unroll
        for (int i = 0; i < 4; ++i) {
            const int t = tok_of(n, lr + 16 * i);
            rq[i] = (u32x4){0u, 0u, 0u, 0u}; rk[i] = (u32x4){0u, 0u, 0u, 0u};
            if (t >= 0) { rq[i] = *(const u32x4*)(qsrc + (tokb + t) * qld + lc * 8); rk[i] = *(const u32x4*)(ksrc + (tokb + t) * qld + lc * 8); }
        }
        { const int t = tok_of(n, vr); rv = (u32x4){0u, 0u, 0u, 0u}; if (t >= 0) rv = *(const u32x4*)(vsrc + (tokb + t) * 4096 + vc * 8); }
        if (!RET) {
            const int t = tok_of(n, lane); rli = 0.f; rlf = 0.f;
            if (t >= 0) { const float* gp = p.gts() + (tokb + t) * 16 + dir * 8 + hh; rli = gp[0]; rlf = logsigmoidf_(gp[4]); }
        }
    };
    float bb, a_, cm;
    auto local_scan = [&]() {
        const float lf = RET ? lgam : rlf, li = RET ? 0.f : rli;
        bb = lf;
#pragma unroll
        for (int o = 1; o < 64; o <<= 1) { const float t = __shfl_up(bb, o); if (lane >= o) bb += t; }
        a_ = li - bb; cm = a_;
        if (!RET) {
#pragma unroll
            for (int o = 1; o < 64; o <<= 1) { const float t = __shfl_up(cm, o); if (lane >= o) cm = fmaxf(cm, t); }
        }
    };
    f32x4 Cacc[2][2];
#pragma unroll
    for (int a = 0; a < 2; ++a)
#pragma unroll
        for (int c = 0; c < 2; ++c) Cacc[a][c] = (f32x4){0.f, 0.f, 0.f, 0.f};
    float m_prev = 0.f, w_state = 0.f, nsum0 = 0.f, nsum1 = 0.f;
    ConvTile cvt;
    load_chunk(0);
    local_scan();
    const int tq = (lane >> 2) & 3, tp = lane & 3;
    const unsigned trK = lbase + SC_KS + (8 * fq + tq) * 272 + (32 * w + 4 * tp) * 2;
    const unsigned trV = lbase + SC_VS + (8 * fq + tq) * 80 + (4 * tp) * 2;
    for (int n = 0; n < 33; ++n) {
        float mm;
        if (RET) mm = 0.f; else mm = bb + fmaxf(m_prev, cm);
        const float b63 = __shfl(bb, 63), m_new = __shfl(mm, 63);
        const float bm_ = bb - mm, winter_ = __expf(bb + m_prev - mm), kw_ = __expf(b63 + a_ - m_new), em_ = __expf(-mm);
#pragma unroll
        for (int mt = 0; mt < 2; ++mt)
#pragma unroll
            for (int ne = 0; ne < 2; ++ne) {
                const f32x4 v = Cacc[mt][ne];
                u32x2 pk; pk.x = pk2(v[0], v[1]); pk.y = pk2(v[2], v[3]);
                *(u32x2*)(lds + SC_CT + (16 * ne + fr) * 272 + (32 * w + 16 * mt + 4 * fq) * 2) = pk;
            }
        if (fq == 0) {
            float* ns = (float*)(lds + SC_NS) + 32 * w + fr;
            ns[0] = (n == 0) ? 0.f : (w_state * ns[0] + nsum0);
            ns[16] = (n == 0) ? 0.f : (w_state * ns[16] + nsum1);
        }
        w_state = __expf(b63 + m_prev - m_new);
#pragma unroll
        for (int i = 0; i < 4; ++i) {
            const int row = lr + 16 * i;
            *(u32x4*)(lds + SC_QS + row * 272 + lc * 16) = rq[i];
            *(u32x4*)(lds + SC_KS + row * 272 + lc * 16) = rk[i];
        }
        {
            const float kwr = __shfl(kw_, vr & 63);
            *(u32x4*)(lds + SC_VS + vr * 80 + vc * 16) = rv;
            u32x4 sv;
            sv.x = pk2(bflo(rv.x) * kwr, bfhi(rv.x) * kwr); sv.y = pk2(bflo(rv.y) * kwr, bfhi(rv.y) * kwr);
            sv.z = pk2(bflo(rv.z) * kwr, bfhi(rv.z) * kwr); sv.w = pk2(bflo(rv.w) * kwr, bfhi(rv.w) * kwr);
            *(u32x4*)(lds + SC_VW + vr * 80 + vc * 16) = sv;
            if (w == 0) { ((float*)(lds + SC_KW))[lane] = kw_; ((float*)(lds + SC_AK))[lane] = a_; }
        }
        __syncthreads();
        if (n + 1 < 33) load_chunk(n + 1);
        float4 cv[4];
        { int rt, kt; deferred_tile(conv_q0 + n * conv_stride, rt, kt); conv_load(p, rt, kt, tid, cv, cvt); }
        const int qrow = 16 * w + fr;
        bf16x8 qf[4];
#pragma unroll
        for (int ks = 0; ks < 4; ++ks) qf[ks] = *(const bf16x8*)(lds + SC_QS + qrow * 272 + (32 * ks + 8 * fq) * 2);
        f32x4 S[4];
#pragma unroll
        for (int nn = 0; nn < 4; ++nn) {
            const int krow = 32 * (nn >> 1) + 8 * (fr >> 2) + 4 * (nn & 1) + (fr & 3);
            f32x4 acc = (f32x4){0.f, 0.f, 0.f, 0.f};
#pragma unroll
            for (int ks = 0; ks < 4; ++ks) {
                const bf16x8 kf = *(const bf16x8*)(lds + SC_KS + krow * 272 + (32 * ks + 8 * fq) * 2);
                acc = __builtin_amdgcn_mfma_f32_16x16x32_bf16(kf, qf[ks], acc, 0, 0, 0);
            }
            S[nn] = acc;
        }
        const float bm_q = __shfl(bm_, qrow), winter_q = __shfl(winter_, qrow), em_q = __shfl(em_, qrow);
        float rsum = 0.f;
#pragma unroll
        for (int nn = 0; nn < 4; ++nn) {
            const int key0 = 32 * (nn >> 1) + 8 * fq + 4 * (nn & 1);
            const f32x4 ak = *(const f32x4*)(lds + SC_AK + key0 * 4);
#pragma unroll
            for (int jj = 0; jj < 4; ++jj) {
                const float dv = __expf(bm_q + ak[jj]);
                const float sv = (key0 + jj <= qrow) ? S[nn][jj] * dv : 0.f;
                S[nn][jj] = sv; rsum += sv;
            }
        }
        f32x4 O[2], OC[2];
#pragma unroll
        for (int ne = 0; ne < 2; ++ne) { O[ne] = (f32x4){0.f, 0.f, 0.f, 0.f}; OC[ne] = (f32x4){0.f, 0.f, 0.f, 0.f}; }
        {
            u32x2 v00a, v00b, v01a, v01b, v10a, v10b, v11a, v11b;
            tr_read8(trV, trV + 4 * 80, trV + 32, trV + 32 + 4 * 80, trV + 32 * 80, trV + 36 * 80, trV + 32 * 80 + 32, trV + 36 * 80 + 32,
                     v00a, v00b, v01a, v01b, v10a, v10b, v11a, v11b);
            u32x4 pw; bf16x8 pf;
            pw.x = pk2(S[0][0], S[0][1]); pw.y = pk2(S[0][2], S[0][3]); pw.z = pk2(S[1][0], S[1][1]); pw.w = pk2(S[1][2], S[1][3]); pf = __builtin_bit_cast(bf16x8, pw);
            O[0] = __builtin_amdgcn_mfma_f32_16x16x32_bf16(cat8(v00a, v00b), pf, O[0], 0, 0, 0);
            O[1] = __builtin_amdgcn_mfma_f32_16x16x32_bf16(cat8(v01a, v01b), pf, O[1], 0, 0, 0);
            pw.x = pk2(S[2][0], S[2][1]); pw.y = pk2(S[2][2], S[2][3]); pw.z = pk2(S[3][0], S[3][1]); pw.w = pk2(S[3][2], S[3][3]); pf = __builtin_bit_cast(bf16x8, pw);
            O[0] = __builtin_amdgcn_mfma_f32_16x16x32_bf16(cat8(v10a, v10b), pf, O[0], 0, 0, 0);
            O[1] = __builtin_amdgcn_mfma_f32_16x16x32_bf16(cat8(v11a, v11b), pf, O[1], 0, 0, 0);
        }
#pragma unroll
        for (int ks = 0; ks < 4; ++ks)
#pragma unroll
            for (int ne = 0; ne < 2; ++ne) {
                const bf16x8 cf = *(const bf16x8*)(lds + SC_CT + (16 * ne + fr) * 272 + (32 * ks + 8 * fq) * 2);
                OC[ne] = __builtin_amdgcn_mfma_f32_16x16x32_bf16(cf, qf[ks], OC[ne], 0, 0, 0);
            }
        float scC = winter_q, scS = 1.f;
        if (!RET) {
            float qn = 0.f;
#pragma unroll
            for (int ks = 0; ks < 4; ++ks) {
                const f32x4 n0 = *(const f32x4*)(lds + SC_NS + (32 * ks + 8 * fq) * 4), n1 = *(const f32x4*)(lds + SC_NS + (32 * ks + 8 * fq + 4) * 4);
                const u32x4 qw = __builtin_bit_cast(u32x4, qf[ks]);
                qn += bflo(qw.x) * n0[0] + bfhi(qw.x) * n0[1] + bflo(qw.y) * n0[2] + bfhi(qw.y) * n0[3]
                    + bflo(qw.z) * n1[0] + bfhi(qw.z) * n1[1] + bflo(qw.w) * n1[2] + bfhi(qw.w) * n1[3];
            }
            qn += __shfl_xor(qn, 16); qn += __shfl_xor(qn, 32);
            rsum += __shfl_xor(rsum, 16); rsum += __shfl_xor(rsum, 32);
            const float den = winter_q * qn + rsum;
            const float rden = 1.f / fmaxf(fabsf(den), em_q);
            scC = winter_q * rden; scS = rden;
        }
        {
            const int t = tok_of(n, qrow);
            if (t >= 0) {
                bf16_t* op = p.osc() + ((size_t)dir * T_ + tokb + t) * 1024 + (RET ? 512 : 0) + hh * 128 + eq * 32 + 4 * fq;
#pragma unroll
                for (int ne = 0; ne < 2; ++ne) {
                    const f32x4 o = OC[ne] * scC + O[ne] * scS;
                    u32x2 pk; pk.x = pk2(o[0], o[1]); pk.y = pk2(o[2], o[3]);
                    *(u32x2*)(op + 16 * ne) = pk;
                }
            }
        }
#pragma unroll
        for (int mt = 0; mt < 2; ++mt)
#pragma unroll
            for (int ne = 0; ne < 2; ++ne) Cacc[mt][ne] = Cacc[mt][ne] * w_state;
        nsum0 = 0.f; nsum1 = 0.f;
#pragma unroll
        for (int t = 0; t < 2; ++t) {
            u32x2 k0a, k0b, k1a, k1b, w0a, w0b, w1a, w1b;
            const unsigned ka = trK + 32 * t * 272, wa = trV + (SC_VW - SC_VS) + 32 * t * 80;
            tr_read8(ka, ka + 4 * 272, ka + 32, ka + 32 + 4 * 272, wa, wa + 4 * 80, wa + 32, wa + 32 + 4 * 80, k0a, k0b, k1a, k1b, w0a, w0b, w1a, w1b);
            const bf16x8 kf0 = cat8(k0a, k0b), kf1 = cat8(k1a, k1b), vf0 = cat8(w0a, w0b), vf1 = cat8(w1a, w1b);
            Cacc[0][0] = __builtin_amdgcn_mfma_f32_16x16x32_bf16(kf0, vf0, Cacc[0][0], 0, 0, 0);
            Cacc[0][1] = __builtin_amdgcn_mfma_f32_16x16x32_bf16(kf0, vf1, Cacc[0][1], 0, 0, 0);
            Cacc[1][0] = __builtin_amdgcn_mfma_f32_16x16x32_bf16(kf1, vf0, Cacc[1][0], 0, 0, 0);
            Cacc[1][1] = __builtin_amdgcn_mfma_f32_16x16x32_bf16(kf1, vf1, Cacc[1][1], 0, 0, 0);
            if (!RET) {
                const f32x4 kwa = *(const f32x4*)(lds + SC_KW + (32 * t + 8 * fq) * 4), kwb = *(const f32x4*)(lds + SC_KW + (32 * t + 8 * fq + 4) * 4);
                nsum0 += bflo(k0a.x) * kwa[0] + bfhi(k0a.x) * kwa[1] + bflo(k0a.y) * kwa[2] + bfhi(k0a.y) * kwa[3]
                       + bflo(k0b.x) * kwb[0] + bfhi(k0b.x) * kwb[1] + bflo(k0b.y) * kwb[2] + bfhi(k0b.y) * kwb[3];
                nsum1 += bflo(k1a.x) * kwa[0] + bfhi(k1a.x) * kwa[1] + bflo(k1a.y) * kwa[2] + bfhi(k1a.y) * kwa[3]
                       + bflo(k1b.x) * kwb[0] + bfhi(k1b.x) * kwb[1] + bflo(k1b.y) * kwb[2] + bfhi(k1b.y) * kwb[3];
            }
        }
        if (!RET) { nsum0 += __shfl_xor(nsum0, 16); nsum0 += __shfl_xor(nsum0, 32); nsum1 += __shfl_xor(nsum1, 16); nsum1 += __shfl_xor(nsum1, 32); }
        m_prev = m_new;
        if (n + 1 < 33) local_scan();
        conv_lds((float*)(lds + SC_CONV), cv, tid);
        __syncthreads();
        conv_store((const float*)(lds + SC_CONV), cvt, tid);
    }
}
__device__ void phase_scan(const P& p, int layer, unsigned char* lds, int bid, int nb) {
    for (int it = bid; it < 512; it += nb) {
        const int x = it & 7, y = it >> 3;
        const int ch = (y >> 2) * 8 + x, eq = y & 3;
        const int type = ch >> 6, b = (ch >> 3) & 7, hh = (ch >> 1) & 3, dir = ch & 1;
        const int q0 = (layer >> 1) * DEF_PER_SCAN + it;
        if (type == 0) scan_item<false>(p, layer, lds, b, hh, dir, eq, q0, 512);
        else scan_item<true>(p, layer, lds, b, hh, dir, eq, q0, 512);
    }
}

__device__ void phase_mixfin(const P& p, int layer, int bid, int nb) {
    const int tid = opaque_tid(), lane = tid & 63, wid = tid >> 6, j = layer >> 1;
    float4 g[4];
#pragma unroll
    for (int i = 0; i < 4; ++i) { const int f = 256 * i + 4 * lane; g[i] = (f < 512) ? *(const float4*)(p.e_mg + j * 512 + f) : *(const float4*)(p.e_rg + j * 512 + (f - 512)); }
    int tok = bid * 4 + wid;
    u32x2 an[4], cn_[4], gzn[4];
    auto ld = [&](int tk) {
#pragma unroll
        for (int i = 0; i < 4; ++i) {
            const int f = 256 * i + 4 * lane;
            const int gcol = (f < 512) ? (1536 + f) : (3584 + (f - 512));
            an[i] = *(const u32x2*)(p.osc() + (size_t)tk * 1024 + f);
            cn_[i] = *(const u32x2*)(p.osc() + ((size_t)T_ + tk) * 1024 + f);
            gzn[i] = *(const u32x2*)(p.ze() + (size_t)tk * 4096 + gcol);
        }
    };
    if (tok < T_) ld(tok);
#pragma unroll 1
    for (; tok < T_; tok += nb * 4) {
        u32x2 a[4], c[4], gz[4];
#pragma unroll
        for (int i = 0; i < 4; ++i) { a[i] = an[i]; c[i] = cn_[i]; gz[i] = gzn[i]; }
        if (tok + nb * 4 < T_) ld(tok + nb * 4);
#pragma unroll
        for (int i = 0; i < 4; ++i) {
            const float v[4] = {bflo(a[i].x) + bflo(c[i].x), bfhi(a[i].x) + bfhi(c[i].x), bflo(a[i].y) + bflo(c[i].y), bfhi(a[i].y) + bfhi(c[i].y)};
            const float gzv[4] = {bflo(gz[i].x), bfhi(gz[i].x), bflo(gz[i].y), bfhi(gz[i].y)};
            float ss = v[0] * v[0] + v[1] * v[1] + v[2] * v[2] + v[3] * v[3];
            for (int o = 16; o > 0; o >>= 1) ss += __shfl_xor(ss, o);
            const float r = rsqrtf(ss * (1.f / 128.f) + 1e-6f);
            const float gv[4] = {g[i].x, g[i].y, g[i].z, g[i].w};
            float o4[4];
#pragma unroll
            for (int c2 = 0; c2 < 4; ++c2) {
                const float sg = 1.f / (1.f + __expf(-gzv[c2]));
                const float gate = (i < 2) ? sg : gzv[c2] * sg;
                o4[c2] = gate * (v[c2] * r * gv[c2]);
            }
            u32x2 pk; pk.x = pk2(o4[0], o4[1]); pk.y = pk2(o4[2], o4[3]);
            *(u32x2*)(p.mix() + (size_t)tok * 1024 + 256 * i + 4 * lane) = pk;
        }
    }
}

__device__ void phase_cn(const P& p, int nl, unsigned char* lds, int bid, int nb, bool dry = false) {
    const int tid = opaque_tid(), lane = tid & 63, wid = tid >> 6;
    const bool even = (nl & 1) == 0 && nl < 4;
    const float* g = p.attn_g + (nl < 4 ? nl : 0) * D_;
    if (even) {
        __syncthreads();
        stage_proj16(lds, p.e_win + (size_t)(nl >> 1) * D_ * EVEN_IN + 2048, EVEN_IN, g, tid);
        __syncthreads();
    }
    Row16 gg; ld_f8(g + 8 * lane, gg.v[0]); ld_f8(g + 512 + 8 * lane, gg.v[1]);
    const int eme = e_of_lane(lane);
    const float gbias = p.e_gb[(nl < 4 ? (nl >> 1) : 0) * 16 + eme];
    auto ld_row = [&](int tk, Row16& dst) {
        if (nl != 0) ld_row_bf(p.h() + (size_t)tk * D_, lane, dst);
        else {
            const int b2 = tk / L_, t2 = tk - b2 * L_;
            const float* src = t2 < NM ? p.meta + (size_t)t2 * D_ : p.x + ((size_t)b2 * 2048 + (t2 - NM)) * D_;
            ld_f8(src + 8 * lane, dst.v[0]); ld_f8(src + 512 + 8 * lane, dst.v[1]);
        }
    };
    int tok = bid * 4 + wid;
    Row16 hn; int seln = -1;
    if (tok < T_) {
        ld_row(tok, hn);
        if (nl != 0) seln = p.sel()[(size_t)tok * 16 + (lane & 15)];
    }
#pragma unroll 1
    for (; tok < T_; tok += nb * 4) {
        const int b = tok / L_, t = tok - b * L_;
        Row16 hv = hn;
        const int sel_l = seln;
        {
            const int tn = tok + nb * 4;
            if (tn < T_) {
                ld_row(tn, hn);
                if (nl != 0) seln = p.sel()[(size_t)tn * 16 + (lane & 15)];
            }
        }
        if (nl != 0) {
            unsigned long long msk = __ballot(sel_l >= 0 && lane < 16);
            while (msk) {
                const int e0 = __builtin_ctzll(msk); msk &= msk - 1;
                int e1 = -1; if (msk) { e1 = __builtin_ctzll(msk); msk &= msk - 1; }
                const int s0 = __shfl(sel_l, e0), s1 = __shfl(sel_l, e1 < 0 ? e0 : e1);
                const bf16_t* y0 = p.ys() + ((size_t)(e0 * B_ + b) * CAP + s0) * D_;
                const bf16_t* y1 = p.ys() + ((size_t)((e1 < 0 ? e0 : e1) * B_ + b) * CAP + s1) * D_;
                Row16 a0, a1;
                ld_row_bf(y0, lane, a0); ld_row_bf(y1, lane, a1);
                const float w1 = e1 < 0 ? 0.f : 1.f;
#pragma unroll
                for (int i = 0; i < 2; ++i)
#pragma unroll
                    for (int c = 0; c < 8; ++c) hv.v[i][c] += a0.v[i][c] + w1 * a1.v[i][c];
            }
        }
        if (nl == 4) {
            if (t >= NM) {
                float* op = p.out + ((size_t)b * 2048 + (t - NM)) * D_;
#pragma unroll
                for (int i = 0; i < 2; ++i) {
                    *(float4*)(op + 512 * i + 8 * lane) = make_float4(hv.v[i][0], hv.v[i][1], hv.v[i][2], hv.v[i][3]);
                    *(float4*)(op + 512 * i + 8 * lane + 4) = make_float4(hv.v[i][4], hv.v[i][5], hv.v[i][6], hv.v[i][7]);
                }
            }
            continue;
        }
        if (!dry) {
#pragma unroll
            for (int i = 0; i < 2; ++i) st_bf8(p.h() + (size_t)tok * D_ + 512 * i + 8 * lane, hv.v[i]);
        }
        const float r = rsqrtf(wave_sum(row_sumsq(hv)) * (1.f / D_) + 1e-6f);
#pragma unroll
        for (int i = 0; i < 2; ++i) {
            float uu[8];
#pragma unroll
            for (int c = 0; c < 8; ++c) uu[c] = hv.v[i][c] * r * gg.v[i][c];
            st_bf8(p.u() + (size_t)tok * D_ + 512 * i + 8 * lane, uu);
        }
        if (even) {
            float acc[16];
            proj16_accum(lds, hv, lane, acc);
            const float gv = reduce_scatter16(acc, lane) * r + gbias;
            if ((lane & 3) == 0) p.gts()[(size_t)tok * 16 + eme] = gv;
        }
    }
}

#define XB_TMO      128
#define XB_XCNT(j)  (256  + 64 * (j))
#define XB_XSUB(j)  (1280 + 64 * (j))
#define XB_XGEN(j)  (2304 + 64 * (j))
#define XB_TOP      3328
#define XB_TOPGEN   3392
#define XB_SPIN_CAP (1u << 22)
#define LAS __attribute__((address_space(3)))
__device__ __forceinline__ unsigned xb_ld(unsigned* p)              { return __hip_atomic_load(p, __ATOMIC_RELAXED, __HIP_MEMORY_SCOPE_AGENT); }
__device__ __forceinline__ unsigned xb_add(unsigned* p, unsigned v) { return __hip_atomic_fetch_add(p, v, __ATOMIC_RELAXED, __HIP_MEMORY_SCOPE_AGENT); }
__device__ __forceinline__ unsigned xb_xcc_id() { return (unsigned)__builtin_amdgcn_s_getreg((3 << 11) | 20) & 0xFu; }
#define XB_SPIN(cond, bar) do { unsigned _sp = 0; while (cond) { __builtin_amdgcn_s_sleep(1); \
    if ((++_sp & 255u) == 0u) { if (xb_ld(&(bar)[XB_TMO])) break; if (_sp > XB_SPIN_CAP) { atomicAdd(&(bar)[XB_TMO], 1u); break; } } } } while (0)
struct XcdBarrier { unsigned* bar; unsigned x; unsigned nloc, nx, epoch; };
__device__ __forceinline__ XcdBarrier xcd_barrier_post(unsigned* bar) {
    XcdBarrier b; b.bar = bar; b.x = xb_xcc_id(); b.nloc = 0u; b.nx = 0u; b.epoch = 0u;
    if (threadIdx.x == 0) (void)xb_add(&bar[XB_XCNT(b.x)], 1u);
    return b;
}
__device__ __forceinline__ void xcd_barrier_complete(unsigned* bar, unsigned x, unsigned& nloc, unsigned& nx) {
    const unsigned G = gridDim.x * gridDim.y * gridDim.z;
    unsigned sum, cnt, mine, sp = 0u;
    for (;;) {
        sum = 0u; cnt = 0u; mine = 0u;
#pragma unroll
        for (unsigned j = 0; j < 16; ++j) { const unsigned c = xb_ld(&bar[XB_XCNT(j)]); sum += c; cnt += (c > 0u) ? 1u : 0u; mine = (j == x) ? c : mine; }
        if (sum == G) break;
        __builtin_amdgcn_s_sleep(1);
        if ((++sp & 255u) == 0u) { if (xb_ld(&bar[XB_TMO])) break; if (sp > XB_SPIN_CAP) { atomicAdd(&bar[XB_TMO], 1u); break; } }
    }
    nloc = mine > 0u ? mine : 1u; nx = cnt > 0u ? cnt : 1u;
}
__device__ __forceinline__ void xcd_barrier(XcdBarrier& b) {
    asm volatile("s_waitcnt vmcnt(0)" ::: "memory");
    __syncthreads();
    if (threadIdx.x == 0) {
        unsigned* bar = b.bar; unsigned bx = b.x;
        asm volatile("" : "+s"(bar), "+s"(bx));
        __builtin_amdgcn_s_waitcnt(0);
        const unsigned nloc = b.nloc, nx = b.nx;
        const unsigned old = xb_add(&bar[XB_XSUB(bx)], 1u);
        const unsigned gen = b.epoch;
        if (old + 1u == (gen + 1u) * nloc) {
            __builtin_amdgcn_fence(__ATOMIC_RELEASE, "agent");
            asm volatile("s_waitcnt vmcnt(0)" ::: "memory");
            const unsigned og = xb_add(&bar[XB_TOP], 1u);
            const unsigned tg = b.epoch;
            if (og + 1u == (tg + 1u) * nx) xb_add(&bar[XB_TOPGEN], 1u);
            else XB_SPIN(xb_ld(&bar[XB_TOPGEN]) == tg, bar);
            __builtin_amdgcn_fence(__ATOMIC_ACQUIRE, "agent");
            xb_add(&bar[XB_XGEN(bx)], 1u);
            asm volatile("s_waitcnt vmcnt(0)" ::: "memory");
        } else {
            XB_SPIN(xb_ld(&bar[XB_XGEN(bx)]) == gen, bar);
            __builtin_amdgcn_fence(__ATOMIC_ACQUIRE, "agent");
            asm volatile("s_waitcnt vmcnt(0)" ::: "memory");
        }
    }
    b.epoch += 1u;
    __syncthreads();
}

typedef const __attribute__((address_space(4))) unsigned long long* KArg;
__device__ __forceinline__ P load_args(KArg k) {
    asm volatile("" : "+s"(k));
    P p;
    p.x = (const float*)k[0]; p.meta = (const float*)k[1]; p.attn_g = (const float*)k[2]; p.ffn_g = (const float*)k[3]; p.e_win = (const float*)k[4];
    p.e_conv = (const float*)k[5]; p.e_gb = (const float*)k[6]; p.e_mg = (const float*)k[7]; p.e_decay = (const float*)k[8]; p.e_rg = (const float*)k[9];
    p.e_wout = (const float*)k[10]; p.o_win = (const float*)k[11]; p.o_qg = (const float*)k[12]; p.o_kg = (const float*)k[13]; p.o_rpb = (const float*)k[14];
    p.o_wout = (const float*)k[15]; p.router_w = (const float*)k[16]; p.w_gate = (const float*)k[17]; p.w_up = (const float*)k[18]; p.w_down = (const float*)k[19];
    p.out = (float*)k[20]; p.ws = (unsigned char*)k[21];
    return p;
}
#define PH(call) { const P p = load_args(kp); int bid = bid_, nb = nb_; asm volatile("" : "+s"(bid), "+s"(nb)); call; }
__global__ void __launch_bounds__(NTHR, 2) k_mega(P p_unused) {
    extern __shared__ __attribute__((aligned(16))) unsigned char lds_raw[];
    unsigned char* lds = lds_raw;
    const KArg kp = (KArg)__builtin_amdgcn_kernarg_segment_ptr();
    const int bid_ = blockIdx.x, nb_ = gridDim.x;
    XcdBarrier xb;
    { const P p = load_args(kp); xb = xcd_barrier_post(p.bar()); }
    if (threadIdx.x == 0) { unsigned nloc, nx; xcd_barrier_complete(xb.bar, xb.x, nloc, nx); ((volatile unsigned*)lds)[0] = nloc; ((volatile unsigned*)lds)[1] = nx; }
    __syncthreads();
    xb.nloc = (unsigned)__builtin_amdgcn_readfirstlane((int)((volatile unsigned*)lds)[0]);
    xb.nx = (unsigned)__builtin_amdgcn_readfirstlane((int)((volatile unsigned*)lds)[1]);
    __syncthreads();
#define GB() xcd_barrier(xb)
    PH(phase_tables(p, bid, nb));
    PH(phase_convert(p, lds, bid, nb));
    PH(phase_cn(p, 0, lds, bid, nb));
    GB();
#if PROBE_BARRIER
    for (int i = 0; i < 100; ++i) GB();
#endif
#pragma nounroll
    for (int layer = 0; layer < 4; ++layer) {
        if ((layer & 1) == 0) {
            PH(phase_even_in(p, layer, lds, bid, nb)); GB();
            PH(phase_conv(p, layer, bid, nb)); GB();
#if PROBE_CONV
            PH(phase_conv(p, layer, bid, nb)); GB();
#endif
            PH(phase_scan(p, layer, lds, bid, nb)); GB();
#if PROBE_SCAN
            PH(phase_scan(p, layer, lds, bid, nb)); GB();
#endif
            PH(phase_mixfin(p, layer, bid, nb)); GB();
#if PROBE_MIXFIN
            PH(phase_mixfin(p, layer, bid, nb)); GB();
#endif
            PH(phase_outproj(p, p.WoutE() + (size_t)(layer >> 1) * 1024 * 1024, lds, bid, nb)); GB();
        } else {
            PH(phase_odd_in(p, layer, lds, bid, nb)); GB();
            PH(phase_natten(p, layer, lds, bid, nb)); GB();
#if PROBE_NATTEN
            PH(phase_natten(p, layer, lds, bid, nb)); GB();
#endif
            PH(phase_outproj(p, p.WoutO() + (size_t)(layer >> 1) * 1024 * 1024, lds, bid, nb)); GB();
        }
        PH(phase_router(p, layer, lds, bid, nb)); GB();
#if PROBE_ROUTER
        PH(phase_router(p, layer, lds, bid, nb)); GB();
#endif
        PH(phase_topk(p, lds, bid, nb)); GB();
        PH(phase_gateup(p, layer, lds, bid, nb)); GB();
        PH(phase_down(p, layer, lds, bid, nb)); GB();
#if PROBE_CN
        PH(phase_cn(p, layer + 1, lds, bid, nb, true)); GB();
#endif
        PH(phase_cn(p, layer + 1, lds, bid, nb));
        if (layer < 3) GB();
    }
}

static inline size_t al256(size_t x) { return (x + 255) & ~(size_t)255; }

extern "C" void kernel_launch(void* const* d_in, const int* in_sizes, int n_in, void* d_out, int out_size, void* d_ws, size_t ws_size, hipStream_t stream) {
    P p; memset(&p, 0, sizeof(p));
    p.x = (const float*)d_in[0]; p.meta = (const float*)d_in[1]; p.attn_g = (const float*)d_in[2]; p.ffn_g = (const float*)d_in[3];
    p.e_win = (const float*)d_in[4]; p.e_conv = (const float*)d_in[5]; p.e_gb = (const float*)d_in[6]; p.e_mg = (const float*)d_in[7];
    p.e_decay = (const float*)d_in[8]; p.e_rg = (const float*)d_in[9]; p.e_wout = (const float*)d_in[10]; p.o_win = (const float*)d_in[11];
    p.o_qg = (const float*)d_in[12]; p.o_kg = (const float*)d_in[13]; p.o_rpb = (const float*)d_in[14]; p.o_wout = (const float*)d_in[15];
    p.router_w = (const float*)d_in[16]; p.w_gate = (const float*)d_in[17]; p.w_up = (const float*)d_in[18]; p.w_down = (const float*)d_in[19];
    p.out = (float*)d_out;

    p.ws = (unsigned char*)d_ws;
    if (WS_NEEDED > ws_size) return;

    static int grid_blocks = 0;
    if (!grid_blocks) {
        int dev = 0, cus = 0, per_cu = 0;
        if (hipGetDevice(&dev) != hipSuccess) return;
        if (hipDeviceGetAttribute(&cus, hipDeviceAttributeMultiprocessorCount, dev) != hipSuccess) return;
        if (hipFuncSetAttribute((const void*)k_mega, hipFuncAttributeMaxDynamicSharedMemorySize, LDS_BYTES) != hipSuccess) return;
        if (hipOccupancyMaxActiveBlocksPerMultiprocessor(&per_cu, (const void*)k_mega, NTHR, LDS_BYTES) != hipSuccess || per_cu < 1) return;
        if (per_cu > 2) per_cu = 2;
        cus &= ~7;
        if (cus < 8) return;
        grid_blocks = cus * per_cu;
    }
    (void)hipMemsetAsync(p.ws + OFF_BAR, 0, 16384, stream);
    hipLaunchKernelGGL(k_mega, dim3(grid_blocks), dim3(NTHR), LDS_BYTES, stream, p);
}
```

```cpp
#include <hip/hip_runtime.h>
#include <stdint.h>
#include <string.h>

#ifndef PROBE_GEMM
#define PROBE_GEMM 0
#endif
#ifndef PROBE_SCAN
#define PROBE_SCAN 0
#endif
#ifndef PROBE_CONVERT
#define PROBE_CONVERT 0
#endif
#ifndef PROBE_NATTEN
#define PROBE_NATTEN 0
#endif
#ifndef PROBE_MISC
#define PROBE_MISC 0
#endif
#ifndef PROBE_MIXFIN
#define PROBE_MIXFIN 0
#endif
#ifndef PROBE_ROUTER
#define PROBE_ROUTER 0
#endif
#ifndef PROBE_TOPK
#define PROBE_TOPK 0
#endif
#ifndef PROBE_BARRIER
#define PROBE_BARRIER 0
#endif
#ifndef PROBE_CN
#define PROBE_CN 0
#endif
#ifndef PROBE_DMA
#define PROBE_DMA 0
#endif
#ifndef PROBE_STAGE
#define PROBE_STAGE 0
#endif
#ifndef PROBE_KLOOP
#define PROBE_KLOOP 0
#endif
#ifndef PROBE_EPI
#define PROBE_EPI 0
#endif
#define B_ 8
#define L_ 2064
#define T_ (B_ * L_)
#define D_ 1024
#define NM 16
#define EVEN_IN 4112
#define ODD_IN 3072
#define NE 16
#define CAP 258
#define NG (B_ * NE)

__device__ __forceinline__ float block_sum256(float v, float* red) {
    for (int o = 32; o > 0; o >>= 1) v += __shfl_xor(v, o);
    __syncthreads();
    if ((threadIdx.x & 63) == 0) red[threadIdx.x >> 6] = v;
    __syncthreads();
    return red[0] + red[1] + red[2] + red[3];
}
__device__ __forceinline__ float sigmoidf_(float x) { return 1.f / (1.f + expf(-x)); }
__device__ __forceinline__ float siluf_(float x) { return x / (1.f + expf(-x)); }
__device__ __forceinline__ float logsigmoidf_(float x) { return fminf(x, 0.f) - log1pf(expf(-fabsf(x))); }


typedef unsigned short bf16_t;
typedef short bf16x8 __attribute__((ext_vector_type(8)));
typedef float f32x4 __attribute__((ext_vector_type(4)));
typedef unsigned u32x4 __attribute__((ext_vector_type(4)));
typedef unsigned u32x2 __attribute__((ext_vector_type(2)));

#define NTHR 256
#define ESLOTS 2064
#define LDS_BYTES (80 * 1024)

__device__ __forceinline__ unsigned f2bf(float f) { unsigned u = __builtin_bit_cast(unsigned, f); return (u + 0x7fffu + ((u >> 16) & 1u)) >> 16; }
__device__ __forceinline__ unsigned pk2(float lo, float hi) { return f2bf(lo) | (f2bf(hi) << 16); }
__device__ __forceinline__ float bf2f(unsigned short b) { return __builtin_bit_cast(float, (unsigned)b << 16); }
__device__ __forceinline__ float bflo(unsigned w) { return __builtin_bit_cast(float, w << 16); }
__device__ __forceinline__ float bfhi(unsigned w) { return __builtin_bit_cast(float, w & 0xffff0000u); }

#define AL256(x) (((x) + 255) & ~(size_t)255)
constexpr size_t OFF_BAR = 0;
constexpr size_t OFF_WGU = 16384;
constexpr size_t OFF_WD = OFF_WGU + AL256((size_t)4 * 16 * 2048 * 1024 * 2);
constexpr size_t OFF_WINE = OFF_WD + AL256((size_t)4 * 16 * 1024 * 1024 * 2);
constexpr size_t OFF_WINO = OFF_WINE + AL256((size_t)2 * 4096 * 1024 * 2);
constexpr size_t OFF_WOUTE = OFF_WINO + AL256((size_t)2 * 3072 * 1024 * 2);
constexpr size_t OFF_WOUTO = OFF_WOUTE + AL256((size_t)2 * 1024 * 1024 * 2);
constexpr size_t OFF_H = OFF_WOUTO + AL256((size_t)2 * 1024 * 1024 * 2);
constexpr size_t OFF_U = OFF_H + AL256((size_t)T_ * D_ * 4);
constexpr size_t OFF_ZE = OFF_U + AL256((size_t)T_ * D_ * 2);
constexpr size_t OFF_QC = OFF_ZE + AL256((size_t)T_ * 4096 * 2);
constexpr size_t OFF_OSC = OFF_QC + AL256((size_t)T_ * D_ * 2);
constexpr size_t OFF_MIX = OFF_OSC + AL256((size_t)2 * T_ * D_ * 2);
constexpr size_t OFF_GTS = OFF_MIX + AL256((size_t)T_ * D_ * 2);
constexpr size_t OFF_AFF = OFF_GTS + AL256((size_t)T_ * 16 * 4);
constexpr size_t OFF_GATE = OFF_AFF + AL256((size_t)T_ * 16 * 4);
constexpr size_t OFF_IDX = OFF_GATE + AL256((size_t)NE * ESLOTS * 4);
constexpr size_t OFF_SEL = OFF_IDX + AL256((size_t)NE * ESLOTS * 4);
constexpr size_t OFF_COS = OFF_SEL + AL256((size_t)T_ * 16 * 4);
constexpr size_t OFF_SIN = OFF_COS + AL256((size_t)L_ * 64 * 4);
constexpr size_t WS_NEEDED = OFF_SIN + AL256((size_t)L_ * 64 * 4);

__device__ __forceinline__ int opaque_tid() { int t = threadIdx.x; asm volatile("" : "+v"(t)); return t; }

struct P {
    const float *x, *meta, *attn_g, *ffn_g, *e_win, *e_conv, *e_gb, *e_mg, *e_decay, *e_rg, *e_wout, *o_win, *o_qg, *o_kg, *o_rpb, *o_wout, *router_w, *w_gate, *w_up, *w_down;
    float* out;
    unsigned char* ws;
    __device__ __forceinline__ unsigned* bar() const { return (unsigned*)(ws + OFF_BAR); }
    __device__ __forceinline__ bf16_t* Wgu() const { return (bf16_t*)(ws + OFF_WGU); }
    __device__ __forceinline__ bf16_t* Wd() const { return (bf16_t*)(ws + OFF_WD); }
    __device__ __forceinline__ bf16_t* WinE() const { return (bf16_t*)(ws + OFF_WINE); }
    __device__ __forceinline__ bf16_t* WinO() const { return (bf16_t*)(ws + OFF_WINO); }
    __device__ __forceinline__ bf16_t* WoutE() const { return (bf16_t*)(ws + OFF_WOUTE); }
    __device__ __forceinline__ bf16_t* WoutO() const { return (bf16_t*)(ws + OFF_WOUTO); }
    __device__ __forceinline__ bf16_t* h() const { return (bf16_t*)(ws + OFF_H); }
    __device__ __forceinline__ bf16_t* u() const { return (bf16_t*)(ws + OFF_U); }
    __device__ __forceinline__ bf16_t* ze() const { return (bf16_t*)(ws + OFF_ZE); }
    __device__ __forceinline__ bf16_t* zo() const { return (bf16_t*)(ws + OFF_ZE); }
    __device__ __forceinline__ bf16_t* vT() const { return (bf16_t*)(ws + OFF_ZE) + (size_t)T_ * 2048; }
    __device__ __forceinline__ bf16_t* ys() const { return (bf16_t*)(ws + OFF_ZE); }
    __device__ __forceinline__ bf16_t* qc() const { return (bf16_t*)(ws + OFF_QC); }
    __device__ __forceinline__ bf16_t* osc() const { return (bf16_t*)(ws + OFF_OSC); }
    __device__ __forceinline__ bf16_t* hdn() const { return (bf16_t*)(ws + OFF_OSC); }
    __device__ __forceinline__ bf16_t* mix() const { return (bf16_t*)(ws + OFF_MIX); }
    __device__ __forceinline__ float* gts() const { return (float*)(ws + OFF_GTS); }
    __device__ __forceinline__ float* aff() const { return (float*)(ws + OFF_AFF); }
    __device__ __forceinline__ float* gate() const { return (float*)(ws + OFF_GATE); }
    __device__ __forceinline__ int* idx() const { return (int*)(ws + OFF_IDX); }
    __device__ __forceinline__ int* sel() const { return (int*)(ws + OFF_SEL); }
    __device__ __forceinline__ float* costab() const { return (float*)(ws + OFF_COS); }
    __device__ __forceinline__ float* sintab() const { return (float*)(ws + OFF_SIN); }
};

__device__ __forceinline__ void conv_desc(const P& p, int rt, const float*& src_base, size_t& le_off, int& ld, bf16_t*& dst, int& kind, int& n0) {
    le_off = 0;
    if (rt < 2048) { const int le = rt >> 5, t = rt & 31; kind = 1; ld = 1024; src_base = p.w_gate; le_off = (size_t)le * 1024 * 1024; dst = p.Wgu() + (size_t)le * 2048 * 1024; n0 = t * 64; return; }
    rt -= 2048;
    if (rt < 1024) { const int le = rt >> 4, t = rt & 15; kind = 3; ld = 1024; src_base = p.w_down + (size_t)le * 1024 * 1024; dst = p.Wd() + (size_t)le * 1024 * 1024; n0 = t * 64; return; }
    rt -= 1024;
    if (rt < 128) { const int j = rt >> 6, t = rt & 63; kind = 2; ld = EVEN_IN; src_base = p.e_win + (size_t)j * 1024 * EVEN_IN; dst = p.WinE() + (size_t)j * 4096 * 1024; n0 = t * 64; return; }
    rt -= 128;
    if (rt < 96) { const int j = rt / 48, t = rt % 48; kind = (t < 32) ? 3 : 0; ld = ODD_IN; src_base = p.o_win + (size_t)j * 1024 * ODD_IN; dst = p.WinO() + (size_t)j * 3072 * 1024; n0 = t * 64; return; }
    rt -= 96;
    if (rt < 32) { const int j = rt >> 4, t = rt & 15; kind = 3; ld = 1024; src_base = p.e_wout + (size_t)j * 1024 * 1024; dst = p.WoutE() + (size_t)j * 1024 * 1024; n0 = t * 64; return; }
    rt -= 32;
    { const int j = rt >> 4, t = rt & 15; kind = 3; ld = 1024; src_base = p.o_wout + (size_t)j * 1024 * 1024; dst = p.WoutO() + (size_t)j * 1024 * 1024; n0 = t * 64; return; }
}
#define N_CONV_ROWTILES 3360
struct ConvTile { bf16_t* dst; int n0, k0; };
__device__ __forceinline__ void conv_load(const P& p, int rt, int kt, int tid, float4 (&cv)[4], ConvTile& ct) {
    const int tn4 = tid & 15, tk = tid >> 4, k0 = kt * 64;
    const float* src_base; size_t le_off; int ld, kind, n0; bf16_t* dst;
    conv_desc(p, rt, src_base, le_off, ld, dst, kind, n0);
    const int n = n0 + tn4 * 4;
    const float* sp;
    if (kind == 0) sp = src_base + n;
    else if (kind == 3) {
        const int r = n & 31, nn = r >> 4, i = r & 15;
        sp = src_base + (n & ~31) + 8 * (i >> 2) + 4 * nn + (i & 3);
    }
    else if (kind == 1) {
        const int tn = n >> 7, r = n & 127, wc = r >> 6, nn = (r >> 4) & 3, i = r & 15;
        const int col = 64 * tn + 32 * wc + 8 * (i >> 2) + 4 * (nn & 1) + (i & 3);
        sp = ((nn < 2) ? p.w_gate : p.w_up) + le_off + col;
    } else {
        const int seg = n >> 9, j = n & 511;
        const int base = seg < 4 ? seg * 512 : 2064 + (seg - 4) * 512;
        int col;
        if (seg == 4 || seg == 5) {
            const int head = j >> 7, r = j & 127, wc = r >> 6, nn = (r >> 4) & 3, i = r & 15;
            col = head * 128 + (nn & 1) * 64 + 32 * wc + 8 * (i >> 2) + 4 * (nn >> 1) + (i & 3);
        } else {
            const int r = j & 31, nn = r >> 4, i = r & 15;
            col = (j & ~31) + 8 * (i >> 2) + 4 * nn + (i & 3);
        }
        sp = src_base + base + col;
    }
#pragma unroll
    for (int i = 0; i < 4; ++i) cv[i] = *(const float4*)(sp + (size_t)(k0 + tk + 16 * i) * ld);
    ct.dst = dst; ct.n0 = n0; ct.k0 = k0;
}
__device__ __forceinline__ void conv_lds(float* tile, const float4 (&cv)[4], int tid) {
    const int tn4 = tid & 15, tk = tid >> 4;
#pragma unroll
    for (int i = 0; i < 4; ++i) {
        const int kk = tk + 16 * i;
        tile[(tn4 * 4 + 0) * 65 + kk] = cv[i].x; tile[(tn4 * 4 + 1) * 65 + kk] = cv[i].y; tile[(tn4 * 4 + 2) * 65 + kk] = cv[i].z; tile[(tn4 * 4 + 3) * 65 + kk] = cv[i].w;
    }
}
__device__ __forceinline__ void conv_store(const float* tile, const ConvTile& ct, int tid) {
    const int row = tid >> 2, sg = tid & 3;
    const float* tr = tile + row * 65 + sg * 16;
    u32x4 w0, w1;
    w0.x = pk2(tr[0], tr[1]); w0.y = pk2(tr[2], tr[3]); w0.z = pk2(tr[4], tr[5]); w0.w = pk2(tr[6], tr[7]);
    w1.x = pk2(tr[8], tr[9]); w1.y = pk2(tr[10], tr[11]); w1.z = pk2(tr[12], tr[13]); w1.w = pk2(tr[14], tr[15]);
    bf16_t* dp = ct.dst + (size_t)(ct.n0 + row) * 1024 + ct.k0 + sg * 16;
    *(u32x4*)dp = w0; *(u32x4*)(dp + 8) = w1;
}
#define DEF_PER_LAYER 12288
#define DEF_PER_SCAN (33 * 512)
#define DEF_TOTAL (3 * DEF_PER_LAYER)
__device__ __forceinline__ void deferred_tile(int q, int& rt, int& kt) {
    const int layer = 1 + q / DEF_PER_LAYER, r = q % DEF_PER_LAYER, rtl = r >> 4;
    kt = r & 15;
    rt = (rtl < 512) ? (512 * layer + rtl) : (2048 + 256 * layer + (rtl - 512));
}
#define P0_RTS (512 + 256 + 288)
#define P0_TILES (P0_RTS * 16 + (DEF_TOTAL - 2 * DEF_PER_SCAN))
__device__ void phase_convert(const P& p, unsigned char* lds, int bid, int nb) {
    float* tile = (float*)lds;
    const int tid = opaque_tid();
    for (int it0 = 0; it0 < P0_TILES; it0 += nb) {
        const bool valid = it0 + bid < P0_TILES;
        const int it = valid ? it0 + bid : P0_TILES - 1;
        int rt, kt;
        if (it < P0_RTS * 16) { const int r = it >> 4; kt = it & 15; rt = r < 512 ? r : (r < 768 ? 2048 + (r - 512) : 3072 + (r - 768)); }
        else deferred_tile(2 * DEF_PER_SCAN + (it - P0_RTS * 16), rt, kt);
        float4 cv[4]; ConvTile ct;
        conv_load(p, rt, kt, tid, cv, ct);
        __syncthreads();
        conv_lds(tile, cv, tid);
        __syncthreads();
        if (valid) conv_store(tile, ct, tid);
    }
}

struct TileAddr { const char* ab; const char* bb; unsigned ao[6]; unsigned bo; };
typedef __attribute__((address_space(3))) unsigned LdsU;
typedef const __attribute__((address_space(1))) unsigned GlbU;
__device__ __forceinline__ unsigned gemm_chunk_off(int tid) { return (unsigned)(((tid & 7) ^ ((tid >> 4) & 7)) * 16); }
template <int MT>
__device__ __forceinline__ void gemm_stage(const TileAddr& t, unsigned char* lds, int st, int ko, int tid) {
    constexpr int ABYTES = 4096 * MT, SBYTES = ABYTES + 16384;
    const char* a_ = t.ab + ko * 2; const char* b_ = t.bb + ko * 2;
    LdsU* d_ = (LdsU*)(lds + st * SBYTES + tid * 16);
#pragma unroll
    for (int i = 0; i < MT; ++i) __builtin_amdgcn_global_load_lds((GlbU*)(a_ + (size_t)t.ao[i]), d_ + 1024 * i, 16, 0, 0);
    LdsU* e_ = d_ + ABYTES / 4;
#pragma unroll
    for (int i = 0; i < 4; ++i) __builtin_amdgcn_global_load_lds((GlbU*)(b_ + i * 65536 + (size_t)t.bo), e_ + 1024 * i, 16, 0, 0);
}
template <bool SWAP, int MT>
__device__ __forceinline__ void gemm_tile(const TileAddr& t, unsigned char* lds, f32x4 (&acc)[MT][4], int tid) {
    constexpr int K = 1024, ABYTES = 4096 * MT, SBYTES = ABYTES + 16384;
    const int lane = tid & 63, wid = tid >> 6, wr = wid >> 1, wc = wid & 1, fr = lane & 15, fq = lane >> 4;
    const int sw = (fr >> 1) & 7;
    const int aofs = (wr * 16 * MT + fr) * 128, bofs = ABYTES + (wc * 64 + fr) * 128;
    const int c0 = ((0 + fq) ^ sw) << 4, c1 = ((4 + fq) ^ sw) << 4;
#pragma unroll
    for (int m = 0; m < MT; ++m)
#pragma unroll
        for (int n = 0; n < 4; ++n) acc[m][n] = (f32x4){0.f, 0.f, 0.f, 0.f};
#define GT_COMPUTE(st) { const unsigned char* sA = lds + (st) * SBYTES + aofs; const unsigned char* sB = lds + (st) * SBYTES + bofs; \
        _Pragma("unroll") for (int kk = 0; kk < 2; ++kk) { const int cc = kk ? c1 : c0; bf16x8 af[MT], bf[4]; \
            _Pragma("unroll") for (int m = 0; m < MT; ++m) af[m] = *(const bf16x8*)(sA + m * 2048 + cc); \
            _Pragma("unroll") for (int n = 0; n < 4; ++n) bf[n] = *(const bf16x8*)(sB + n * 2048 + cc); \
            __builtin_amdgcn_s_setprio(1); \
            _Pragma("unroll") for (int m = 0; m < MT; ++m) _Pragma("unroll") for (int n = 0; n < 4; ++n) { \
                if (SWAP) acc[m][n] = __builtin_amdgcn_mfma_f32_16x16x32_bf16(af[m], bf[n], acc[m][n], 0, 0, 0); \
                else      acc[m][n] = __builtin_amdgcn_mfma_f32_16x16x32_bf16(bf[n], af[m], acc[m][n], 0, 0, 0); } \
            __builtin_amdgcn_s_setprio(0); \
            if (MT > 4) __builtin_amdgcn_sched_barrier(0); } }
    constexpr int nk = K >> 6;
    gemm_stage<MT>(t, lds, 0, 0, tid);
    __syncthreads();
#pragma unroll 1
    for (int kt = 0; kt < nk - 2; kt += 2) {
        gemm_stage<MT>(t, lds, 1, (kt + 1) * 64, tid);
        GT_COMPUTE(0);
        __syncthreads();
        gemm_stage<MT>(t, lds, 0, (kt + 2) * 64, tid);
        GT_COMPUTE(1);
        __syncthreads();
    }
    gemm_stage<MT>(t, lds, 1, (nk - 1) * 64, tid);
    GT_COMPUTE(0);
    __syncthreads();
    GT_COMPUTE(1);
    __syncthreads();
#undef GT_COMPUTE
}
template <int MT>
__device__ __forceinline__ void tile_addr_rows(TileAddr& t, const bf16_t* A, int row0, const bf16_t* W, int nt, int tid) {
    const int lrow = tid >> 3; const unsigned ch = gemm_chunk_off(tid);
    t.ab = (const char*)A; t.bb = (const char*)W; t.bo = (unsigned)(nt * 128 + lrow) * 2048u + ch;
#pragma unroll
    for (int i = 0; i < MT; ++i) t.ao[i] = (unsigned)(row0 + lrow + 32 * i) * 2048u + ch;
}

struct Row16 { float v[2][8]; };
__device__ __forceinline__ void ld_bf8(const bf16_t* q, float (&d)[8]) {
    const u32x4 w = *(const u32x4*)q;
    d[0] = bflo(w.x); d[1] = bfhi(w.x); d[2] = bflo(w.y); d[3] = bfhi(w.y); d[4] = bflo(w.z); d[5] = bfhi(w.z); d[6] = bflo(w.w); d[7] = bfhi(w.w);
}
__device__ __forceinline__ void st_bf8(bf16_t* q, const float (&d)[8]) {
    u32x4 w; w.x = pk2(d[0], d[1]); w.y = pk2(d[2], d[3]); w.z = pk2(d[4], d[5]); w.w = pk2(d[6], d[7]); *(u32x4*)q = w;
}
__device__ __forceinline__ void ld_f8(const float* q, float (&d)[8]) {
    const float4 a = *(const float4*)q, b = *(const float4*)(q + 4);
    d[0] = a.x; d[1] = a.y; d[2] = a.z; d[3] = a.w; d[4] = b.x; d[5] = b.y; d[6] = b.z; d[7] = b.w;
}
__device__ __forceinline__ void ld_row_bf(const bf16_t* row, int lane, Row16& r) { ld_bf8(row + 8 * lane, r.v[0]); ld_bf8(row + 512 + 8 * lane, r.v[1]); }
__device__ __forceinline__ float row_sumsq(const Row16& r) {
    float s = 0.f;
#pragma unroll
    for (int i = 0; i < 2; ++i)
#pragma unroll
        for (int c = 0; c < 8; ++c) s += r.v[i][c] * r.v[i][c];
    return s;
}
__device__ __forceinline__ void stage_proj16(unsigned char* lds, const float* W, int ldw, const float* g, int tid) {
#pragma unroll
    for (int r = 0; r < 4; ++r) {
        const int k = tid + 256 * r;
        const int i = k >> 9, ln = (k >> 3) & 63, c = k & 7;
        const int rho = 64 * (8 * i + c) + ln;
        const float gk = g[k];
        const float4* wp = (const float4*)(W + (size_t)k * ldw);
#pragma unroll
        for (int ch = 0; ch < 4; ++ch) {
            float4 w = wp[ch]; w.x *= gk; w.y *= gk; w.z *= gk; w.w *= gk;
            *(float4*)(lds + rho * 64 + ((ch ^ ((rho >> 2) & 3)) << 4)) = w;
        }
    }
}
__device__ __forceinline__ void proj16_accum(const unsigned char* lds, const Row16& h, int lane, float (&acc)[16]) {
#pragma unroll
    for (int e = 0; e < 16; ++e) acc[e] = 0.f;
#pragma unroll
    for (int i = 0; i < 2; ++i) {
#pragma unroll
        for (int c = 0; c < 8; ++c) {
            const int rho = 64 * (8 * i + c) + lane;
            const unsigned char* rp = lds + rho * 64;
            const int sw = (rho >> 2) & 3;
#pragma unroll
            for (int ch = 0; ch < 4; ++ch) {
                const float4 w = *(const float4*)(rp + ((ch ^ sw) << 4));
                acc[ch * 4 + 0] += h.v[i][c] * w.x; acc[ch * 4 + 1] += h.v[i][c] * w.y; acc[ch * 4 + 2] += h.v[i][c] * w.z; acc[ch * 4 + 3] += h.v[i][c] * w.w;
            }
            if (c == 3) __builtin_amdgcn_sched_barrier(0);
        }
        __builtin_amdgcn_sched_barrier(0);
    }
}
__device__ __forceinline__ void proj16_accum2(const unsigned char* lds, const Row16& ha, const Row16& hb, int lane, float (&acca)[16], float (&accb)[16]) {
#pragma unroll
    for (int e = 0; e < 16; ++e) { acca[e] = 0.f; accb[e] = 0.f; }
#pragma unroll
    for (int i = 0; i < 2; ++i) {
#pragma unroll
        for (int c = 0; c < 8; ++c) {
            const int rho = 64 * (8 * i + c) + lane;
            const unsigned char* rp = lds + rho * 64;
            const int sw = (rho >> 2) & 3;
#pragma unroll
            for (int ch = 0; ch < 4; ++ch) {
                const float4 w = *(const float4*)(rp + ((ch ^ sw) << 4));
                acca[ch * 4 + 0] += ha.v[i][c] * w.x; acca[ch * 4 + 1] += ha.v[i][c] * w.y; acca[ch * 4 + 2] += ha.v[i][c] * w.z; acca[ch * 4 + 3] += ha.v[i][c] * w.w;
                accb[ch * 4 + 0] += hb.v[i][c] * w.x; accb[ch * 4 + 1] += hb.v[i][c] * w.y; accb[ch * 4 + 2] += hb.v[i][c] * w.z; accb[ch * 4 + 3] += hb.v[i][c] * w.w;
            }
            if (c == 3) __builtin_amdgcn_sched_barrier(0);
        }
        __builtin_amdgcn_sched_barrier(0);
    }
}
__device__ __forceinline__ int e_of_lane(int lane) { return ((lane >> 5) & 1) * 8 + ((lane >> 4) & 1) * 4 + ((lane >> 3) & 1) * 2 + ((lane >> 2) & 1); }
__device__ __forceinline__ float reduce_scatter16(const float (&a)[16], int lane) {
    float b8[8], b4[4], b2[2];
    { const bool up = (lane & 32) != 0;
#pragma unroll
      for (int e = 0; e < 8; ++e) { const float keep = up ? a[e + 8] : a[e], send = up ? a[e] : a[e + 8]; b8[e] = keep + __shfl_xor(send, 32); } }
    { const bool up = (lane & 16) != 0;
#pragma unroll
      for (int e = 0; e < 4; ++e) { const float keep = up ? b8[e + 4] : b8[e], send = up ? b8[e] : b8[e + 4]; b4[e] = keep + __shfl_xor(send, 16); } }
    { const bool up = (lane & 8) != 0;
#pragma unroll
      for (int e = 0; e < 2; ++e) { const float keep = up ? b4[e + 2] : b4[e], send = up ? b4[e] : b4[e + 2]; b2[e] = keep + __shfl_xor(send, 8); } }
    float b1;
    { const bool up = (lane & 4) != 0; const float keep = up ? b2[1] : b2[0], send = up ? b2[0] : b2[1]; b1 = keep + __shfl_xor(send, 4); }
    b1 += __shfl_xor(b1, 2); b1 += __shfl_xor(b1, 1);
    return b1;
}
__device__ __forceinline__ float4 ld_bf4(const bf16_t* q) { const u32x2 w = *(const u32x2*)q; return make_float4(bflo(w.x), bfhi(w.x), bflo(w.y), bfhi(w.y)); }
__device__ __forceinline__ void st_bf4(bf16_t* q, float4 v) { u32x2 w; w.x = pk2(v.x, v.y); w.y = pk2(v.z, v.w); *(u32x2*)q = w; }
#define DPP_F(x, ctrl, rmask, oldv) __builtin_bit_cast(float, __builtin_amdgcn_update_dpp(__builtin_bit_cast(int, (float)(oldv)), __builtin_bit_cast(int, (x)), (ctrl), (rmask), 0xf, false))
__device__ __forceinline__ float wave_sum(float v) {
    v += DPP_F(v, 0x111, 0xf, 0.f); v += DPP_F(v, 0x112, 0xf, 0.f); v += DPP_F(v, 0x114, 0xf, 0.f); v += DPP_F(v, 0x118, 0xf, 0.f);
    v += DPP_F(v, 0x142, 0xa, 0.f);
    v += DPP_F(v, 0x143, 0xc, 0.f);
    return __builtin_bit_cast(float, __builtin_amdgcn_readlane(__builtin_bit_cast(int, v), 63));
}
__device__ __forceinline__ float wave_max(float v) {
    const float ninf = -3.0e38f;
    v = fmaxf(v, DPP_F(v, 0x111, 0xf, ninf)); v = fmaxf(v, DPP_F(v, 0x112, 0xf, ninf)); v = fmaxf(v, DPP_F(v, 0x114, 0xf, ninf)); v = fmaxf(v, DPP_F(v, 0x118, 0xf, ninf));
    v = fmaxf(v, DPP_F(v, 0x142, 0xa, ninf));
    v = fmaxf(v, DPP_F(v, 0x143, 0xc, ninf));
    return __builtin_bit_cast(float, __builtin_amdgcn_readlane(__builtin_bit_cast(int, v), 63));
}

__device__ void phase_router(const P& p, int layer, unsigned char* lds, int bid, int nb) {
    const int tid = opaque_tid(), lane = tid & 63, wid = tid >> 6;
    const float* g = p.ffn_g + layer * D_;
    __syncthreads();
    stage_proj16(lds, p.router_w + (size_t)layer * D_ * 16, 16, g, tid);
    __syncthreads();
    Row16 gg; ld_f8(g + 8 * lane, gg.v[0]); ld_f8(g + 512 + 8 * lane, gg.v[1]);
    const int eme = e_of_lane(lane);
    const int stride = nb * 4;
#pragma unroll 1
    for (int tok = bid * 4 + wid; tok < T_; tok += 2 * stride) {
        const int tokb = tok + stride, tbc = tokb < T_ ? tokb : T_ - 1;
        Row16 ha, hb;
        ld_row_bf(p.h() + (size_t)tok * D_, lane, ha); ld_row_bf(p.h() + (size_t)tbc * D_, lane, hb);
        const float ra = rsqrtf(wave_sum(row_sumsq(ha)) * (1.f / D_) + 1e-6f), rb = rsqrtf(wave_sum(row_sumsq(hb)) * (1.f / D_) + 1e-6f);
#pragma unroll
        for (int i = 0; i < 2; ++i) {
            float ua[8], ub[8];
#pragma unroll
            for (int c = 0; c < 8; ++c) { ua[c] = ha.v[i][c] * ra * gg.v[i][c]; ub[c] = hb.v[i][c] * rb * gg.v[i][c]; }
            st_bf8(p.u() + (size_t)tok * D_ + 512 * i + 8 * lane, ua);
            if (tokb < T_) st_bf8(p.u() + (size_t)tokb * D_ + 512 * i + 8 * lane, ub);
        }
        float acca[16], accb[16];
        proj16_accum2(lds, ha, hb, lane, acca, accb);
        const float la = reduce_scatter16(acca, lane) * ra, lb = reduce_scatter16(accb, lane) * rb;
        const float ma = wave_max(la), mb = wave_max(lb);
        const float ea = __expf(la - ma), eb = __expf(lb - mb);
        const float suma = wave_sum(ea) * 0.25f, sumb = wave_sum(eb) * 0.25f;
        if ((lane & 3) == 0) {
            { const int b = tok / L_, t = tok - b * L_; p.aff()[(size_t)(b * 16 + eme) * L_ + t] = ea / suma; }
            if (tokb < T_) { const int b = tokb / L_, t = tokb - b * L_; p.aff()[(size_t)(b * 16 + eme) * L_ + t] = eb / sumb; }
        }
    }
}

__device__ void phase_topk(const P& p, unsigned char* lds, int bid, int nb) {
    const int tid = opaque_tid(), lane = tid & 63, wid = tid >> 6;
    unsigned* wc = (unsigned*)lds;
#if PROBE_TOPK
    for (int rep = 0; rep < 4; ++rep)
#endif
    for (int g = bid; g < NG; g += nb) {
        const int b = g >> 4, e = g & 15;
        const float* ap = p.aff() + (size_t)g * L_;
        unsigned key[9];
#pragma unroll
        for (int m = 0; m < 9; ++m) { const int i = tid + 256 * m; key[m] = (i < L_) ? __builtin_bit_cast(unsigned, ap[i]) : 0u; }
        unsigned T = 0u;
        for (int bit = 31; bit >= 0; --bit) {
            const unsigned cand = T | (1u << bit);
            unsigned c = 0;
#pragma unroll
            for (int m = 0; m < 9; ++m) c += (unsigned)__popcll(__ballot(key[m] >= cand));
            unsigned* w = wc + (bit & 1) * 4;
            if (lane == 0) w[wid] = c;
            __syncthreads();
            const unsigned tot = w[0] + w[1] + w[2] + w[3];
            if (tot >= CAP) T = cand;
        }
        __syncthreads();
        unsigned cg = 0;
#pragma unroll
        for (int m = 0; m < 9; ++m) cg += (unsigned)__popcll(__ballot(key[m] > T));
        if (lane == 0) wc[wid] = cg;
        __syncthreads();
        const unsigned n_gt = wc[0] + wc[1] + wc[2] + wc[3];
        const unsigned need = CAP - n_gt;
        __syncthreads();
        unsigned base_sel = 0, base_tie = 0;
#pragma unroll
        for (int m = 0; m < 9; ++m) {
            const int i = tid + 256 * m;
            const bool gt = key[m] > T, tie = (key[m] == T) && (i < L_);
            const unsigned long long bt = __ballot(tie);
            const unsigned long long lower = (1ull << lane) - 1ull;
            if (lane == 0) { wc[8 + wid] = (unsigned)__popcll(bt); }
            __syncthreads();
            unsigned tie_before = base_tie + (unsigned)__popcll(bt & lower);
            for (int w2 = 0; w2 < wid; ++w2) tie_before += wc[8 + w2];
            const unsigned tie_row = wc[8] + wc[9] + wc[10] + wc[11];
            const bool take = gt || (tie && tie_before < need);
            const unsigned long long bs = __ballot(take);
            if (lane == 0) { wc[12 + wid] = (unsigned)__popcll(bs); }
            __syncthreads();
            unsigned slot = base_sel + (unsigned)__popcll(bs & lower);
            for (int w2 = 0; w2 < wid; ++w2) slot += wc[12 + w2];
            const unsigned sel_row = wc[12] + wc[13] + wc[14] + wc[15];
            if (i < L_) {
                if (take) { const int sl = (e * B_ + b) * CAP + (int)slot; p.idx()[sl] = b * L_ + i; p.gate()[sl] = __builtin_bit_cast(float, key[m]); }
                p.sel()[((size_t)b * L_ + i) * 16 + e] = take ? (int)slot : -1;
            }
            base_sel += sel_row; base_tie += tie_row;
            __syncthreads();
        }
    }
}

template <int MT>
__device__ __forceinline__ void gateup_unit(const P& p, int layer, unsigned char* lds, int e, int srow0, int nt, int tid) {
    const int lane = tid & 63, wid = tid >> 6, wr = wid >> 1, wc = wid & 1, fr = lane & 15, fq = lane >> 4, lrow = tid >> 3;
    TileAddr t;
#pragma unroll
    for (int i = 0; i < MT; ++i) { int srow = srow0 + lrow + 32 * i; if (srow > ESLOTS - 1) srow = ESLOTS - 1; t.ao[i] = (unsigned)p.idx()[e * ESLOTS + srow] * 2048u + gemm_chunk_off(tid); }
    t.ab = (const char*)p.u();
    t.bb = (const char*)(p.Wgu() + (size_t)(layer * 16 + e) * 2048 * 1024); t.bo = (unsigned)(nt * 128 + lrow) * 2048u + gemm_chunk_off(tid);
    f32x4 acc[MT][4];
    gemm_tile<false, MT>(t, lds, acc, tid);
#pragma unroll
    for (int m = 0; m < MT; ++m) {
        const int srow = srow0 + wr * 16 * MT + m * 16 + fr;
        if (srow < ESLOTS) {
            float o[8];
#pragma unroll
            for (int n = 0; n < 2; ++n) {
                const f32x4 gv = acc[m][n], uv = acc[m][n + 2];
#pragma unroll
                for (int j = 0; j < 4; ++j) o[4 * n + j] = gv[j] / (1.f + __expf(-gv[j])) * uv[j];
            }
            u32x4 pk; pk.x = pk2(o[0], o[1]); pk.y = pk2(o[2], o[3]); pk.z = pk2(o[4], o[5]); pk.w = pk2(o[6], o[7]);
            *(u32x4*)(p.hdn() + ((size_t)e * ESLOTS + srow) * D_ + nt * 64 + wc * 32 + fq * 8) = pk;
        }
    }
}
__device__ void phase_gateup(const P& p, int layer, unsigned char* lds, int bid, int nb) {
    const int tid = opaque_tid();
    const int x = bid & 7, l = bid >> 3, nbx = nb >> 3;
#if PROBE_GEMM
    for (int rep = 0; rep < 2; ++rep)
#endif
    for (int s = l; s < 320; s += nbx) {
        const int e = 2 * x + s / 160, s2 = s % 160, mt = s2 >> 4, nt = s2 & 15;
        gateup_unit<6>(p, layer, lds, e, mt * 192, nt, tid);
    }
    for (int s = l; s < 64; s += nbx) {
        const int u = s & 31, e = 2 * x + (u >> 4), nt = u & 15;
        if (s < 32) gateup_unit<4>(p, layer, lds, e, 1920, nt, tid); else gateup_unit<1>(p, layer, lds, e, 2048, nt, tid);
    }
}

template <int MT>
__device__ __forceinline__ void down_unit(const P& p, int layer, unsigned char* lds, int e, int srow0, int nt, int tid) {
    const int lane = tid & 63, wid = tid >> 6, wr = wid >> 1, wc = wid & 1, fr = lane & 15, fq = lane >> 4, lrow = tid >> 3;
    TileAddr t;
#pragma unroll
    for (int i = 0; i < MT; ++i) { int srow = srow0 + lrow + 32 * i; if (srow > ESLOTS - 1) srow = ESLOTS - 1; t.ao[i] = (unsigned)srow * 2048u + gemm_chunk_off(tid); }
    t.ab = (const char*)(p.hdn() + (size_t)e * ESLOTS * D_);
    t.bb = (const char*)(p.Wd() + (size_t)(layer * 16 + e) * 1024 * 1024); t.bo = (unsigned)(nt * 128 + lrow) * 2048u + gemm_chunk_off(tid);
    f32x4 acc[MT][4];
    gemm_tile<false, MT>(t, lds, acc, tid);
#pragma unroll
    for (int m = 0; m < MT; ++m) {
        const int srow = srow0 + wr * 16 * MT + m * 16 + fr;
        if (srow < ESLOTS) {
            const float gt = p.gate()[e * ESLOTS + srow];
#pragma unroll
            for (int pr = 0; pr < 2; ++pr) {
                const f32x4 v0 = acc[m][2 * pr], v1 = acc[m][2 * pr + 1];
                u32x4 pk; pk.x = pk2(v0[0] * gt, v0[1] * gt); pk.y = pk2(v0[2] * gt, v0[3] * gt); pk.z = pk2(v1[0] * gt, v1[1] * gt); pk.w = pk2(v1[2] * gt, v1[3] * gt);
                *(u32x4*)(p.ys() + ((size_t)e * ESLOTS + srow) * D_ + nt * 128 + wc * 64 + pr * 32 + fq * 8) = pk;
            }
        }
        if (MT > 4) __builtin_amdgcn_sched_barrier(0);
    }
}
__device__ void phase_down(const P& p, int layer, unsigned char* lds, int bid, int nb) {
    const int tid = opaque_tid();
    const int x = bid & 7, l = bid >> 3, nbx = nb >> 3;
#if PROBE_GEMM
    for (int rep = 0; rep < 2; ++rep)
#endif
    for (int s = l; s < 160 + 32; s += nbx) {
        if (s < 160) {
            const int e = 2 * x + s / 80, s2 = s % 80, mt = s2 >> 3, nt = s2 & 7;
            down_unit<6>(p, layer, lds, e, mt * 192, nt, tid);
        } else {
            const int u = (s - 160) & 15, e = 2 * x + (u >> 3), nt = u & 7;
            if (s < 176) down_unit<4>(p, layer, lds, e, 1920, nt, tid); else down_unit<1>(p, layer, lds, e, 2048, nt, tid);
        }
    }
}


template <int MT>
__device__ __forceinline__ void odd_in_unit(const P& p, int j, const bf16_t* W, unsigned char* lds, int row0, int nt, int tid) {
    const int lane = tid & 63, wid = tid >> 6, wr = wid >> 1, wc = wid & 1, fr = lane & 15, fq = lane >> 4;
    TileAddr t; tile_addr_rows<MT>(t, p.u(), row0, W, nt, tid);
    f32x4 acc[MT][4];
    if (nt < 16) {
        gemm_tile<false, MT>(t, lds, acc, tid);
        const bool isq = nt < 8;
        const float* g = isq ? (p.o_qg + j * 64) : (p.o_kg + j * 64);
        const float sc = isq ? 0.125f : 1.f;
        f32x4 gv[4];
#pragma unroll
        for (int n = 0; n < 4; ++n) gv[n] = *(const f32x4*)(g + 32 * (n >> 1) + 8 * fq + 4 * (n & 1));
#pragma unroll
        for (int m = 0; m < MT; ++m) {
            float ss = 0.f;
#pragma unroll
            for (int n = 0; n < 4; ++n) { const f32x4 v = acc[m][n]; ss += v[0] * v[0] + v[1] * v[1] + v[2] * v[2] + v[3] * v[3]; }
            ss += __shfl_xor(ss, 16); ss += __shfl_xor(ss, 32);
            const float rinv = rsqrtf(ss * (1.f / 64.f) + 1e-6f) * sc;
            const size_t row = (size_t)row0 + wr * 16 * MT + m * 16 + fr;
#pragma unroll
            for (int pr = 0; pr < 2; ++pr) {
                const f32x4 v0 = acc[m][2 * pr], v1 = acc[m][2 * pr + 1], g0 = gv[2 * pr], g1 = gv[2 * pr + 1];
                u32x4 pk; pk.x = pk2(v0[0] * rinv * g0[0], v0[1] * rinv * g0[1]); pk.y = pk2(v0[2] * rinv * g0[2], v0[3] * rinv * g0[3]);
                pk.z = pk2(v1[0] * rinv * g1[0], v1[1] * rinv * g1[1]); pk.w = pk2(v1[2] * rinv * g1[2], v1[3] * rinv * g1[3]);
                *(u32x4*)(p.zo() + row * 2048 + nt * 128 + wc * 64 + pr * 32 + fq * 8) = pk;
            }
        }
    } else {
        gemm_tile<true, MT>(t, lds, acc, tid);
        const int head = (nt - 16) * 2 + wc;
#pragma unroll
        for (int m = 0; m < MT; ++m) {
            const int row = row0 + wr * 16 * MT + m * 16 + fq * 4;
            const int b = row / L_, tk = row - b * L_;
#pragma unroll
            for (int n = 0; n < 4; ++n) {
                const int d = n * 16 + fr;
                const f32x4 v = acc[m][n];
                u32x2 pk; pk.x = pk2(v[0], v[1]); pk.y = pk2(v[2], v[3]);
                *(u32x2*)(p.vT() + ((size_t)(b * 16 + head) * 64 + d) * L_ + tk) = pk;
            }
        }
    }
}
__device__ void phase_odd_in(const P& p, int layer, unsigned char* lds, int bid, int nb) {
    const int tid = opaque_tid();
    const int x = bid & 7, l = bid >> 3, nbx = nb >> 3;
    const int j = layer >> 1;
    const bf16_t* W = p.WinO() + (size_t)j * 3072 * 1024;
    const int nt0 = 6 * (x >> 1), par = x & 1;
#if PROBE_GEMM
    for (int rep = 0; rep < 2; ++rep)
#endif
    for (int s = l; s < 246; s += nbx) odd_in_unit<6>(p, j, W, lds, (2 * (s / 6) + par) * 192, nt0 + (s % 6), tid);
    if (nbx == 64) { for (int s = l - 54; s >= 0 && s < 18; s += 10) odd_in_unit<4>(p, j, W, lds, 15744 + (2 * (s / 6) + par) * 128, nt0 + (s % 6), tid); }
    else           { for (int s = l; s < 18; s += nbx) odd_in_unit<4>(p, j, W, lds, 15744 + (2 * (s / 6) + par) * 128, nt0 + (s % 6), tid); }
}

#define NA_VSTRIDE 1072
#define NA_RPB 68608
__device__ __forceinline__ int na_key(int row) { return ((row >> 1) & 1) | ((row >> 2) & 6); }
__device__ void phase_natten(const P& p, int layer, unsigned char* lds, int bid, int nb) {
    const int tid = opaque_tid(), lane = tid & 63, wid = tid >> 6, fr = lane & 15, fq = lane >> 4;
    typedef __attribute__((address_space(3))) unsigned LdsU;
    typedef const __attribute__((address_space(1))) unsigned GlbU;
    const int h = bid & 15, jb = bid >> 4, njb = nb >> 4;
    const float* rpbh = p.o_rpb + ((size_t)(layer >> 1) * 16 + h) * 15 * 31;
    float* rtab = (float*)(lds + NA_RPB);
    __syncthreads();
    for (int i = tid; i < 15 * 31; i += NTHR) rtab[i] = rpbh[i];
    const int w = wid;
    const int kc0 = (w == 0) ? 0 : (w == 1) ? 8 : (w == 2) ? 24 : 32;
    const int c = 16 * w + fr;
    const int cs = min(max(c - 8, 0), 48);
    for (int pr = jb; pr < B_ * 32; pr += njb) {
        const int b = pr >> 5, r = pr & 31;
        const int rs = min(max(r - 4, 0), 24);
        const size_t tokb = (size_t)b * L_;
        __syncthreads();
        for (int q = w; q < 66; q += 4) {
            const int row = 8 * q + (lane >> 3), pc = lane & 7;
            const size_t tok = row < 512 ? tokb + NM + rs * 64 + row : tokb + (row - 512);
            const bf16_t* src = p.zo() + tok * 2048 + 1024 + h * 64 + ((pc ^ na_key(row)) << 3);
            __builtin_amdgcn_global_load_lds((GlbU*)src, (LdsU*)(lds + q * 1024 + lane * 16), 16, 0, 0);
        }
        const bf16_t* qp = p.zo() + (tokb + NM + r * 64 + c) * 2048 + h * 64 + fq * 8;
        const bf16x8 qf0 = *(const bf16x8*)qp, qf1 = *(const bf16x8*)(qp + 32);
        __syncthreads();
        f32x4 S[17];
#pragma unroll
        for (int n = 0; n < 17; ++n) {
            const int row = (n < 16) ? ((n >> 1) * 64 + kc0 + 8 * (fr >> 2) + 4 * (n & 1) + (fr & 3)) : (512 + fr);
            const int ky = na_key(row);
            const bf16x8 kf0 = *(const bf16x8*)(lds + row * 128 + (((0 + fq) ^ ky) << 4));
            const bf16x8 kf1 = *(const bf16x8*)(lds + row * 128 + (((4 + fq) ^ ky) << 4));
            f32x4 a = (f32x4){0.f, 0.f, 0.f, 0.f};
            a = __builtin_amdgcn_mfma_f32_16x16x32_bf16(kf0, qf0, a, 0, 0, 0);
            a = __builtin_amdgcn_mfma_f32_16x16x32_bf16(kf1, qf1, a, 0, 0, 0);
            S[n] = a;
        }
        __syncthreads();
        {
            const bf16_t* vsrc = p.vT() + (size_t)(b * 16 + h) * 64 * L_;
            for (int d = w; d < 64; d += 4)
                __builtin_amdgcn_global_load_lds((GlbU*)(vsrc + (size_t)d * L_ + NM + rs * 64 + lane * 8), (LdsU*)(lds + d * NA_VSTRIDE + lane * 16), 16, 0, 0);
            if (tid < 128) { const int d = tid >> 1, hf = tid & 1; *(u32x4*)(lds + d * NA_VSTRIDE + 1024 + hf * 16) = *(const u32x4*)(vsrc + (size_t)d * L_ + hf * 8); }
        }
        float mx = -3.0e38f;
#pragma unroll
        for (int n = 0; n < 16; ++n) {
            const int dr = rs + (n >> 1) - r + 7;
#pragma unroll
            for (int jj = 0; jj < 4; ++jj) {
                const int kc = kc0 + 8 * fq + 4 * (n & 1) + jj;
                const bool valid = (kc >= cs) && (kc < cs + 16);
                const int dc = min(max(kc - c + 15, 0), 30);
                const float sv = valid ? S[n][jj] + rtab[dr * 31 + dc] : -3.0e38f;
                S[n][jj] = sv; mx = fmaxf(mx, sv);
            }
        }
#pragma unroll
        for (int jj = 0; jj < 4; ++jj) mx = fmaxf(mx, S[16][jj]);
        mx = fmaxf(mx, __shfl_xor(mx, 16)); mx = fmaxf(mx, __shfl_xor(mx, 32));
        float sum = 0.f;
#pragma unroll
        for (int n = 0; n < 17; ++n)
#pragma unroll
            for (int jj = 0; jj < 4; ++jj) { const float e = __expf(S[n][jj] - mx); S[n][jj] = e; sum += e; }
        sum += __shfl_xor(sum, 16); sum += __shfl_xor(sum, 32);
        const float rinv = 1.f / sum;
        __syncthreads();
        f32x4 O[4];
#pragma unroll
        for (int nd = 0; nd < 4; ++nd) O[nd] = (f32x4){0.f, 0.f, 0.f, 0.f};
#pragma unroll
        for (int t = 0; t < 8; ++t) {
            u32x4 pw; pw.x = pk2(S[2 * t][0], S[2 * t][1]); pw.y = pk2(S[2 * t][2], S[2 * t][3]); pw.z = pk2(S[2 * t + 1][0], S[2 * t + 1][1]); pw.w = pk2(S[2 * t + 1][2], S[2 * t + 1][3]);
            const bf16x8 pf = __builtin_bit_cast(bf16x8, pw);
#pragma unroll
            for (int nd = 0; nd < 4; ++nd) {
                const bf16x8 vf = *(const bf16x8*)(lds + (16 * nd + fr) * NA_VSTRIDE + (t * 64 + kc0 + 8 * fq) * 2);
                O[nd] = __builtin_amdgcn_mfma_f32_16x16x32_bf16(vf, pf, O[nd], 0, 0, 0);
            }
        }
        {
            u32x4 pw; pw.x = pk2(S[16][0], S[16][1]); pw.y = pk2(S[16][2], S[16][3]); pw.z = 0u; pw.w = 0u;
            const bf16x8 pf = __builtin_bit_cast(bf16x8, pw);
#pragma unroll
            for (int nd = 0; nd < 4; ++nd) {
                const u32x2 v2 = *(const u32x2*)(lds + (16 * nd + fr) * NA_VSTRIDE + 1024 + 8 * fq);
                u32x4 vw; vw.x = v2.x; vw.y = v2.y; vw.z = 0u; vw.w = 0u;
                O[nd] = __builtin_amdgcn_mfma_f32_16x16x32_bf16(__builtin_bit_cast(bf16x8, vw), pf, O[nd], 0, 0, 0);
            }
        }
        bf16_t* op = p.mix() + (tokb + NM + r * 64 + c) * D_ + h * 64 + fq * 4;
#pragma unroll
        for (int nd = 0; nd < 4; ++nd) {
            u32x2 pk; pk.x = pk2(O[nd][0] * rinv, O[nd][1] * rinv); pk.y = pk2(O[nd][2] * rinv, O[nd][3] * rinv);
            *(u32x2*)(op + nd * 16) = pk;
        }
    }
    for (int mi = bid * 4 + wid; mi < B_ * 16; mi += nb * 4) {
        const int hm = mi & 15, b = mi >> 4;
        const size_t tokb = (size_t)b * L_;
        const bf16_t* qp = p.zo() + (tokb + fr) * 2048 + hm * 64 + fq * 8;
        const bf16x8 qf0 = *(const bf16x8*)qp, qf1 = *(const bf16x8*)(qp + 32);
        const bf16_t* kp = qp + 1024;
        const bf16x8 kf0 = *(const bf16x8*)kp, kf1 = *(const bf16x8*)(kp + 32);
        f32x4 a = (f32x4){0.f, 0.f, 0.f, 0.f};
        a = __builtin_amdgcn_mfma_f32_16x16x32_bf16(kf0, qf0, a, 0, 0, 0);
        a = __builtin_amdgcn_mfma_f32_16x16x32_bf16(kf1, qf1, a, 0, 0, 0);
        float mx = fmaxf(fmaxf(a[0], a[1]), fmaxf(a[2], a[3]));
        mx = fmaxf(mx, __shfl_xor(mx, 16)); mx = fmaxf(mx, __shfl_xor(mx, 32));
        float sum = 0.f;
#pragma unroll
        for (int jj = 0; jj < 4; ++jj) { a[jj] = __expf(a[jj] - mx); sum += a[jj]; }
        sum += __shfl_xor(sum, 16); sum += __shfl_xor(sum, 32);
        const float rinv = 1.f / sum;
        u32x4 pw; pw.x = pk2(a[0], a[1]); pw.y = pk2(a[2], a[3]); pw.z = 0u; pw.w = 0u;
        const bf16x8 pf = __builtin_bit_cast(bf16x8, pw);
        const bf16_t* vb = p.vT() + ((size_t)(b * 16 + hm) * 64 + fr) * L_;
        bf16_t* op = p.mix() + (tokb + fr) * D_ + hm * 64 + fq * 4;
#pragma unroll
        for (int nd = 0; nd < 4; ++nd) {
            const u32x2 v2 = *(const u32x2*)(vb + (size_t)nd * 16 * L_ + 4 * fq);
            u32x4 vw; vw.x = v2.x; vw.y = v2.y; vw.z = 0u; vw.w = 0u;
            f32x4 o = (f32x4){0.f, 0.f, 0.f, 0.f};
            o = __builtin_amdgcn_mfma_f32_16x16x32_bf16(__builtin_bit_cast(bf16x8, vw), pf, o, 0, 0, 0);
            u32x2 pk; pk.x = pk2(o[0] * rinv, o[1] * rinv); pk.y = pk2(o[2] * rinv, o[3] * rinv);
            *(u32x2*)(op + nd * 16) = pk;
        }
    }
}

template <int MT>
__device__ __forceinline__ void outproj_unit(const P& p, const bf16_t* W, unsigned char* lds, int row0, int nt, int tid) {
    const int lane = tid & 63, wid = tid >> 6, wr = wid >> 1, wc = wid & 1, fr = lane & 15, fq = lane >> 4;
    TileAddr t; tile_addr_rows<MT>(t, p.mix(), row0, W, nt, tid);
    f32x4 acc[MT][4];
    gemm_tile<false, MT>(t, lds, acc, tid);
#pragma unroll
    for (int m = 0; m < MT; ++m) {
        const size_t row = (size_t)row0 + wr * 16 * MT + m * 16 + fr;
#pragma unroll
        for (int pr = 0; pr < 2; ++pr) {
            bf16_t* hp = p.h() + row * D_ + nt * 128 + wc * 64 + pr * 32 + fq * 8;
            const u32x4 hw = *(const u32x4*)hp; const f32x4 a0 = acc[m][2 * pr], a1 = acc[m][2 * pr + 1];
            u32x4 ow;
            ow.x = pk2(bflo(hw.x) + a0[0], bfhi(hw.x) + a0[1]); ow.y = pk2(bflo(hw.y) + a0[2], bfhi(hw.y) + a0[3]);
            ow.z = pk2(bflo(hw.z) + a1[0], bfhi(hw.z) + a1[1]); ow.w = pk2(bflo(hw.w) + a1[2], bfhi(hw.w) + a1[3]);
            *(u32x4*)hp = ow;
        }
        if (MT > 4) __builtin_amdgcn_sched_barrier(0);
    }
}
__device__ void phase_outproj(const P& p, const bf16_t* W, unsigned char* lds, int bid, int nb) {
    const int tid = opaque_tid();
    const int x = bid & 7, l = bid >> 3, nbx = nb >> 3;
    for (int s = l; s < 64; s += nbx) outproj_unit<6>(p, W, lds, (8 * (s >> 3) + x) * 192, s & 7, tid);
    for (int s = l; s < 40; s += nbx) { const int m4 = 8 * (s >> 3) + x; if (m4 < 33) outproj_unit<4>(p, W, lds, 12288 + m4 * 128, s & 7, tid); }
}

__device__ void phase_tables(const P& p, int bid, int nb) {
    for (int i = bid * NTHR + opaque_tid(); i < L_ * 64; i += nb * NTHR) {
        const int pos = i >> 6, k = i & 63;
        const float inv = powf(10000.f, -(float)k / 64.f);
        const float ang = (float)pos * inv;
        p.costab()[i] = cosf(ang); p.sintab()[i] = sinf(ang);
    }
}

template <int MT>
__device__ __forceinline__ void even_in_unit(const P& p, const bf16_t* W, unsigned char* lds, int row0, int nt, int tid) {
    const int lane = tid & 63, wid = tid >> 6, wr = wid >> 1, wc = wid & 1, fr = lane & 15, fq = lane >> 4;
    TileAddr t; tile_addr_rows<MT>(t, p.u(), row0, W, nt, tid);
    f32x4 acc[MT][4];
    gemm_tile<false, MT>(t, lds, acc, tid);
    const int seg = nt >> 2;
    if (seg == 4 || seg == 5) {
        const float sc = (seg == 5) ? 0.08838834764831845f : 1.f;
#pragma unroll
        for (int m = 0; m < MT; ++m) {
            const int row = row0 + wr * 16 * MT + m * 16 + fr;
            const int pos = row % L_;
            const int idx = 32 * wc + 8 * fq;
            u32x4 k1, k2;
#pragma unroll
            for (int pp = 0; pp < 2; ++pp) {
                const f32x4 cv = *(const f32x4*)(p.costab() + pos * 64 + idx + 4 * pp), sv = *(const f32x4*)(p.sintab() + pos * 64 + idx + 4 * pp);
                const f32x4 x1 = acc[m][2 * pp], x2 = acc[m][2 * pp + 1];
                const f32x4 y1 = (x1 * cv - x2 * sv) * sc, y2 = (x2 * cv + x1 * sv) * sc;
                if (pp == 0) { k1.x = pk2(y1[0], y1[1]); k1.y = pk2(y1[2], y1[3]); k2.x = pk2(y2[0], y2[1]); k2.y = pk2(y2[2], y2[3]); }
                else         { k1.z = pk2(y1[0], y1[1]); k1.w = pk2(y1[2], y1[3]); k2.z = pk2(y2[0], y2[1]); k2.w = pk2(y2[2], y2[3]); }
            }
            bf16_t* zp = p.ze() + (size_t)row * 4096 + nt * 128 + idx;
            *(u32x4*)zp = k1; *(u32x4*)(zp + 64) = k2;
            if (MT > 4) __builtin_amdgcn_sched_barrier(0);
        }
    } else {
#pragma unroll
        for (int m = 0; m < MT; ++m) {
            const size_t row = (size_t)row0 + wr * 16 * MT + m * 16 + fr;
#pragma unroll
            for (int pr = 0; pr < 2; ++pr) {
                const f32x4 v0 = acc[m][2 * pr], v1 = acc[m][2 * pr + 1];
                u32x4 pk; pk.x = pk2(v0[0], v0[1]); pk.y = pk2(v0[2], v0[3]); pk.z = pk2(v1[0], v1[1]); pk.w = pk2(v1[2], v1[3]);
                *(u32x4*)(p.ze() + row * 4096 + nt * 128 + wc * 64 + pr * 32 + fq * 8) = pk;
            }
        }
    }
}
__device__ void phase_even_in(const P& p, int layer, unsigned char* lds, int bid, int nb) {
    const int tid = opaque_tid();
    const int x = bid & 7, l = bid >> 3, nbx = nb >> 3;
    const bf16_t* W = p.WinE() + (size_t)(layer >> 1) * 4096 * 1024;
    const int nt0 = 8 * (x >> 1), par = x & 1;
#if PROBE_GEMM
    for (int rep = 0; rep < 2; ++rep)
#endif
    for (int s = l; s < 320; s += nbx) even_in_unit<6>(p, W, lds, (2 * (s >> 3) + par) * 192, nt0 + (s & 7), tid);
    for (int s = l; s < 40; s += nbx) { const int m4 = 2 * (s >> 3) + par; if (m4 < 9) even_in_unit<4>(p, W, lds, 15360 + m4 * 128, nt0 + (s & 7), tid); }
}

__device__ void phase_conv(const P& p, int layer, int bid, int nb) {
    const int tid = opaque_tid(), cg = tid & 127, th = tid >> 7;
    const int c0 = cg * 8;
    const float* w = p.e_conv + (size_t)(layer >> 1) * 5 * 1024 + c0;
    float wv[5][8];
#pragma unroll
    for (int jj = 0; jj < 5; ++jj) { const float4 a = *(const float4*)(w + jj * 1024), b2 = *(const float4*)(w + jj * 1024 + 4);
        wv[jj][0] = a.x; wv[jj][1] = a.y; wv[jj][2] = a.z; wv[jj][3] = a.w; wv[jj][4] = b2.x; wv[jj][5] = b2.y; wv[jj][6] = b2.z; wv[jj][7] = b2.w; }
    const float sc = (c0 >= 512) ? 0.08838834764831845f : 1.f;
    for (int it = bid; it < T_ / 16; it += nb) {
        const int tok0 = it * 16 + th * 8;
        const int b = tok0 / L_, t0 = tok0 - b * L_;
        float win[5][8];
#pragma unroll
        for (int r = 0; r < 4; ++r) {
            const int tt = t0 - 2 + r;
            u32x4 raw = (u32x4){0u, 0u, 0u, 0u};
            if (tt >= 0 && tt < L_) raw = *(const u32x4*)(p.ze() + ((size_t)b * L_ + tt) * 4096 + c0);
            win[r + 1][0] = bflo(raw.x); win[r + 1][1] = bfhi(raw.x); win[r + 1][2] = bflo(raw.y); win[r + 1][3] = bfhi(raw.y);
            win[r + 1][4] = bflo(raw.z); win[r + 1][5] = bfhi(raw.z); win[r + 1][6] = bflo(raw.w); win[r + 1][7] = bfhi(raw.w);
        }
#pragma unroll
        for (int i = 0; i < 8; ++i) {
#pragma unroll
            for (int r = 0; r < 4; ++r)
#pragma unroll
                for (int c = 0; c < 8; ++c) win[r][c] = win[r + 1][c];
            const int tt = t0 + i + 2;
            u32x4 raw = (u32x4){0u, 0u, 0u, 0u};
            if (tt < L_) raw = *(const u32x4*)(p.ze() + ((size_t)b * L_ + tt) * 4096 + c0);
            win[4][0] = bflo(raw.x); win[4][1] = bfhi(raw.x); win[4][2] = bflo(raw.y); win[4][3] = bfhi(raw.y);
            win[4][4] = bflo(raw.z); win[4][5] = bfhi(raw.z); win[4][6] = bflo(raw.w); win[4][7] = bfhi(raw.w);
            float o[8];
#pragma unroll
            for (int c = 0; c < 8; ++c) {
                float s = 0.f;
#pragma unroll
                for (int jj = 0; jj < 5; ++jj) s += wv[jj][c] * win[jj][c];
                o[c] = s / (1.f + __expf(-s)) * sc;
            }
            u32x4 pk; pk.x = pk2(o[0], o[1]); pk.y = pk2(o[2], o[3]); pk.z = pk2(o[4], o[5]); pk.w = pk2(o[6], o[7]);
            *(u32x4*)(p.qc() + (size_t)(tok0 + i) * 1024 + c0) = pk;
        }
    }
}

#define SC_QS 0
#define SC_KS 17408
#define SC_VS 34816
#define SC_VW 39936
#define SC_CT 45056
#define SC_NS 53760
#define SC_KW 54272
#define SC_AK 54528
#define SC_CONV 55296
__device__ __forceinline__ void tr_read8(unsigned a0, unsigned a1, unsigned a2, unsigned a3, unsigned a4, unsigned a5, unsigned a6, unsigned a7,
                                         u32x2& r0, u32x2& r1, u32x2& r2, u32x2& r3, u32x2& r4, u32x2& r5, u32x2& r6, u32x2& r7) {
    asm volatile("ds_read_b64_tr_b16 %0, %8\n\tds_read_b64_tr_b16 %1, %9\n\tds_read_b64_tr_b16 %2, %10\n\tds_read_b64_tr_b16 %3, %11\n\t"
                 "ds_read_b64_tr_b16 %4, %12\n\tds_read_b64_tr_b16 %5, %13\n\tds_read_b64_tr_b16 %6, %14\n\tds_read_b64_tr_b16 %7, %15\n\ts_waitcnt lgkmcnt(0)"
                 : "=&v"(r0), "=&v"(r1), "=&v"(r2), "=&v"(r3), "=&v"(r4), "=&v"(r5), "=&v"(r6), "=&v"(r7)
                 : "v"(a0), "v"(a1), "v"(a2), "v"(a3), "v"(a4), "v"(a5), "v"(a6), "v"(a7) : "memory");
}
__device__ __forceinline__ void tr_read4(unsigned a0, unsigned a1, unsigned a2, unsigned a3, u32x2& r0, u32x2& r1, u32x2& r2, u32x2& r3) {
    asm volatile("ds_read_b64_tr_b16 %0, %4\n\tds_read_b64_tr_b16 %1, %5\n\tds_read_b64_tr_b16 %2, %6\n\tds_read_b64_tr_b16 %3, %7\n\ts_waitcnt lgkmcnt(0)"
                 : "=&v"(r0), "=&v"(r1), "=&v"(r2), "=&v"(r3) : "v"(a0), "v"(a1), "v"(a2), "v"(a3) : "memory");
}
__device__ __forceinline__ bf16x8 cat8(u32x2 lo, u32x2 hi) { u32x4 w; w.x = lo.x; w.y = lo.y; w.z = hi.x; w.w = hi.y; return __builtin_bit_cast(bf16x8, w); }
template <bool RET>
__device__ void scan_item(const P& p, int layer, unsigned char* lds, int b, int hh, int dir, int eq, int conv_q0, int conv_stride) {
    const int tid = opaque_tid(), lane = tid & 63, w = tid >> 6, fr = lane & 15, fq = lane >> 4;
    const unsigned lbase = (unsigned)(size_t)lds;
    const size_t tokb = (size_t)b * L_;
    const bf16_t* qsrc = RET ? (p.ze() + 2048 + hh * 128) : (p.qc() + hh * 128);
    const bf16_t* ksrc = RET ? (p.ze() + 2560 + hh * 128) : (p.qc() + 512 + hh * 128);
    const bf16_t* vsrc = p.ze() + (RET ? 3072 : 1024) + hh * 128 + eq * 32;
    const int qld = RET ? 4096 : 1024;
    const float lgam = RET ? logsigmoidf_(p.e_decay[(layer >> 1) * 8 + dir * 4 + hh]) : 0.f;
    const int lr = tid >> 4, lc = tid & 15;
    const int vr = tid >> 2, vc = tid & 3;
    u32x4 rq[4], rk[4], rv; float rli = 0.f, rlf = 0.f;
    auto tok_of = [&](int n, int pp) -> int {
        if (n == 0) return pp < 48 ? -1 : pp - 48;
        const int rr = 64 * (n - 1) + pp;
        return NM + (dir ? 2047 - rr : rr);
    };
    auto load_chunk = [&](int n) {
#pragma unroll
        for (int i = 0; i < 4; ++i) {
            const int t = tok_of(n, lr + 16 * i);
            rq[i] = (u32x4){0u, 0u, 0u, 0u}; rk[i] = (u32x4){0u, 0u, 0u, 0u};
            if (t >= 0) { rq[i] = *(const u32x4*)(qsrc + (tokb + t) * qld + lc * 8); rk[i] = *(const u32x4*)(ksrc + (tokb + t) * qld + lc * 8); }
        }
        { const int t = tok_of(n, vr); rv = (u32x4){0u, 0u, 0u, 0u}; if (t >= 0) rv = *(const u32x4*)(vsrc + (tokb + t) * 4096 + vc * 8); }
        if (!RET) {
            const int t = tok_of(n, lane); rli = 0.f; rlf = 0.f;
            if (t >= 0) { const float* gp = p.gts() + (tokb + t) * 16 + dir * 8 + hh; rli = gp[0]; rlf = logsigmoidf_(gp[4]); }
        }
    };
    float bb, a_, cm;
    auto local_scan = [&]() {
        const float lf = RET ? lgam : rlf, li = RET ? 0.f : rli;
        bb = lf;
#pragma unroll
        for (int o = 1; o < 64; o <<= 1) { const float t = __shfl_up(bb, o); if (lane >= o) bb += t; }
        a_ = li - bb; cm = a_;
        if (!RET) {
#pragma unroll
            for (int o = 1; o < 64; o <<= 1) { const float t = __shfl_up(cm, o); if (lane >= o) cm = fmaxf(cm, t); }
        }
    };
    f32x4 Cacc[2][2];
#pragma unroll
    for (int a = 0; a < 2; ++a)
#pragma unroll
        for (int c = 0; c < 2; ++c) Cacc[a][c] = (f32x4){0.f, 0.f, 0.f, 0.f};
    float m_prev = 0.f, w_state = 0.f, nsum0 = 0.f, nsum1 = 0.f;
    ConvTile cvt;
    load_chunk(0);
    local_scan();
    const int tq = (lane >> 2) & 3, tp = lane & 3;
    const unsigned trK = lbase + SC_KS + (8 * fq + tq) * 272 + (32 * w + 4 * tp) * 2;
    const unsigned trV = lbase + SC_VS + (8 * fq + tq) * 80 + (4 * tp) * 2;
    for (int n = 0; n < 33; ++n) {
        float mm;
        if (RET) mm = 0.f; else mm = bb + fmaxf(m_prev, cm);
        const float b63 = __shfl(bb, 63), m_new = __shfl(mm, 63);
        const float bm_ = bb - mm, winter_ = __expf(bb + m_prev - mm), kw_ = __expf(b63 + a_ - m_new), em_ = __expf(-mm);
#pragma unroll
        for (int mt = 0; mt < 2; ++mt)
#pragma unroll
            for (int ne = 0; ne < 2; ++ne) {
                const f32x4 v = Cacc[mt][ne];
                u32x2 pk; pk.x = pk2(v[0], v[1]); pk.y = pk2(v[2], v[3]);
                *(u32x2*)(lds + SC_CT + (16 * ne + fr) * 272 + (32 * w + 16 * mt + 4 * fq) * 2) = pk;
            }
        if (fq == 0) {
            float* ns = (float*)(lds + SC_NS) + 32 * w + fr;
            ns[0] = (n == 0) ? 0.f : (w_state * ns[0] + nsum0);
            ns[16] = (n == 0) ? 0.f : (w_state * ns[16] + nsum1);
        }
        w_state = __expf(b63 + m_prev - m_new);
#pragma unroll
        for (int i = 0; i < 4; ++i) {
            const int row = lr + 16 * i;
            *(u32x4*)(lds + SC_QS + row * 272 + lc * 16) = rq[i];
            *(u32x4*)(lds + SC_KS + row * 272 + lc * 16) = rk[i];
        }
        {
            const float kwr = __shfl(kw_, vr & 63);
            *(u32x4*)(lds + SC_VS + vr * 80 + vc * 16) = rv;
            u32x4 sv;
            sv.x = pk2(bflo(rv.x) * kwr, bfhi(rv.x) * kwr); sv.y = pk2(bflo(rv.y) * kwr, bfhi(rv.y) * kwr);
            sv.z = pk2(bflo(rv.z) * kwr, bfhi(rv.z) * kwr); sv.w = pk2(bflo(rv.w) * kwr, bfhi(rv.w) * kwr);
            *(u32x4*)(lds + SC_VW + vr * 80 + vc * 16) = sv;
            if (w == 0) { ((float*)(lds + SC_KW))[lane] = kw_; ((float*)(lds + SC_AK))[lane] = a_; }
        }
        __syncthreads();
        if (n + 1 < 33) load_chunk(n + 1);
        float4 cv[4];
        { int rt, kt; deferred_tile(conv_q0 + n * conv_stride, rt, kt); conv_load(p, rt, kt, tid, cv, cvt); }
        const int qrow = 16 * w + fr;
        bf16x8 qf[4];
#pragma unroll
        for (int ks = 0; ks < 4; ++ks) qf[ks] = *(const bf16x8*)(lds + SC_QS + qrow * 272 + (32 * ks + 8 * fq) * 2);
        f32x4 S[4];
#pragma unroll
        for (int nn = 0; nn < 4; ++nn) {
            const int krow = 32 * (nn >> 1) + 8 * (fr >> 2) + 4 * (nn & 1) + (fr & 3);
            f32x4 acc = (f32x4){0.f, 0.f, 0.f, 0.f};
#pragma unroll
            for (int ks = 0; ks < 4; ++ks) {
                const bf16x8 kf = *(const bf16x8*)(lds + SC_KS + krow * 272 + (32 * ks + 8 * fq) * 2);
                acc = __builtin_amdgcn_mfma_f32_16x16x32_bf16(kf, qf[ks], acc, 0, 0, 0);
            }
            S[nn] = acc;
        }
        const float bm_q = __shfl(bm_, qrow), winter_q = __shfl(winter_, qrow), em_q = __shfl(em_, qrow);
        float rsum = 0.f;
#pragma unroll
        for (int nn = 0; nn < 4; ++nn) {
            const int key0 = 32 * (nn >> 1) + 8 * fq + 4 * (nn & 1);
            const f32x4 ak = *(const f32x4*)(lds + SC_AK + key0 * 4);
#pragma unroll
            for (int jj = 0; jj < 4; ++jj) {
                const float dv = __expf(bm_q + ak[jj]);
                const float sv = (key0 + jj <= qrow) ? S[nn][jj] * dv : 0.f;
                S[nn][jj] = sv; rsum += sv;
            }
        }
        f32x4 O[2], OC[2];
#pragma unroll
        for (int ne = 0; ne < 2; ++ne) { O[ne] = (f32x4){0.f, 0.f, 0.f, 0.f}; OC[ne] = (f32x4){0.f, 0.f, 0.f, 0.f}; }
        {
            u32x2 v00a, v00b, v01a, v01b, v10a, v10b, v11a, v11b;
            tr_read8(trV, trV + 4 * 80, trV + 32, trV + 32 + 4 * 80, trV + 32 * 80, trV + 36 * 80, trV + 32 * 80 + 32, trV + 36 * 80 + 32,
                     v00a, v00b, v01a, v01b, v10a, v10b, v11a, v11b);
            u32x4 pw; bf16x8 pf;
            pw.x = pk2(S[0][0], S[0][1]); pw.y = pk2(S[0][2], S[0][3]); pw.z = pk2(S[1][0], S[1][1]); pw.w = pk2(S[1][2], S[1][3]); pf = __builtin_bit_cast(bf16x8, pw);
            O[0] = __builtin_amdgcn_mfma_f32_16x16x32_bf16(cat8(v00a, v00b), pf, O[0], 0, 0, 0);
            O[1] = __builtin_amdgcn_mfma_f32_16x16x32_bf16(cat8(v01a, v01b), pf, O[1], 0, 0, 0);
            pw.x = pk2(S[2][0], S[2][1]); pw.y = pk2(S[2][2], S[2][3]); pw.z = pk2(S[3][0], S[3][1]); pw.w = pk2(S[3][2], S[3][3]); pf = __builtin_bit_cast(bf16x8, pw);
            O[0] = __builtin_amdgcn_mfma_f32_16x16x32_bf16(cat8(v10a, v10b), pf, O[0], 0, 0, 0);
            O[1] = __builtin_amdgcn_mfma_f32_16x16x32_bf16(cat8(v11a, v11b), pf, O[1], 0, 0, 0);
        }
#pragma unroll
        for (int ks = 0; ks < 4; ++ks)
#pragma unroll
            for (int ne = 0; ne < 2; ++ne) {
                const bf16x8 cf = *(const bf16x8*)(lds + SC_CT + (16 * ne + fr) * 272 + (32 * ks + 8 * fq) * 2);
                OC[ne] = __builtin_amdgcn_mfma_f32_16x16x32_bf16(cf, qf[ks], OC[ne], 0, 0, 0);
            }
        float scC = winter_q, scS = 1.f;
        if (!RET) {
            float qn = 0.f;
#pragma unroll
            for (int ks = 0; ks < 4; ++ks) {
                const f32x4 n0 = *(const f32x4*)(lds + SC_NS + (32 * ks + 8 * fq) * 4), n1 = *(const f32x4*)(lds + SC_NS + (32 * ks + 8 * fq + 4) * 4);
                const u32x4 qw = __builtin_bit_cast(u32x4, qf[ks]);
                qn += bflo(qw.x) * n0[0] + bfhi(qw.x) * n0[1] + bflo(qw.y) * n0[2] + bfhi(qw.y) * n0[3]
                    + bflo(qw.z) * n1[0] + bfhi(qw.z) * n1[1] + bflo(qw.w) * n1[2] + bfhi(qw.w) * n1[3];
            }
            qn += __shfl_xor(qn, 16); qn += __shfl_xor(qn, 32);
            rsum += __shfl_xor(rsum, 16); rsum += __shfl_xor(rsum, 32);
            const float den = winter_q * qn + rsum;
            const float rden = 1.f / fmaxf(fabsf(den), em_q);
            scC = winter_q * rden; scS = rden;
        }
        {
            const int t = tok_of(n, qrow);
            if (t >= 0) {
                bf16_t* op = p.osc() + ((size_t)dir * T_ + tokb + t) * 1024 + (RET ? 512 : 0) + hh * 128 + eq * 32 + 4 * fq;
#pragma unroll
                for (int ne = 0; ne < 2; ++ne) {
                    const f32x4 o = OC[ne] * scC + O[ne] * scS;
                    u32x2 pk; pk.x = pk2(o[0], o[1]); pk.y = pk2(o[2], o[3]);
                    *(u32x2*)(op + 16 * ne) = pk;
                }
            }
        }
#pragma unroll
        for (int mt = 0; mt < 2; ++mt)
#pragma unroll
            for (int ne = 0; ne < 2; ++ne) Cacc[mt][ne] = Cacc[mt][ne] * w_state;
        nsum0 = 0.f; nsum1 = 0.f;
#pragma unroll
        for (int t = 0; t < 2; ++t) {
            u32x2 k0a, k0b, k1a, k1b, w0a, w0b, w1a, w1b;
            const unsigned ka = trK + 32 * t * 272, wa = trV + (SC_VW - SC_VS) + 32 * t * 80;
            tr_read8(ka, ka + 4 * 272, ka + 32, ka + 32 + 4 * 272, wa, wa + 4 * 80, wa + 32, wa + 32 + 4 * 80, k0a, k0b, k1a, k1b, w0a, w0b, w1a, w1b);
            const bf16x8 kf0 = cat8(k0a, k0b), kf1 = cat8(k1a, k1b), vf0 = cat8(w0a, w0b), vf1 = cat8(w1a, w1b);
            Cacc[0][0] = __builtin_amdgcn_mfma_f32_16x16x32_bf16(kf0, vf0, Cacc[0][0], 0, 0, 0);
            Cacc[0][1] = __builtin_amdgcn_mfma_f32_16x16x32_bf16(kf0, vf1, Cacc[0][1], 0, 0, 0);
            Cacc[1][0] = __builtin_amdgcn_mfma_f32_16x16x32_bf16(kf1, vf0, Cacc[1][0], 0, 0, 0);
            Cacc[1][1] = __builtin_amdgcn_mfma_f32_16x16x32_bf16(kf1, vf1, Cacc[1][1], 0, 0, 0);
            if (!RET) {
                const f32x4 kwa = *(const f32x4*)(lds + SC_KW + (32 * t + 8 * fq) * 4), kwb = *(const f32x4*)(lds + SC_KW + (32 * t + 8 * fq + 4) * 4);
                nsum0 += bflo(k0a.x) * kwa[0] + bfhi(k0a.x) * kwa[1] + bflo(k0a.y) * kwa[2] + bfhi(k0a.y) * kwa[3]
                       + bflo(k0b.x) * kwb[0] + bfhi(k0b.x) * kwb[1] + bflo(k0b.y) * kwb[2] + bfhi(k0b.y) * kwb[3];
                nsum1 += bflo(k1a.x) * kwa[0] + bfhi(k1a.x) * kwa[1] + bflo(k1a.y) * kwa[2] + bfhi(k1a.y) * kwa[3]
                       + bflo(k1b.x) * kwb[0] + bfhi(k1b.x) * kwb[1] + bflo(k1b.y) * kwb[2] + bfhi(k1b.y) * kwb[3];
            }
        }
        if (!RET) { nsum0 += __shfl_xor(nsum0, 16); nsum0 += __shfl_xor(nsum0, 32); nsum1 += __shfl_xor(nsum1, 16); nsum1 += __shfl_xor(nsum1, 32); }
        m_prev = m_new;
        if (n + 1 < 33) local_scan();
        conv_lds((float*)(lds + SC_CONV), cv, tid);
        __syncthreads();
        conv_store((const float*)(lds + SC_CONV), cvt, tid);
    }
}
__device__ void phase_scan(const P& p, int layer, unsigned char* lds, int bid, int nb) {
    for (int it = bid; it < 512; it += nb) {
        const int x = it & 7, y = it >> 3;
        const int ch = (y >> 2) * 8 + x, eq = y & 3;
        const int type = ch >> 6, b = (ch >> 3) & 7, hh = (ch >> 1) & 3, dir = ch & 1;
        const int q0 = (layer >> 1) * DEF_PER_SCAN + it;
        if (type == 0) scan_item<false>(p, layer, lds, b, hh, dir, eq, q0, 512);
        else scan_item<true>(p, layer, lds, b, hh, dir, eq, q0, 512);
    }
}

__device__ void phase_mixfin(const P& p, int layer, int bid, int nb) {
    const int tid = opaque_tid(), lane = tid & 63, wid = tid >> 6, j = layer >> 1;
    float4 g[4];
#pragma unroll
    for (int i = 0; i < 4; ++i) { const int f = 256 * i + 4 * lane; g[i] = (f < 512) ? *(const float4*)(p.e_mg + j * 512 + f) : *(const float4*)(p.e_rg + j * 512 + (f - 512)); }
    int tok = bid * 4 + wid;
    u32x2 an[4], cn_[4], gzn[4];
    auto ld = [&](int tk) {
#pragma unroll
        for (int i = 0; i < 4; ++i) {
            const int f = 256 * i + 4 * lane;
            const int gcol = (f < 512) ? (1536 + f) : (3584 + (f - 512));
            an[i] = *(const u32x2*)(p.osc() + (size_t)tk * 1024 + f);
            cn_[i] = *(const u32x2*)(p.osc() + ((size_t)T_ + tk) * 1024 + f);
            gzn[i] = *(const u32x2*)(p.ze() + (size_t)tk * 4096 + gcol);
        }
    };
    if (tok < T_) ld(tok);
#pragma unroll 1
    for (; tok < T_; tok += nb * 4) {
        u32x2 a[4], c[4], gz[4];
#pragma unroll
        for (int i = 0; i < 4; ++i) { a[i] = an[i]; c[i] = cn_[i]; gz[i] = gzn[i]; }
        if (tok + nb * 4 < T_) ld(tok + nb * 4);
#pragma unroll
        for (int i = 0; i < 4; ++i) {
            const float v[4] = {bflo(a[i].x) + bflo(c[i].x), bfhi(a[i].x) + bfhi(c[i].x), bflo(a[i].y) + bflo(c[i].y), bfhi(a[i].y) + bfhi(c[i].y)};
            const float gzv[4] = {bflo(gz[i].x), bfhi(gz[i].x), bflo(gz[i].y), bfhi(gz[i].y)};
            float ss = v[0] * v[0] + v[1] * v[1] + v[2] * v[2] + v[3] * v[3];
            for (int o = 16; o > 0; o >>= 1) ss += __shfl_xor(ss, o);
            const float r = rsqrtf(ss * (1.f / 128.f) + 1e-6f);
            const float gv[4] = {g[i].x, g[i].y, g[i].z, g[i].w};
            float o4[4];
#pragma unroll
            for (int c2 = 0; c2 < 4; ++c2) {
                const float sg = 1.f / (1.f + __expf(-gzv[c2]));
                const float gate = (i < 2) ? sg : gzv[c2] * sg;
                o4[c2] = gate * (v[c2] * r * gv[c2]);
            }
            u32x2 pk; pk.x = pk2(o4[0], o4[1]); pk.y = pk2(o4[2], o4[3]);
            *(u32x2*)(p.mix() + (size_t)tok * 1024 + 256 * i + 4 * lane) = pk;
        }
    }
}

__device__ void phase_cn(const P& p, int nl, unsigned char* lds, int bid, int nb, bool dry = false) {
    const int tid = opaque_tid(), lane = tid & 63, wid = tid >> 6;
    const bool even = (nl & 1) == 0 && nl < 4;
    const float* g = p.attn_g + (nl < 4 ? nl : 0) * D_;
    if (even) {
        __syncthreads();
        stage_proj16(lds, p.e_win + (size_t)(nl >> 1) * D_ * EVEN_IN + 2048, EVEN_IN, g, tid);
        __syncthreads();
    }
    Row16 gg; ld_f8(g + 8 * lane, gg.v[0]); ld_f8(g + 512 + 8 * lane, gg.v[1]);
    const int eme = e_of_lane(lane);
    const float gbias = p.e_gb[(nl < 4 ? (nl >> 1) : 0) * 16 + eme];
    auto ld_row = [&](int tk, Row16& dst) {
        if (nl != 0) ld_row_bf(p.h() + (size_t)tk * D_, lane, dst);
        else {
            const int b2 = tk / L_, t2 = tk - b2 * L_;
            const float* src = t2 < NM ? p.meta + (size_t)t2 * D_ : p.x + ((size_t)b2 * 2048 + (t2 - NM)) * D_;
            ld_f8(src + 8 * lane, dst.v[0]); ld_f8(src + 512 + 8 * lane, dst.v[1]);
        }
    };
    int tok = bid * 4 + wid;
    Row16 hn; int seln = -1;
    if (tok < T_) {
        ld_row(tok, hn);
        if (nl != 0) seln = p.sel()[(size_t)tok * 16 + (lane & 15)];
    }
#pragma unroll 1
    for (; tok < T_; tok += nb * 4) {
        const int b = tok / L_, t = tok - b * L_;
        Row16 hv = hn;
        const int sel_l = seln;
        {
            const int tn = tok + nb * 4;
            if (tn < T_) {
                ld_row(tn, hn);
                if (nl != 0) seln = p.sel()[(size_t)tn * 16 + (lane & 15)];
            }
        }
        if (nl != 0) {
            unsigned long long msk = __ballot(sel_l >= 0 && lane < 16);
            while (msk) {
                const int e0 = __builtin_ctzll(msk); msk &= msk - 1;
                int e1 = -1; if (msk) { e1 = __builtin_ctzll(msk); msk &= msk - 1; }
                const int s0 = __shfl(sel_l, e0), s1 = __shfl(sel_l, e1 < 0 ? e0 : e1);
                const bf16_t* y0 = p.ys() + ((size_t)(e0 * B_ + b) * CAP + s0) * D_;
                const bf16_t* y1 = p.ys() + ((size_t)((e1 < 0 ? e0 : e1) * B_ + b) * CAP + s1) * D_;
                Row16 a0, a1;
                ld_row_bf(y0, lane, a0); ld_row_bf(y1, lane, a1);
                const float w1 = e1 < 0 ? 0.f : 1.f;
#pragma unroll
                for (int i = 0; i < 2; ++i)
#pragma unroll
                    for (int c = 0; c < 8; ++c) hv.v[i][c] += a0.v[i][c] + w1 * a1.v[i][c];
            }
        }
        if (nl == 4) {
            if (t >= NM) {
                float* op = p.out + ((size_t)b * 2048 + (t - NM)) * D_;
#pragma unroll
                for (int i = 0; i < 2; ++i) {
                    *(float4*)(op + 512 * i + 8 * lane) = make_float4(hv.v[i][0], hv.v[i][1], hv.v[i][2], hv.v[i][3]);
                    *(float4*)(op + 512 * i + 8 * lane + 4) = make_float4(hv.v[i][4], hv.v[i][5], hv.v[i][6], hv.v[i][7]);
                }
            }
            continue;
        }
        if (!dry) {
#pragma unroll
            for (int i = 0; i < 2; ++i) st_bf8(p.h() + (size_t)tok * D_ + 512 * i + 8 * lane, hv.v[i]);
        }
        const float r = rsqrtf(wave_sum(row_sumsq(hv)) * (1.f / D_) + 1e-6f);
#pragma unroll
        for (int i = 0; i < 2; ++i) {
            float uu[8];
#pragma unroll
            for (int c = 0; c < 8; ++c) uu[c] = hv.v[i][c] * r * gg.v[i][c];
            st_bf8(p.u() + (size_t)tok * D_ + 512 * i + 8 * lane, uu);
        }
        if (even) {
            float acc[16];
            proj16_accum(lds, hv, lane, acc);
            const float gv = reduce_scatter16(acc, lane) * r + gbias;
            if ((lane & 3) == 0) p.gts()[(size_t)tok * 16 + eme] = gv;
        }
    }
}

#define XB_TMO      128
#define XB_XCNT(j)  (256  + 64 * (j))
#define XB_XSUB(j)  (1280 + 64 * (j))
#define XB_XGEN(j)  (2304 + 64 * (j))
#define XB_TOP      3328
#define XB_TOPGEN   3392
#define XB_SPIN_CAP (1u << 22)
#define LAS __attribute__((address_space(3)))
__device__ __forceinline__ unsigned xb_ld(unsigned* p)              { return __hip_atomic_load(p, __ATOMIC_RELAXED, __HIP_MEMORY_SCOPE_AGENT); }
__device__ __forceinline__ unsigned xb_add(unsigned* p, unsigned v) { return __hip_atomic_fetch_add(p, v, __ATOMIC_RELAXED, __HIP_MEMORY_SCOPE_AGENT); }
__device__ __forceinline__ unsigned xb_xcc_id() { return (unsigned)__builtin_amdgcn_s_getreg((3 << 11) | 20) & 0xFu; }
#define XB_SPIN(cond, bar) do { unsigned _sp = 0; while (cond) { __builtin_amdgcn_s_sleep(1); \
    if ((++_sp & 255u) == 0u) { if (xb_ld(&(bar)[XB_TMO])) break; if (_sp > XB_SPIN_CAP) { atomicAdd(&(bar)[XB_TMO], 1u); break; } } } } while (0)
struct XcdBarrier { unsigned* bar; unsigned x; unsigned nloc, nx, epoch; };
__device__ __forceinline__ XcdBarrier xcd_barrier_post(unsigned* bar) {
    XcdBarrier b; b.bar = bar; b.x = xb_xcc_id(); b.nloc = 0u; b.nx = 0u; b.epoch = 0u;
    if (threadIdx.x == 0) (void)xb_add(&bar[XB_XCNT(b.x)], 1u);
    return b;
}
__device__ __forceinline__ void xcd_barrier_complete(unsigned* bar, unsigned x, unsigned& nloc, unsigned& nx) {
    const unsigned G = gridDim.x * gridDim.y * gridDim.z;
    unsigned sum, cnt, mine, sp = 0u;
    for (;;) {
        sum = 0u; cnt = 0u; mine = 0u;
#pragma unroll
        for (unsigned j = 0; j < 16; ++j) { const unsigned c = xb_ld(&bar[XB_XCNT(j)]); sum += c; cnt += (c > 0u) ? 1u : 0u; mine = (j == x) ? c : mine; }
        if (sum == G) break;
        __builtin_amdgcn_s_sleep(1);
        if ((++sp & 255u) == 0u) { if (xb_ld(&bar[XB_TMO])) break; if (sp > XB_SPIN_CAP) { atomicAdd(&bar[XB_TMO], 1u); break; } }
    }
    nloc = mine > 0u ? mine : 1u; nx = cnt > 0u ? cnt : 1u;
}
__device__ __forceinline__ void xcd_barrier(XcdBarrier& b) {
    asm volatile("s_waitcnt vmcnt(0)" ::: "memory");
    __syncthreads();
    if (threadIdx.x == 0) {
        unsigned* bar = b.bar; unsigned bx = b.x;
        asm volatile("" : "+s"(bar), "+s"(bx));
        __builtin_amdgcn_s_waitcnt(0);
        const unsigned nloc = b.nloc, nx = b.nx;
        const unsigned old = xb_add(&bar[XB_XSUB(bx)], 1u);
        const unsigned gen = b.epoch;
        if (old + 1u == (gen + 1u) * nloc) {
            __builtin_amdgcn_fence(__ATOMIC_RELEASE, "agent");
            asm volatile("s_waitcnt vmcnt(0)" ::: "memory");
            const unsigned og = xb_add(&bar[XB_TOP], 1u);
            const unsigned tg = b.epoch;
            if (og + 1u == (tg + 1u) * nx) xb_add(&bar[XB_TOPGEN], 1u);
            else XB_SPIN(xb_ld(&bar[XB_TOPGEN]) == tg, bar);
            __builtin_amdgcn_fence(__ATOMIC_ACQUIRE, "agent");
            xb_add(&bar[XB_XGEN(bx)], 1u);
            asm volatile("s_waitcnt vmcnt(0)" ::: "memory");
        } else {
            XB_SPIN(xb_ld(&bar[XB_XGEN(bx)]) == gen, bar);
            __builtin_amdgcn_fence(__ATOMIC_ACQUIRE, "agent");
            asm volatile("s_waitcnt vmcnt(0)" ::: "memory");
        }
    }
    b.epoch += 1u;
    __syncthreads();
}

typedef const __attribute__((address_space(4))) unsigned long long* KArg;
__device__ __forceinline__ P load_args(KArg k) {
    asm volatile("" : "+s"(k));
    P p;
    p.x = (const float*)k[0]; p.meta = (const float*)k[1]; p.attn_g = (const float*)k[2]; p.ffn_g = (const float*)k[3]; p.e_win = (const float*)k[4];
    p.e_conv = (const float*)k[5]; p.e_gb = (const float*)k[6]; p.e_mg = (const float*)k[7]; p.e_decay = (const float*)k[8]; p.e_rg = (const float*)k[9];
    p.e_wout = (const float*)k[10]; p.o_win = (const float*)k[11]; p.o_qg = (const float*)k[12]; p.o_kg = (const float*)k[13]; p.o_rpb = (const float*)k[14];
    p.o_wout = (const float*)k[15]; p.router_w = (const float*)k[16]; p.w_gate = (const float*)k[17]; p.w_up = (const float*)k[18]; p.w_down = (const float*)k[19];
    p.out = (float*)k[20]; p.ws = (unsigned char*)k[21];
    return p;
}
#define PH(call) { const P p = load_args(kp); int bid = bid_, nb = nb_; asm volatile("" : "+s"(bid), "+s"(nb)); call; }
__global__ void __launch_bounds__(NTHR, 2) k_mega(P p_unused) {
    extern __shared__ __attribute__((aligned(16))) unsigned char lds_raw[];
    unsigned char* lds = lds_raw;
    const KArg kp = (KArg)__builtin_amdgcn_kernarg_segment_ptr();
    const int bid_ = blockIdx.x, nb_ = gridDim.x;
    XcdBarrier xb;
    { const P p = load_args(kp); xb = xcd_barrier_post(p.bar()); }
    if (threadIdx.x == 0) { unsigned nloc, nx; xcd_barrier_complete(xb.bar, xb.x, nloc, nx); ((volatile unsigned*)lds)[0] = nloc; ((volatile unsigned*)lds)[1] = nx; }
    __syncthreads();
    xb.nloc = (unsigned)__builtin_amdgcn_readfirstlane((int)((volatile unsigned*)lds)[0]);
    xb.nx = (unsigned)__builtin_amdgcn_readfirstlane((int)((volatile unsigned*)lds)[1]);
    __syncthreads();
#define GB() xcd_barrier(xb)
    PH(phase_tables(p, bid, nb));
    PH(phase_convert(p, lds, bid, nb));
    PH(phase_cn(p, 0, lds, bid, nb));
    GB();
#if PROBE_BARRIER
    for (int i = 0; i < 100; ++i) GB();
#endif
#pragma nounroll
    for (int layer = 0; layer < 4; ++layer) {
        if ((layer & 1) == 0) {
            PH(phase_even_in(p, layer, lds, bid, nb)); GB();
            PH(phase_conv(p, layer, bid, nb)); GB();
#if PROBE_CONV
            PH(phase_conv(p, layer, bid, nb)); GB();
#endif
            PH(phase_scan(p, layer, lds, bid, nb)); GB();
#if PROBE_SCAN
            PH(phase_scan(p, layer, lds, bid, nb)); GB();
#endif
            PH(phase_mixfin(p, layer, bid, nb)); GB();
#if PROBE_MIXFIN
            PH(phase_mixfin(p, layer, bid, nb)); GB();
#endif
            PH(phase_outproj(p, p.WoutE() + (size_t)(layer >> 1) * 1024 * 1024, lds, bid, nb)); GB();
        } else {
            PH(phase_odd_in(p, layer, lds, bid, nb)); GB();
            PH(phase_natten(p, layer, lds, bid, nb)); GB();
#if PROBE_NATTEN
            PH(phase_natten(p, layer, lds, bid, nb)); GB();
#endif
            PH(phase_outproj(p, p.WoutO() + (size_t)(layer >> 1) * 1024 * 1024, lds, bid, nb)); GB();
        }
        PH(phase_router(p, layer, lds, bid, nb)); GB();
#if PROBE_ROUTER
        PH(phase_router(p, layer, lds, bid, nb)); GB();
#endif
        PH(phase_topk(p, lds, bid, nb)); GB();
        PH(phase_gateup(p, layer, lds, bid, nb)); GB();
        PH(phase_down(p, layer, lds, bid, nb)); GB();
#if PROBE_CN
        PH(phase_cn(p, layer + 1, lds, bid, nb, true)); GB();
#endif
        PH(phase_cn(p, layer + 1, lds, bid, nb));
        if (layer < 3) GB();
    }
}

static inline size_t al256(size_t x) { return (x + 255) & ~(size_t)255; }

extern "C" void kernel_launch(void* const* d_in, const int* in_sizes, int n_in, void* d_out, int out_size, void* d_ws, size_t ws_size, hipStream_t stream) {
    P p; memset(&p, 0, sizeof(p));
    p.x = (const float*)d_in[0]; p.meta = (const float*)d_in[1]; p.attn_g = (const float*)d_in[2]; p.ffn_g = (const float*)d_in[3];
    p.e_win = (const float*)d_in[4]; p.e_conv = (const float*)d_in[5]; p.e_gb = (const float*)d_in[6]; p.e_mg = (const float*)d_in[7];
    p.e_decay = (const float*)d_in[8]; p.e_rg = (const float*)d_in[9]; p.e_wout = (const float*)d_in[10]; p.o_win = (const float*)d_in[11];
    p.o_qg = (const float*)d_in[12]; p.o_kg = (const float*)d_in[13]; p.o_rpb = (const float*)d_in[14]; p.o_wout = (const float*)d_in[15];
    p.router_w = (const float*)d_in[16]; p.w_gate = (const float*)d_in[17]; p.w_up = (const float*)d_in[18]; p.w_down = (const float*)d_in[19];
    p.out = (float*)d_out;

    p.ws = (unsigned char*)d_ws;
    if (WS_NEEDED > ws_size) return;

    static int grid_blocks = 0;
    if (!grid_blocks) {
        int dev = 0, cus = 0, per_cu = 0;
        if (hipGetDevice(&dev) != hipSuccess) return;
        if (hipDeviceGetAttribute(&cus, hipDeviceAttributeMultiprocessorCount, dev) != hipSuccess) return;
        if (hipFuncSetAttribute((const void*)k_mega, hipFuncAttributeMaxDynamicSharedMemorySize, LDS_BYTES) != hipSuccess) return;
        if (hipOccupancyMaxActiveBlocksPerMultiprocessor(&per_cu, (const void*)k_mega, NTHR, LDS_BYTES) != hipSuccess || per_cu < 1) return;
        if (per_cu > 2) per_cu = 2;
        cus &= ~7;
        if (cus < 8) return;
        grid_blocks = cus * per_cu;
    }
    (void)hipMemsetAsync(p.ws + OFF_BAR, 0, 16384, stream);
    hipLaunchKernelGGL(k_mega, dim3(grid_blocks), dim3(NTHR), LDS_BYTES, stream, p);
}
```

```cpp
#include <hip/hip_runtime.h>
#include <stdint.h>
#include <string.h>

#ifndef PROBE_CONV
#define PROBE_CONV 0
#endif
#ifndef PROBE_GEMM
#define PROBE_GEMM 0
#endif
#ifndef PROBE_SCAN
#define PROBE_SCAN 0
#endif
#ifndef PROBE_CONVERT
#define PROBE_CONVERT 0
#endif
#ifndef PROBE_NATTEN
#define PROBE_NATTEN 0
#endif
#ifndef PROBE_MISC
#define PROBE_MISC 0
#endif
#ifndef PROBE_MIXFIN
#define PROBE_MIXFIN 0
#endif
#ifndef PROBE_ROUTER
#define PROBE_ROUTER 0
#endif
#ifndef PROBE_TOPK
#define PROBE_TOPK 0
#endif
#ifndef PROBE_BARRIER
#define PROBE_BARRIER 0
#endif
#ifndef PROBE_CN
#define PROBE_CN 0
#endif
#ifndef PROBE_DMA
#define PROBE_DMA 0
#endif
#ifndef PROBE_STAGE
#define PROBE_STAGE 0
#endif
#ifndef PROBE_KLOOP
#define PROBE_KLOOP 0
#endif
#ifndef PROBE_EPI
#define PROBE_EPI 0
#endif
#define B_ 8
#define L_ 2064
#define T_ (B_ * L_)
#define D_ 1024
#define NM 16
#define EVEN_IN 4112
#define ODD_IN 3072
#define NE 16
#define CAP 258
#define NG (B_ * NE)

__device__ __forceinline__ float block_sum256(float v, float* red) {
    for (int o = 32; o > 0; o >>= 1) v += __shfl_xor(v, o);
    __syncthreads();
    if ((threadIdx.x & 63) == 0) red[threadIdx.x >> 6] = v;
    __syncthreads();
    return red[0] + red[1] + red[2] + red[3];
}
__device__ __forceinline__ float sigmoidf_(float x) { return 1.f / (1.f + expf(-x)); }
__device__ __forceinline__ float siluf_(float x) { return x / (1.f + expf(-x)); }
__device__ __forceinline__ float fmax_nc(float a, float b) { return __builtin_amdgcn_fmed3f(a, b, __builtin_inff()); }
__device__ __forceinline__ float fmax3_raw(float a, float b, float c) { float r; asm("v_max3_f32 %0, %1, %2, %3" : "=v"(r) : "v"(a), "v"(b), "v"(c)); return r; }
__device__ __forceinline__ float frcp(float x) { return __builtin_amdgcn_rcpf(x); }
__device__ __forceinline__ float frsq(float x) { return __builtin_amdgcn_rsqf(x); }
__device__ __forceinline__ float logsigmoidf_(float x) { return fminf(x, 0.f) - __logf(1.f + __expf(-fabsf(x))); }


typedef unsigned short bf16_t;
typedef short bf16x8 __attribute__((ext_vector_type(8)));
typedef float f32x4 __attribute__((ext_vector_type(4)));
typedef unsigned u32x4 __attribute__((ext_vector_type(4)));
typedef unsigned u32x2 __attribute__((ext_vector_type(2)));

#define NTHR 256
#define ESLOTS 2064
#define LDS_BYTES (80 * 1024)

__device__ __forceinline__ unsigned f2bf(float f) { unsigned u = __builtin_bit_cast(unsigned, f); return (u + 0x7fffu + ((u >> 16) & 1u)) >> 16; }
typedef __attribute__((ext_vector_type(2))) __bf16 bf16pair_t;
typedef __attribute__((ext_vector_type(2))) float f32pair_t;
__device__ __forceinline__ unsigned pk2(float lo, float hi) { const f32pair_t v = {lo, hi}; const bf16pair_t r = __builtin_convertvector(v, bf16pair_t); return __builtin_bit_cast(unsigned, r); }
__device__ __forceinline__ float bf2f(unsigned short b) { return __builtin_bit_cast(float, (unsigned)b << 16); }
__device__ __forceinline__ float bflo(unsigned w) { return __builtin_bit_cast(float, w << 16); }
__device__ __forceinline__ float bfhi(unsigned w) { return __builtin_bit_cast(float, w & 0xffff0000u); }

#define AL256(x) (((x) + 255) & ~(size_t)255)
constexpr size_t OFF_BAR = 0;
constexpr size_t OFF_WGU = 16384;
constexpr size_t OFF_WD = OFF_WGU + AL256((size_t)4 * 16 * 2048 * 1024 * 2);
constexpr size_t OFF_WINE = OFF_WD + AL256((size_t)4 * 16 * 1024 * 1024 * 2);
constexpr size_t OFF_WINO = OFF_WINE + AL256((size_t)2 * 4096 * 1024 * 2);
constexpr size_t OFF_WOUTE = OFF_WINO + AL256((size_t)2 * 3072 * 1024 * 2);
constexpr size_t OFF_WOUTO = OFF_WOUTE + AL256((size_t)2 * 1024 * 1024 * 2);
constexpr size_t OFF_H = OFF_WOUTO + AL256((size_t)2 * 1024 * 1024 * 2);
constexpr size_t OFF_U = OFF_H + AL256((size_t)T_ * D_ * 4);
constexpr size_t OFF_ZE = OFF_U + AL256((size_t)T_ * D_ * 2);
constexpr size_t OFF_QC = OFF_ZE + AL256((size_t)T_ * 4096 * 2);
constexpr size_t OFF_OSC = OFF_QC + AL256((size_t)T_ * D_ * 2);
constexpr size_t OFF_MIX = OFF_OSC + AL256((size_t)2 * T_ * D_ * 2);
constexpr size_t OFF_GTS = OFF_MIX + AL256((size_t)T_ * D_ * 2);
constexpr size_t OFF_AFF = OFF_GTS + AL256((size_t)T_ * 16 * 4);
constexpr size_t OFF_GATE = OFF_AFF + AL256((size_t)T_ * 16 * 4);
constexpr size_t OFF_IDX = OFF_GATE + AL256((size_t)NE * ESLOTS * 4);
constexpr size_t OFF_SEL = OFF_IDX + AL256((size_t)NE * ESLOTS * 4);
constexpr size_t OFF_COS = OFF_SEL + AL256((size_t)T_ * 16 * 4);
constexpr size_t OFF_SIN = OFF_COS + AL256((size_t)L_ * 64 * 4);
constexpr size_t WS_NEEDED = OFF_SIN + AL256((size_t)L_ * 64 * 4);

__device__ __forceinline__ int opaque_tid() { int t = threadIdx.x; asm volatile("" : "+v"(t)); return t; }

struct P {
    const float *x, *meta, *attn_g, *ffn_g, *e_win, *e_conv, *e_gb, *e_mg, *e_decay, *e_rg, *e_wout, *o_win, *o_qg, *o_kg, *o_rpb, *o_wout, *router_w, *w_gate, *w_up, *w_down;
    float* out;
    unsigned char* ws;
    __device__ __forceinline__ unsigned* bar() const { return (unsigned*)(ws + OFF_BAR); }
    __device__ __forceinline__ bf16_t* Wgu() const { return (bf16_t*)(ws + OFF_WGU); }
    __device__ __forceinline__ bf16_t* Wd() const { return (bf16_t*)(ws + OFF_WD); }
    __device__ __forceinline__ bf16_t* WinE() const { return (bf16_t*)(ws + OFF_WINE); }
    __device__ __forceinline__ bf16_t* WinO() const { return (bf16_t*)(ws + OFF_WINO); }
    __device__ __forceinline__ bf16_t* WoutE() const { return (bf16_t*)(ws + OFF_WOUTE); }
    __device__ __forceinline__ bf16_t* WoutO() const { return (bf16_t*)(ws + OFF_WOUTO); }
    __device__ __forceinline__ bf16_t* h() const { return (bf16_t*)(ws + OFF_H); }
    __device__ __forceinline__ bf16_t* u() const { return (bf16_t*)(ws + OFF_U); }
    __device__ __forceinline__ bf16_t* ze() const { return (bf16_t*)(ws + OFF_ZE); }
    __device__ __forceinline__ bf16_t* zo() const { return (bf16_t*)(ws + OFF_ZE); }
    __device__ __forceinline__ bf16_t* kh() const { return (bf16_t*)(ws + OFF_ZE) + (size_t)T_ * 1024; }
    __device__ __forceinline__ bf16_t* vT() const { return (bf16_t*)(ws + OFF_ZE) + (size_t)T_ * 2048; }
    __device__ __forceinline__ bf16_t* ys() const { return (bf16_t*)(ws + OFF_ZE); }
    __device__ __forceinline__ bf16_t* qc() const { return (bf16_t*)(ws + OFF_QC); }
    __device__ __forceinline__ bf16_t* osc() const { return (bf16_t*)(ws + OFF_OSC); }
    __device__ __forceinline__ bf16_t* hdn() const { return (bf16_t*)(ws + OFF_OSC); }
    __device__ __forceinline__ bf16_t* mix() const { return (bf16_t*)(ws + OFF_MIX); }
    __device__ __forceinline__ float* gts() const { return (float*)(ws + OFF_GTS); }
    __device__ __forceinline__ float* aff() const { return (float*)(ws + OFF_AFF); }
    __device__ __forceinline__ float* gate() const { return (float*)(ws + OFF_GATE); }
    __device__ __forceinline__ int* idx() const { return (int*)(ws + OFF_IDX); }
    __device__ __forceinline__ int* sel() const { return (int*)(ws + OFF_SEL); }
    __device__ __forceinline__ float* costab() const { return (float*)(ws + OFF_COS); }
    __device__ __forceinline__ float* sintab() const { return (float*)(ws + OFF_SIN); }
};

__device__ __forceinline__ void conv_desc(const P& p, int rt, const float*& src_base, size_t& le_off, int& ld, bf16_t*& dst, int& kind, int& n0) {
    le_off = 0;
    if (rt < 2048) { const int le = rt >> 5, t = rt & 31; kind = 1; ld = 1024; src_base = p.w_gate; le_off = (size_t)le * 1024 * 1024; dst = p.Wgu() + (size_t)le * 2048 * 1024; n0 = t * 64; return; }
    rt -= 2048;
    if (rt < 1024) { const int le = rt >> 4, t = rt & 15; kind = 3; ld = 1024; src_base = p.w_down + (size_t)le * 1024 * 1024; dst = p.Wd() + (size_t)le * 1024 * 1024; n0 = t * 64; return; }
    rt -= 1024;
    if (rt < 128) { const int j = rt >> 6, t = rt & 63; kind = 2; ld = EVEN_IN; src_base = p.e_win + (size_t)j * 1024 * EVEN_IN; dst = p.WinE() + (size_t)j * 4096 * 1024; n0 = t * 64; return; }
    rt -= 128;
    if (rt < 96) { const int j = rt / 48, t = rt % 48; kind = (t < 32) ? 3 : 0; ld = ODD_IN; src_base = p.o_win + (size_t)j * 1024 * ODD_IN; dst = p.WinO() + (size_t)j * 3072 * 1024; n0 = t * 64; return; }
    rt -= 96;
    if (rt < 32) { const int j = rt >> 4, t = rt & 15; kind = 3; ld = 1024; src_base = p.e_wout + (size_t)j * 1024 * 1024; dst = p.WoutE() + (size_t)j * 1024 * 1024; n0 = t * 64; return; }
    rt -= 32;
    { const int j = rt >> 4, t = rt & 15; kind = 3; ld = 1024; src_base = p.o_wout + (size_t)j * 1024 * 1024; dst = p.WoutO() + (size_t)j * 1024 * 1024; n0 = t * 64; return; }
}
#define N_CONV_ROWTILES 3360
struct ConvTile { bf16_t* dst; int n0, k0; };
__device__ __forceinline__ void conv_load(const P& p, int rt, int kt, int tid, float4 (&cv)[4], ConvTile& ct) {
    const int tn4 = tid & 15, tk = tid >> 4, k0 = kt * 64;
    const float* src_base; size_t le_off; int ld, kind, n0; bf16_t* dst;
    conv_desc(p, rt, src_base, le_off, ld, dst, kind, n0);
    const int n = n0 + tn4 * 4;
    const float* sp;
    if (kind == 0) sp = src_base + n;
    else if (kind == 3) {
        const int r = n & 31, nn = r >> 4, i = r & 15;
        sp = src_base + (n & ~31) + 8 * (i >> 2) + 4 * nn + (i & 3);
    }
    else if (kind == 1) {
        const int tn = n >> 7, r = n & 127, wc = r >> 6, nn = (r >> 4) & 3, i = r & 15;
        const int col = 64 * tn + 32 * wc + 8 * (i >> 2) + 4 * (nn & 1) + (i & 3);
        sp = ((nn < 2) ? p.w_gate : p.w_up) + le_off + col;
    } else {
        const int seg = n >> 9, j = n & 511;
        const int base = seg < 4 ? seg * 512 : 2064 + (seg - 4) * 512;
        int col;
        if (seg == 4 || seg == 5) {
            const int head = j >> 7, r = j & 127, wc = r >> 6, nn = (r >> 4) & 3, i = r & 15;
            col = head * 128 + (nn & 1) * 64 + 32 * wc + 8 * (i >> 2) + 4 * (nn >> 1) + (i & 3);
        } else {
            const int r = j & 31, nn = r >> 4, i = r & 15;
            col = (j & ~31) + 8 * (i >> 2) + 4 * nn + (i & 3);
        }
        sp = src_base + base + col;
    }
#pragma unroll
    for (int i = 0; i < 4; ++i) cv[i] = *(const float4*)(sp + (size_t)(k0 + tk + 16 * i) * ld);
    ct.dst = dst; ct.n0 = n0; ct.k0 = k0;
}
__device__ __forceinline__ void conv_lds(float* tile, const float4 (&cv)[4], int tid) {
    const int tn4 = tid & 15, tk = tid >> 4;
#pragma unroll
    for (int i = 0; i < 4; ++i) {
        const int kk = tk + 16 * i;
        tile[(tn4 * 4 + 0) * 65 + kk] = cv[i].x; tile[(tn4 * 4 + 1) * 65 + kk] = cv[i].y; tile[(tn4 * 4 + 2) * 65 + kk] = cv[i].z; tile[(tn4 * 4 + 3) * 65 + kk] = cv[i].w;
    }
}
__device__ __forceinline__ void conv_store(const float* tile, const ConvTile& ct, int tid) {
    const int row = tid >> 2, sg = tid & 3;
    const float* tr = tile + row * 65 + sg * 16;
    u32x4 w0, w1;
    w0.x = pk2(tr[0], tr[1]); w0.y = pk2(tr[2], tr[3]); w0.z = pk2(tr[4], tr[5]); w0.w = pk2(tr[6], tr[7]);
    w1.x = pk2(tr[8], tr[9]); w1.y = pk2(tr[10], tr[11]); w1.z = pk2(tr[12], tr[13]); w1.w = pk2(tr[14], tr[15]);
    bf16_t* dp = ct.dst + (size_t)(ct.n0 + row) * 1024 + ct.k0 + sg * 16;
    *(u32x4*)dp = w0; *(u32x4*)(dp + 8) = w1;
}
#define DEF_PER_LAYER 12288
#define DEF_PER_SCAN (33 * 512)
#define DEF_TOTAL (3 * DEF_PER_LAYER)
__device__ __forceinline__ void deferred_tile(int q, int& rt, int& kt) {
    const int layer = 1 + q / DEF_PER_LAYER, r = q % DEF_PER_LAYER, rtl = r >> 4;
    kt = r & 15;
    rt = (rtl < 512) ? (512 * layer + rtl) : (2048 + 256 * layer + (rtl - 512));
}
__device__ __forceinline__ void deferred_load(const P& p, int q, int tid, float4 (&cv)[4], ConvTile& ct) {
    const int tn4 = tid & 15, tk = tid >> 4;
    const int layer = 1 + q / DEF_PER_LAYER, r = q - (layer - 1) * DEF_PER_LAYER, rtl = r >> 4, k0 = (r & 15) * 64;
    const float* sp; bf16_t* dst; int n0;
    if (rtl < 512) {
        const int le = layer * 16 + (rtl >> 5); n0 = (rtl & 31) * 64;
        const int n = n0 + tn4 * 4, tn = n >> 7, rr = n & 127, wc = rr >> 6, nn = (rr >> 4) & 3, i = rr & 15;
        const int col = 64 * tn + 32 * wc + 8 * (i >> 2) + 4 * (nn & 1) + (i & 3);
        sp = ((nn < 2) ? p.w_gate : p.w_up) + (size_t)le * 1024 * 1024 + col;
        dst = p.Wgu() + (size_t)le * 2048 * 1024;
    } else {
        const int rd = rtl - 512, le = layer * 16 + (rd >> 4); n0 = (rd & 15) * 64;
        const int n = n0 + tn4 * 4, r2 = n & 31, nn = r2 >> 4, i = r2 & 15;
        sp = p.w_down + (size_t)le * 1024 * 1024 + (n & ~31) + 8 * (i >> 2) + 4 * nn + (i & 3);
        dst = p.Wd() + (size_t)le * 1024 * 1024;
    }
#pragma unroll
    for (int i = 0; i < 4; ++i) cv[i] = *(const float4*)(sp + (size_t)(k0 + tk + 16 * i) * 1024);
    ct.dst = dst; ct.n0 = n0; ct.k0 = k0;
}
#define P0_RTS (512 + 256 + 288)
#define P0_TILES (P0_RTS * 16 + (DEF_TOTAL - 2 * DEF_PER_SCAN))
__device__ __forceinline__ void phase_convert(const P& p, unsigned char* lds, int bid, int nb) {
    float* tile = (float*)lds;
    const int tid = opaque_tid();
    float4 c0[4], c1[4], c2[4]; ConvTile t0, t1, t2; bool v0, v1, v2;
    auto request = [&](int it, float4 (&cv)[4], ConvTile& ct, bool& valid) {
        valid = it < P0_TILES;
        if (valid) {
            int rt, kt;
            if (it < P0_RTS * 16) { const int r = it >> 4; kt = it & 15; rt = r < 512 ? r : (r < 768 ? 2048 + (r - 512) : 3072 + (r - 768)); }
            else deferred_tile(2 * DEF_PER_SCAN + (it - P0_RTS * 16), rt, kt);
            conv_load(p, rt, kt, tid, cv, ct);
        }
    };
    auto finish = [&](const float4 (&cv)[4], const ConvTile& ct, bool valid) {
        if (valid) {
            __syncthreads();
            conv_lds(tile, cv, tid);
            __syncthreads();
            conv_store(tile, ct, tid);
        }
    };
    int it = bid;
    request(it, c0, t0, v0); request(it + nb, c1, t1, v1);
    while (v0) {
        request(it + 2 * nb, c2, t2, v2); finish(c0, t0, v0);
        request(it + 3 * nb, c0, t0, v0); finish(c1, t1, v1);
        request(it + 4 * nb, c1, t1, v1); finish(c2, t2, v2);
        it += 3 * nb;
    }
}

struct TileAddr { const char* ab; const char* bb; unsigned ao[6]; unsigned bo; };
struct Prefetch { bool have; TileAddr t; float r0, r1; };
typedef __attribute__((address_space(3))) unsigned LdsU;
typedef const __attribute__((address_space(1))) unsigned GlbU;
__device__ __forceinline__ unsigned gemm_chunk_off(int tid) { return (unsigned)(((tid & 7) ^ ((tid >> 4) & 7)) * 16); }
#define GLDS_STEP(voff, sbase) "s_nop 0\n\tglobal_load_lds_dwordx4 " voff ", " sbase "\n\ts_add_u32 m0, m0, 0x1000\n\t"
template <int MT>
__device__ __forceinline__ void gemm_stage(const TileAddr& t, unsigned char* lds, int st, int ko, int tid) {
    constexpr int ABYTES = 4096 * MT, SBYTES = ABYTES + 16384;
    const char* a_ = t.ab + ko * 2;
    const char* b0 = t.bb + ko * 2; const char* b1 = b0 + 65536; const char* b2 = b0 + 131072; const char* b3 = b0 + 196608;
    const int wfirst = __builtin_amdgcn_readfirstlane(tid) & ~63;
    const unsigned ld0 = (unsigned)(size_t)(lds + st * SBYTES + wfirst * 16);
    unsigned keep;
    if (MT == 6) {
        asm volatile("s_nop 4\n\ts_mov_b32 %[keep], m0\n\ts_mov_b32 m0, %[ld]\n\t"
                     GLDS_STEP("%[a0]", "%[ab]") GLDS_STEP("%[a1]", "%[ab]") GLDS_STEP("%[a2]", "%[ab]") GLDS_STEP("%[a3]", "%[ab]") GLDS_STEP("%[a4]", "%[ab]") GLDS_STEP("%[a5]", "%[ab]")
                     GLDS_STEP("%[bo]", "%[b0]") GLDS_STEP("%[bo]", "%[b1]") GLDS_STEP("%[bo]", "%[b2]") GLDS_STEP("%[bo]", "%[b3]")
                     "s_mov_b32 m0, %[keep]"
                     : [keep] "=&s"(keep)
                     : [ld] "s"(ld0), [ab] "s"(a_), [b0] "s"(b0), [b1] "s"(b1), [b2] "s"(b2), [b3] "s"(b3),
                       [a0] "v"(t.ao[0]), [a1] "v"(t.ao[1]), [a2] "v"(t.ao[2]), [a3] "v"(t.ao[3]), [a4] "v"(t.ao[4]), [a5] "v"(t.ao[5]), [bo] "v"(t.bo)
                     : "memory", "scc");
    } else if (MT == 4) {
        asm volatile("s_nop 4\n\ts_mov_b32 %[keep], m0\n\ts_mov_b32 m0, %[ld]\n\t"
                     GLDS_STEP("%[a0]", "%[ab]") GLDS_STEP("%[a1]", "%[ab]") GLDS_STEP("%[a2]", "%[ab]") GLDS_STEP("%[a3]", "%[ab]")
                     GLDS_STEP("%[bo]", "%[b0]") GLDS_STEP("%[bo]", "%[b1]") GLDS_STEP("%[bo]", "%[b2]") GLDS_STEP("%[bo]", "%[b3]")
                     "s_mov_b32 m0, %[keep]"
                     : [keep] "=&s"(keep)
                     : [ld] "s"(ld0), [ab] "s"(a_), [b0] "s"(b0), [b1] "s"(b1), [b2] "s"(b2), [b3] "s"(b3),
                       [a0] "v"(t.ao[0]), [a1] "v"(t.ao[1]), [a2] "v"(t.ao[2]), [a3] "v"(t.ao[3]), [bo] "v"(t.bo)
                     : "memory", "scc");
    } else {
        asm volatile("s_nop 4\n\ts_mov_b32 %[keep], m0\n\ts_mov_b32 m0, %[ld]\n\t"
                     GLDS_STEP("%[a0]", "%[ab]")
                     GLDS_STEP("%[bo]", "%[b0]") GLDS_STEP("%[bo]", "%[b1]") GLDS_STEP("%[bo]", "%[b2]") GLDS_STEP("%[bo]", "%[b3]")
                     "s_mov_b32 m0, %[keep]"
                     : [keep] "=&s"(keep)
                     : [ld] "s"(ld0), [ab] "s"(a_), [b0] "s"(b0), [b1] "s"(b1), [b2] "s"(b2), [b3] "s"(b3), [a0] "v"(t.ao[0]), [bo] "v"(t.bo)
                     : "memory", "scc");
    }
}
#define GT_DMA_WAIT() asm volatile("s_waitcnt vmcnt(0)" ::: "memory")
__device__ __forceinline__ const char* uni_ptr(const void* q) {
    const unsigned long long v = (unsigned long long)q;
    const unsigned lo = (unsigned)__builtin_amdgcn_readfirstlane((int)(unsigned)v), hi = (unsigned)__builtin_amdgcn_readfirstlane((int)(unsigned)(v >> 32));
    return (const char*)(((unsigned long long)hi << 32) | lo);
}
template <int MT>
__device__ __forceinline__ void rv_load(const float* tab, int rbase, int rmax, int fr, int fq, float& r0, float& r1) {
    const char* base = uni_ptr(tab);
    const unsigned o0 = (unsigned)min(rbase + 16 * fq + fr, rmax) * 4u, o1 = (unsigned)min(rbase + 16 * (fq + 4) + fr, rmax) * 4u;
    asm volatile("s_nop 4\n\tglobal_load_dword %0, %2, %4\n\tglobal_load_dword %1, %3, %4" : "=&v"(r0), "=&v"(r1) : "v"(o0), "v"(o1), "s"(base));
}
#define RV_PIN(r0, r1) asm volatile("" : "+v"(r0), "+v"(r1))
#define RV_DONE(r0, r1) asm volatile("s_waitcnt vmcnt(0)" : "+v"(r0), "+v"(r1) :: "memory")
__device__ __forceinline__ float rv_get(float r0, float r1, int m, int fr) { return __shfl(m < 4 ? r0 : r1, fr + 16 * (m & 3)); }
template <bool SWAP, int MT>
__device__ __forceinline__ void gemm_tile(const TileAddr& t, unsigned char* lds, f32x4 (&acc)[MT][4], int tid, bool prestaged = false, const TileAddr* next = nullptr) {
    constexpr int K = 1024, ABYTES = 4096 * MT, SBYTES = ABYTES + 16384;
    const int lane = tid & 63, wid = tid >> 6, wr = wid >> 1, wc = wid & 1, fr = lane & 15, fq = lane >> 4;
    const int sw = (fr >> 1) & 7;
    const int aofs = (wr * 16 * MT + fr) * 128, bofs = ABYTES + (wc * 64 + fr) * 128;
    const int c0 = ((0 + fq) ^ sw) << 4, c1 = ((4 + fq) ^ sw) << 4;
#pragma unroll
    for (int m = 0; m < MT; ++m)
#pragma unroll
        for (int n = 0; n < 4; ++n) acc[m][n] = (f32x4){0.f, 0.f, 0.f, 0.f};
#define GT_READ(st) const unsigned char* sA = lds + (st) * SBYTES + aofs; const unsigned char* sB = lds + (st) * SBYTES + bofs; \
        bf16x8 af0[MT], bf0[4], af1[MT], bf1[4]; \
        _Pragma("unroll") for (int n = 0; n < 4; ++n) bf0[n] = *(const bf16x8*)(sB + n * 2048 + c0); \
        _Pragma("unroll") for (int m = 0; m < MT; ++m) af0[m] = *(const bf16x8*)(sA + m * 2048 + c0); \
        _Pragma("unroll") for (int n = 0; n < 4; ++n) bf1[n] = *(const bf16x8*)(sB + n * 2048 + c1); \
        _Pragma("unroll") for (int m = 0; m < MT; ++m) af1[m] = *(const bf16x8*)(sA + m * 2048 + c1);
#define GT_MMA() __builtin_amdgcn_s_setprio(1); \
        _Pragma("unroll") for (int m = 0; m < MT; ++m) _Pragma("unroll") for (int n = 0; n < 4; ++n) { \
            if (SWAP) acc[m][n] = __builtin_amdgcn_mfma_f32_16x16x32_bf16(af0[m], bf0[n], acc[m][n], 0, 0, 0); \
            else      acc[m][n] = __builtin_amdgcn_mfma_f32_16x16x32_bf16(bf0[n], af0[m], acc[m][n], 0, 0, 0); } \
        _Pragma("unroll") for (int m = 0; m < MT; ++m) _Pragma("unroll") for (int n = 0; n < 4; ++n) { \
            if (SWAP) acc[m][n] = __builtin_amdgcn_mfma_f32_16x16x32_bf16(af1[m], bf1[n], acc[m][n], 0, 0, 0); \
            else      acc[m][n] = __builtin_amdgcn_mfma_f32_16x16x32_bf16(bf1[n], af1[m], acc[m][n], 0, 0, 0); } \
        __builtin_amdgcn_s_setprio(0);
    constexpr int nk = K >> 6;
    if (!prestaged) gemm_stage<MT>(t, lds, 0, 0, tid);
    GT_DMA_WAIT(); __syncthreads();
#pragma unroll 1
    for (int kt = 0; kt < nk - 2; kt += 2) {
        { GT_READ(0) gemm_stage<MT>(t, lds, 1, (kt + 1) * 64, tid); GT_MMA() }
        GT_DMA_WAIT(); __syncthreads();
        { GT_READ(1) gemm_stage<MT>(t, lds, 0, (kt + 2) * 64, tid); GT_MMA() }
        GT_DMA_WAIT(); __syncthreads();
    }
    { GT_READ(0) gemm_stage<MT>(t, lds, 1, (nk - 1) * 64, tid); GT_MMA() }
    GT_DMA_WAIT(); __syncthreads();
    { GT_READ(1) GT_MMA() }
    __syncthreads();
    if (next) gemm_stage<MT>(*next, lds, 0, 0, tid);
#undef GT_READ
#undef GT_MMA
}
template <int MT>
__device__ __forceinline__ void tile_addr_rows(TileAddr& t, const bf16_t* A, int row0, const bf16_t* W, int nt, int tid) {
    const int lrow = tid >> 3; const unsigned ch = gemm_chunk_off(tid);
    t.ab = (const char*)A; t.bb = (const char*)W; t.bo = (unsigned)(nt * 128 + lrow) * 2048u + ch;
#pragma unroll
    for (int i = 0; i < MT; ++i) t.ao[i] = (unsigned)(row0 + lrow + 32 * i) * 2048u + ch;
}

__device__ __forceinline__ void rows_swap16(float x, float& a, float& b) { const auto r = __builtin_amdgcn_permlane16_swap(__builtin_bit_cast(unsigned, x), __builtin_bit_cast(unsigned, x), false, false); const unsigned ua = r[0], ub = r[1]; a = __builtin_bit_cast(float, ua); b = __builtin_bit_cast(float, ub); }
__device__ __forceinline__ void rows_swap32(float x, float& a, float& b) { const auto r = __builtin_amdgcn_permlane32_swap(__builtin_bit_cast(unsigned, x), __builtin_bit_cast(unsigned, x), false, false); const unsigned ua = r[0], ub = r[1]; a = __builtin_bit_cast(float, ua); b = __builtin_bit_cast(float, ub); }
__device__ __forceinline__ float row_bcast_w(float x, int w) {
    float a, b; rows_swap16(x, a, b);
    const float y = (w & 1) ? b : a;
    float c, d; rows_swap32(y, c, d);
    return (w & 2) ? d : c;
}
__device__ __forceinline__ float rows_sum(float x) { float a, b; rows_swap16(x, a, b); x = a + b; rows_swap32(x, a, b); return a + b; }
__device__ __forceinline__ float rows_max(float x) { float a, b; rows_swap16(x, a, b); x = fmaxf(a, b); rows_swap32(x, a, b); return fmaxf(a, b); }

struct Row16 { float v[2][8]; };
__device__ __forceinline__ void ld_bf8(const bf16_t* q, float (&d)[8]) {
    const u32x4 w = *(const u32x4*)q;
    d[0] = bflo(w.x); d[1] = bfhi(w.x); d[2] = bflo(w.y); d[3] = bfhi(w.y); d[4] = bflo(w.z); d[5] = bfhi(w.z); d[6] = bflo(w.w); d[7] = bfhi(w.w);
}
__device__ __forceinline__ void st_bf8(bf16_t* q, const float (&d)[8]) {
    u32x4 w; w.x = pk2(d[0], d[1]); w.y = pk2(d[2], d[3]); w.z = pk2(d[4], d[5]); w.w = pk2(d[6], d[7]); *(u32x4*)q = w;
}
__device__ __forceinline__ void ld_f8(const float* q, float (&d)[8]) {
    const float4 a = *(const float4*)q, b = *(const float4*)(q + 4);
    d[0] = a.x; d[1] = a.y; d[2] = a.z; d[3] = a.w; d[4] = b.x; d[5] = b.y; d[6] = b.z; d[7] = b.w;
}
__device__ __forceinline__ void ld_row_bf(const bf16_t* row, int lane, Row16& r) { ld_bf8(row + 8 * lane, r.v[0]); ld_bf8(row + 512 + 8 * lane, r.v[1]); }
__device__ __forceinline__ float row_sumsq(const Row16& r) {
    float s = 0.f;
#pragma unroll
    for (int i = 0; i < 2; ++i)
#pragma unroll
        for (int c = 0; c < 8; ++c) s += r.v[i][c] * r.v[i][c];
    return s;
}
__device__ __forceinline__ void stage_proj16(unsigned char* lds, const float* W, int ldw, const float* g, int tid) {
#pragma unroll
    for (int r = 0; r < 4; ++r) {
        const int k = tid + 256 * r;
        const int i = k >> 9, ln = (k >> 3) & 63, c = k & 7;
        const int rho = 64 * (8 * i + c) + ln;
        const float gk = g[k];
        const float4* wp = (const float4*)(W + (size_t)k * ldw);
#pragma unroll
        for (int ch = 0; ch < 4; ++ch) {
            float4 w = wp[ch]; w.x *= gk; w.y *= gk; w.z *= gk; w.w *= gk;
            *(float4*)(lds + rho * 64 + ((ch ^ ((rho >> 2) & 3)) << 4)) = w;
        }
    }
}
__device__ __forceinline__ void proj16_accum(const unsigned char* lds, const Row16& h, int lane, float (&acc)[16]) {
#pragma unroll
    for (int e = 0; e < 16; ++e) acc[e] = 0.f;
#pragma unroll
    for (int i = 0; i < 2; ++i) {
#pragma unroll
        for (int c = 0; c < 8; ++c) {
            const int rho = 64 * (8 * i + c) + lane;
            const unsigned char* rp = lds + rho * 64;
            const int sw = (rho >> 2) & 3;
#pragma unroll
            for (int ch = 0; ch < 4; ++ch) {
                const float4 w = *(const float4*)(rp + ((ch ^ sw) << 4));
                const f32pair_t hh = {h.v[i][c], h.v[i][c]};
                f32pair_t a01 = {acc[ch * 4 + 0], acc[ch * 4 + 1]}, a23 = {acc[ch * 4 + 2], acc[ch * 4 + 3]};
                a01 = __builtin_elementwise_fma(hh, (f32pair_t){w.x, w.y}, a01); a23 = __builtin_elementwise_fma(hh, (f32pair_t){w.z, w.w}, a23);
                acc[ch * 4 + 0] = a01[0]; acc[ch * 4 + 1] = a01[1]; acc[ch * 4 + 2] = a23[0]; acc[ch * 4 + 3] = a23[1];
            }
            if (c == 3) __builtin_amdgcn_sched_barrier(0);
        }
        __builtin_amdgcn_sched_barrier(0);
    }
}
__device__ __forceinline__ void proj16_accum2(const unsigned char* lds, const Row16& ha, const Row16& hb, int lane, float (&acca)[16], float (&accb)[16]) {
#pragma unroll
    for (int e = 0; e < 16; ++e) { acca[e] = 0.f; accb[e] = 0.f; }
#pragma unroll
    for (int i = 0; i < 2; ++i) {
#pragma unroll
        for (int c = 0; c < 8; ++c) {
            const int rho = 64 * (8 * i + c) + lane;
            const unsigned char* rp = lds + rho * 64;
            const int sw = (rho >> 2) & 3;
#pragma unroll
            for (int ch = 0; ch < 4; ++ch) {
                const float4 w = *(const float4*)(rp + ((ch ^ sw) << 4));
                acca[ch * 4 + 0] += ha.v[i][c] * w.x; acca[ch * 4 + 1] += ha.v[i][c] * w.y; acca[ch * 4 + 2] += ha.v[i][c] * w.z; acca[ch * 4 + 3] += ha.v[i][c] * w.w;
                accb[ch * 4 + 0] += hb.v[i][c] * w.x; accb[ch * 4 + 1] += hb.v[i][c] * w.y; accb[ch * 4 + 2] += hb.v[i][c] * w.z; accb[ch * 4 + 3] += hb.v[i][c] * w.w;
            }
            if (c == 3) __builtin_amdgcn_sched_barrier(0);
        }
        __builtin_amdgcn_sched_barrier(0);
    }
}
__device__ __forceinline__ int e_of_lane(int lane) { return ((lane >> 5) & 1) * 8 + ((lane >> 4) & 1) * 4 + ((lane >> 3) & 1) * 2 + ((lane >> 2) & 1); }
__device__ __forceinline__ float reduce_scatter16(const float (&a)[16], int lane) {
    float b8[8], b4[4], b2[2];
#pragma unroll
    for (int e = 0; e < 8; ++e) {
        const auto r = __builtin_amdgcn_permlane32_swap(__builtin_bit_cast(unsigned, a[e]), __builtin_bit_cast(unsigned, a[e + 8]), false, false);
        const unsigned ux = r[0], uy = r[1]; b8[e] = __builtin_bit_cast(float, ux) + __builtin_bit_cast(float, uy);
    }
#pragma unroll
    for (int e = 0; e < 4; ++e) {
        const auto r = __builtin_amdgcn_permlane16_swap(__builtin_bit_cast(unsigned, b8[e]), __builtin_bit_cast(unsigned, b8[e + 4]), false, false);
        const unsigned ux = r[0], uy = r[1]; b4[e] = __builtin_bit_cast(float, ux) + __builtin_bit_cast(float, uy);
    }
    { const bool up = (lane & 8) != 0;
#pragma unroll
      for (int e = 0; e < 2; ++e) { const float keep = up ? b4[e + 2] : b4[e], send = up ? b4[e] : b4[e + 2]; b2[e] = keep + __shfl_xor(send, 8); } }
    float b1;
    { const bool up = (lane & 4) != 0; const float keep = up ? b2[1] : b2[0], send = up ? b2[0] : b2[1]; b1 = keep + __shfl_xor(send, 4); }
    b1 += __shfl_xor(b1, 2); b1 += __shfl_xor(b1, 1);
    return b1;
}
__device__ __forceinline__ float4 ld_bf4(const bf16_t* q) { const u32x2 w = *(const u32x2*)q; return make_float4(bflo(w.x), bfhi(w.x), bflo(w.y), bfhi(w.y)); }
__device__ __forceinline__ void st_bf4(bf16_t* q, float4 v) { u32x2 w; w.x = pk2(v.x, v.y); w.y = pk2(v.z, v.w); *(u32x2*)q = w; }
#define DPP_F(x, ctrl, rmask, oldv) __builtin_bit_cast(float, __builtin_amdgcn_update_dpp(__builtin_bit_cast(int, (float)(oldv)), __builtin_bit_cast(int, (x)), (ctrl), (rmask), 0xf, false))
__device__ __forceinline__ float wave_sum(float v) {
    v += DPP_F(v, 0x111, 0xf, 0.f); v += DPP_F(v, 0x112, 0xf, 0.f); v += DPP_F(v, 0x114, 0xf, 0.f); v += DPP_F(v, 0x118, 0xf, 0.f);
    v += DPP_F(v, 0x142, 0xa, 0.f);
    v += DPP_F(v, 0x143, 0xc, 0.f);
    return __builtin_bit_cast(float, __builtin_amdgcn_readlane(__builtin_bit_cast(int, v), 63));
}
__device__ __forceinline__ float wave_prefix_sum(float v) {
    v += DPP_F(v, 0x111, 0xf, 0.f); v += DPP_F(v, 0x112, 0xf, 0.f); v += DPP_F(v, 0x114, 0xf, 0.f); v += DPP_F(v, 0x118, 0xf, 0.f);
    v += DPP_F(v, 0x142, 0xa, 0.f);
    v += DPP_F(v, 0x143, 0xc, 0.f);
    return v;
}
__device__ __forceinline__ float wave_prefix_max(float v) {
    const float ninf = -3.0e38f;
    v = fmaxf(v, DPP_F(v, 0x111, 0xf, ninf)); v = fmaxf(v, DPP_F(v, 0x112, 0xf, ninf)); v = fmaxf(v, DPP_F(v, 0x114, 0xf, ninf)); v = fmaxf(v, DPP_F(v, 0x118, 0xf, ninf));
    v = fmaxf(v, DPP_F(v, 0x142, 0xa, ninf));
    v = fmaxf(v, DPP_F(v, 0x143, 0xc, ninf));
    return v;
}
__device__ __forceinline__ float lane_bcast(float v, int l) { return __builtin_bit_cast(float, __builtin_amdgcn_readlane(__builtin_bit_cast(int, v), l)); }
__device__ __forceinline__ float wave_max(float v) {
    const float ninf = -3.0e38f;
    v = fmaxf(v, DPP_F(v, 0x111, 0xf, ninf)); v = fmaxf(v, DPP_F(v, 0x112, 0xf, ninf)); v = fmaxf(v, DPP_F(v, 0x114, 0xf, ninf)); v = fmaxf(v, DPP_F(v, 0x118, 0xf, ninf));
    v = fmaxf(v, DPP_F(v, 0x142, 0xa, ninf));
    v = fmaxf(v, DPP_F(v, 0x143, 0xc, ninf));
    return __builtin_bit_cast(float, __builtin_amdgcn_readlane(__builtin_bit_cast(int, v), 63));
}

#define RT_LO 32768
#define RT_G 65536
typedef __attribute__((ext_vector_type(2))) __bf16 bf16x2_t;
__device__ __forceinline__ float dot2_self(unsigned w, float acc) {
    return __builtin_amdgcn_fdot2_f32_bf16(__builtin_bit_cast(bf16x2_t, w), __builtin_bit_cast(bf16x2_t, w), acc, false);
}
__device__ __forceinline__ void phase_router(const P& p, int layer, unsigned char* lds, int bid, int nb) {
    const int tid = opaque_tid(), lane = tid & 63, wid = tid >> 6, r = lane & 15, q = lane >> 4;
    const float* g = p.ffn_g + layer * D_;
    const float* wr = p.router_w + (size_t)layer * D_ * 16;
    constexpr int NT = T_ / 16;
#if PROBE_ROUTER
    for (int rep = 0; rep < 2; ++rep) {
#endif
    int tile = bid + nb * wid;
    u32x4 hv[32];
    auto load_tile = [&](int tl) {
        const bf16_t* hp = p.h() + (size_t)(tl * 16 + r) * D_ + 8 * q;
#pragma unroll
        for (int s = 0; s < 32; ++s) hv[s] = *(const u32x4*)(hp + 32 * s);
    };
    if (tile < NT) load_tile(tile);
    __syncthreads();
#pragma unroll 4
    for (int it = 0; it < 8; ++it) {
        const int s = (tid >> 6) + 4 * it, lq = lane >> 4, e = lane & 15, k0 = 32 * s + 8 * lq;
        const float4 g0 = *(const float4*)(g + k0), g1 = *(const float4*)(g + k0 + 4);
        const float gv[8] = {g0.x, g0.y, g0.z, g0.w, g1.x, g1.y, g1.z, g1.w};
        unsigned hi[4], lo[4];
#pragma unroll
        for (int jp = 0; jp < 4; ++jp) {
            const float w0 = gv[2 * jp] * wr[(size_t)(k0 + 2 * jp) * 16 + e], w1 = gv[2 * jp + 1] * wr[(size_t)(k0 + 2 * jp + 1) * 16 + e];
            const unsigned hw = pk2(w0, w1);
            hi[jp] = hw; lo[jp] = pk2(w0 - bflo(hw), w1 - bfhi(hw));
        }
        *(u32x4*)(lds + (s * 64 + lane) * 16) = (u32x4){hi[0], hi[1], hi[2], hi[3]};
        *(u32x4*)(lds + RT_LO + (s * 64 + lane) * 16) = (u32x4){lo[0], lo[1], lo[2], lo[3]};
    }
    for (int i = tid; i < 256; i += NTHR) *(float4*)(lds + RT_G + i * 16) = *(const float4*)(g + 4 * i);
    __syncthreads();
#pragma unroll 1
    while (tile < NT) {
        const int token = tile * 16 + r;
        float ss0 = 0.f, ss1 = 0.f;
#pragma unroll
        for (int s = 0; s < 32; ++s) {
            const u32x4 w = hv[s];
            ss0 = dot2_self(w.x, ss0); ss1 = dot2_self(w.y, ss1); ss0 = dot2_self(w.z, ss0); ss1 = dot2_self(w.w, ss1);
        }
        float ss = ss0 + ss1;
        ss = rows_sum(ss);
        const float rinv = frsq(ss * (1.f / D_) + 1e-6f);
        f32x4 a0 = (f32x4){0.f, 0.f, 0.f, 0.f}, a1 = a0, a2 = a0, a3 = a0;
        bf16_t* up = p.u() + (size_t)token * D_ + 8 * q;
#pragma unroll
        for (int s = 0; s < 32; s += 2) {
            const bf16x8 wh0 = *(const bf16x8*)(lds + (s * 64 + lane) * 16), wl0 = *(const bf16x8*)(lds + RT_LO + (s * 64 + lane) * 16);
            const bf16x8 wh1 = *(const bf16x8*)(lds + ((s + 1) * 64 + lane) * 16), wl1 = *(const bf16x8*)(lds + RT_LO + ((s + 1) * 64 + lane) * 16);
            a0 = __builtin_amdgcn_mfma_f32_16x16x32_bf16(wh0, __builtin_bit_cast(bf16x8, hv[s]), a0, 0, 0, 0);
            a1 = __builtin_amdgcn_mfma_f32_16x16x32_bf16(wl0, __builtin_bit_cast(bf16x8, hv[s]), a1, 0, 0, 0);
            a2 = __builtin_amdgcn_mfma_f32_16x16x32_bf16(wh1, __builtin_bit_cast(bf16x8, hv[s + 1]), a2, 0, 0, 0);
            a3 = __builtin_amdgcn_mfma_f32_16x16x32_bf16(wl1, __builtin_bit_cast(bf16x8, hv[s + 1]), a3, 0, 0, 0);
#pragma unroll
            for (int s2 = s; s2 < s + 2; ++s2) {
                const float4 g0 = *(const float4*)(lds + RT_G + (32 * s2 + 8 * q) * 4), g1 = *(const float4*)(lds + RT_G + (32 * s2 + 8 * q + 4) * 4);
                const u32x4 w = hv[s2];
                u32x4 o;
                o.x = pk2(bflo(w.x) * rinv * g0.x, bfhi(w.x) * rinv * g0.y); o.y = pk2(bflo(w.y) * rinv * g0.z, bfhi(w.y) * rinv * g0.w);
                o.z = pk2(bflo(w.z) * rinv * g1.x, bfhi(w.z) * rinv * g1.y); o.w = pk2(bflo(w.w) * rinv * g1.z, bfhi(w.w) * rinv * g1.w);
                *(u32x4*)(up + 32 * s2) = o;
            }
            __builtin_amdgcn_sched_barrier(0);
        }
        {
            const f32x4 lg = ((a0 + a1) + (a2 + a3)) * rinv;
            float m = fmaxf(fmaxf(lg[0], lg[1]), fmaxf(lg[2], lg[3]));
            m = rows_max(m);
            const float e0 = __expf(lg[0] - m), e1 = __expf(lg[1] - m), e2 = __expf(lg[2] - m), e3 = __expf(lg[3] - m);
            float sm = (e0 + e1) + (e2 + e3);
            sm = rows_sum(sm);
            const float ri = frcp(sm);
            const int b = token / L_, t = token - b * L_;
            float* ap = p.aff() + (size_t)(b * 16 + 4 * q) * L_ + t;
            ap[0] = e0 * ri; ap[L_] = e1 * ri; ap[2 * L_] = e2 * ri; ap[3 * L_] = e3 * ri;
        }
        tile += nb * 4;
        if (tile < NT) load_tile(tile);
    }
#if PROBE_ROUTER
    }
#endif
}

__device__ __forceinline__ void phase_topk(const P& p, unsigned char* lds, int bid, int nb) {
    const int tid = opaque_tid(), lane = tid & 63, wid = tid >> 6;
    unsigned* wc = (unsigned*)lds;
#if PROBE_TOPK
    for (int rep = 0; rep < 4; ++rep)
#endif
    for (int g = bid; g < NG; g += nb) {
        const int b = g >> 4, e = g & 15;
        const float* ap = p.aff() + (size_t)g * L_;
        unsigned key[9];
#pragma unroll
        for (int m = 0; m < 9; ++m) { const int i = tid + 256 * m; key[m] = (i < L_) ? __builtin_bit_cast(unsigned, ap[i]) : 0u; }
        unsigned T = 0u;
        for (int bit = 31; bit >= 0; --bit) {
            const unsigned cand = T | (1u << bit);
            unsigned c = 0;
#pragma unroll
            for (int m = 0; m < 9; ++m) c += (unsigned)__popcll(__ballot(key[m] >= cand));
            unsigned* w = wc + (bit & 1) * 4;
            if (lane == 0) w[wid] = c;
            __syncthreads();
            const unsigned tot = w[0] + w[1] + w[2] + w[3];
            if (tot >= CAP) T = cand;
        }
        __syncthreads();
        unsigned cg = 0;
#pragma unroll
        for (int m = 0; m < 9; ++m) cg += (unsigned)__popcll(__ballot(key[m] > T));
        if (lane == 0) wc[wid] = cg;
        __syncthreads();
        const unsigned n_gt = wc[0] + wc[1] + wc[2] + wc[3];
        const unsigned need = CAP - n_gt;
        __syncthreads();
        unsigned base_sel = 0, base_tie = 0;
#pragma unroll
        for (int m = 0; m < 9; ++m) {
            const int i = tid + 256 * m;
            const bool gt = key[m] > T, tie = (key[m] == T) && (i < L_);
            const unsigned long long bt = __ballot(tie);
            const unsigned long long lower = (1ull << lane) - 1ull;
            if (lane == 0) { wc[8 + wid] = (unsigned)__popcll(bt); }
            __syncthreads();
            unsigned tie_before = base_tie + (unsigned)__popcll(bt & lower);
            for (int w2 = 0; w2 < wid; ++w2) tie_before += wc[8 + w2];
            const unsigned tie_row = wc[8] + wc[9] + wc[10] + wc[11];
            const bool take = gt || (tie && tie_before < need);
            const unsigned long long bs = __ballot(take);
            if (lane == 0) { wc[12 + wid] = (unsigned)__popcll(bs); }
            __syncthreads();
            unsigned slot = base_sel + (unsigned)__popcll(bs & lower);
            for (int w2 = 0; w2 < wid; ++w2) slot += wc[12 + w2];
            const unsigned sel_row = wc[12] + wc[13] + wc[14] + wc[15];
            if (i < L_) {
                if (take) { const int sl = (e * B_ + b) * CAP + (int)slot; p.idx()[sl] = b * L_ + i; p.gate()[sl] = __builtin_bit_cast(float, key[m]); }
                p.sel()[((size_t)b * L_ + i) * 16 + e] = take ? (int)slot : -1;
            }
            base_sel += sel_row; base_tie += tie_row;
            __syncthreads();
        }
    }
}

template <int MT>
__device__ __forceinline__ void gateup_addr(const P& p, int layer, int e, int srow0, int nt, int tid, TileAddr& t) {
    const int lrow = tid >> 3;
#pragma unroll
    for (int i = 0; i < MT; ++i) { int srow = srow0 + lrow + 32 * i; if (srow > ESLOTS - 1) srow = ESLOTS - 1; t.ao[i] = (unsigned)p.idx()[e * ESLOTS + srow] * 2048u + gemm_chunk_off(tid); }
    t.ab = (const char*)p.u();
    t.bb = (const char*)(p.Wgu() + (size_t)(layer * 16 + e) * 2048 * 1024); t.bo = (unsigned)(nt * 128 + lrow) * 2048u + gemm_chunk_off(tid);
}
template <int MT>
__device__ __forceinline__ void gateup_unit(const P& p, int layer, unsigned char* lds, int e, int srow0, int nt, int tid, Prefetch& pf, bool has_next = false, int e2 = 0, int srow2 = 0, int nt2 = 0) {
    const int lane = tid & 63, wid = tid >> 6, wr = wid >> 1, wc = wid & 1, fr = lane & 15, fq = lane >> 4;
    TileAddr t; const bool pre = pf.have;
    if (pre) t = pf.t; else gateup_addr<MT>(p, layer, e, srow0, nt, tid, t);
    if (has_next) gateup_addr<MT>(p, layer, e2, srow2, nt2, tid, pf.t);
    pf.have = has_next;
    f32x4 acc[MT][4];
    gemm_tile<false, MT>(t, lds, acc, tid, pre, has_next ? &pf.t : nullptr);
#pragma unroll
    for (int m = 0; m < MT; ++m) {
        const int srow = srow0 + wr * 16 * MT + m * 16 + fr;
        if (srow < ESLOTS) {
            float o[8];
#pragma unroll
            for (int n = 0; n < 2; ++n) {
                const f32x4 gv = acc[m][n], uv = acc[m][n + 2];
#pragma unroll
                for (int j = 0; j < 4; ++j) o[4 * n + j] = gv[j] * frcp(1.f + __expf(-gv[j])) * uv[j];
            }
            u32x4 pk; pk.x = pk2(o[0], o[1]); pk.y = pk2(o[2], o[3]); pk.z = pk2(o[4], o[5]); pk.w = pk2(o[6], o[7]);
            *(u32x4*)(p.hdn() + ((size_t)e * ESLOTS + srow) * D_ + nt * 64 + wc * 32 + fq * 8) = pk;
        }
    }
}
__device__ __forceinline__ void phase_gateup(const P& p, int layer, unsigned char* lds, int bid, int nb) {
    const int tid = opaque_tid();
    const int x = bid & 7, l = bid >> 3, nbx = nb >> 3;
#if PROBE_GEMM
    for (int rep = 0; rep < 2; ++rep)
#endif
    {
        Prefetch pf; pf.have = false;
        for (int s = l; s < 320; s += nbx) {
            const int e = 2 * x + s / 160, s2 = s % 160, mt = s2 >> 4, nt = s2 & 15;
            const int sn = s + nbx, en = 2 * x + sn / 160, sn2 = sn % 160;
            gateup_unit<6>(p, layer, lds, e, mt * 192, nt, tid, pf, sn < 320, en, (sn2 >> 4) * 192, sn2 & 15);
        }
    }
    for (int s = l; s < 64; s += nbx) {
        const int u = s & 31, e = 2 * x + (u >> 4), nt = u & 15;
        Prefetch pf; pf.have = false;
        if (s < 32) gateup_unit<4>(p, layer, lds, e, 1920, nt, tid, pf); else gateup_unit<1>(p, layer, lds, e, 2048, nt, tid, pf);
    }
}

template <int MT>
__device__ __forceinline__ void down_addr(const P& p, int layer, int e, int srow0, int nt, int tid, TileAddr& t) {
    const int lrow = tid >> 3;
#pragma unroll
    for (int i = 0; i < MT; ++i) { int srow = srow0 + lrow + 32 * i; if (srow > ESLOTS - 1) srow = ESLOTS - 1; t.ao[i] = (unsigned)srow * 2048u + gemm_chunk_off(tid); }
    t.ab = (const char*)(p.hdn() + (size_t)e * ESLOTS * D_);
    t.bb = (const char*)(p.Wd() + (size_t)(layer * 16 + e) * 1024 * 1024); t.bo = (unsigned)(nt * 128 + lrow) * 2048u + gemm_chunk_off(tid);
}
template <int MT>
__device__ __forceinline__ void down_unit(const P& p, int layer, unsigned char* lds, int e, int srow0, int nt, int tid, Prefetch& pf, bool has_next = false, int e2 = 0, int srow2 = 0, int nt2 = 0) {
    const int lane = tid & 63, wid = tid >> 6, wr = wid >> 1, wc = wid & 1, fr = lane & 15, fq = lane >> 4;
    TileAddr t; const bool pre = pf.have;
    if (pre) t = pf.t; else down_addr<MT>(p, layer, e, srow0, nt, tid, t);
    if (has_next) down_addr<MT>(p, layer, e2, srow2, nt2, tid, pf.t);
    pf.have = has_next;
    float gt0, gt1;
    if (pre) { gt0 = pf.r0; gt1 = pf.r1; } else rv_load<MT>(p.gate(), e * ESLOTS + srow0 + wr * 16 * MT, e * ESLOTS + ESLOTS - 1, fr, fq, gt0, gt1);
    f32x4 acc[MT][4];
    gemm_tile<false, MT>(t, lds, acc, tid, pre, has_next ? &pf.t : nullptr);
    RV_PIN(gt0, gt1);
    if (has_next) rv_load<MT>(p.gate(), e2 * ESLOTS + srow2 + wr * 16 * MT, e2 * ESLOTS + ESLOTS - 1, fr, fq, pf.r0, pf.r1);
#pragma unroll
    for (int m = 0; m < MT; ++m) {
        const int srow = srow0 + wr * 16 * MT + m * 16 + fr;
        const float gt = rv_get(gt0, gt1, m, fr);
        if (srow < ESLOTS) {
#pragma unroll
            for (int pr = 0; pr < 2; ++pr) {
                const f32x4 v0 = acc[m][2 * pr], v1 = acc[m][2 * pr + 1];
                u32x4 pk; pk.x = pk2(v0[0] * gt, v0[1] * gt); pk.y = pk2(v0[2] * gt, v0[3] * gt); pk.z = pk2(v1[0] * gt, v1[1] * gt); pk.w = pk2(v1[2] * gt, v1[3] * gt);
                *(u32x4*)(p.ys() + ((size_t)e * ESLOTS + srow) * D_ + nt * 128 + wc * 64 + pr * 32 + fq * 8) = pk;
            }
        }
        if (MT > 4) __builtin_amdgcn_sched_barrier(0);
    }
    if (has_next) RV_DONE(pf.r0, pf.r1);
}
__device__ __forceinline__ void phase_down(const P& p, int layer, unsigned char* lds, int bid, int nb) {
    const int tid = opaque_tid();
    const int x = bid & 7, l = bid >> 3, nbx = nb >> 3;
#if PROBE_GEMM
    for (int rep = 0; rep < 2; ++rep)
#endif
    Prefetch pf; pf.have = false;
    for (int s = l; s < 160 + 32; s += nbx) {
        if (s < 160) {
            const int e = 2 * x + s / 80, s2 = s % 80, mt = s2 >> 3, nt = s2 & 7;
            const int sn = s + nbx, en = 2 * x + sn / 80, sn2 = sn % 80;
            down_unit<6>(p, layer, lds, e, mt * 192, nt, tid, pf, sn < 160, en, (sn2 >> 3) * 192, sn2 & 7);
        } else {
            const int u = (s - 160) & 15, e = 2 * x + (u >> 3), nt = u & 7;
            if (s < 176) down_unit<4>(p, layer, lds, e, 1920, nt, tid, pf); else down_unit<1>(p, layer, lds, e, 2048, nt, tid, pf);
        }
    }
}


template <int MT>
__device__ __forceinline__ void odd_in_unit(const P& p, int j, const bf16_t* W, unsigned char* lds, int row0, int nt, int tid, Prefetch& pf, bool has_next = false, int row2 = 0, int nt2 = 0) {
    const int lane = tid & 63, wid = tid >> 6, wr = wid >> 1, wc = wid & 1, fr = lane & 15, fq = lane >> 4;
    TileAddr t; const bool pre = pf.have;
    if (pre) t = pf.t; else tile_addr_rows<MT>(t, p.u(), row0, W, nt, tid);
    if (has_next) tile_addr_rows<MT>(pf.t, p.u(), row2, W, nt2, tid);
    pf.have = has_next;
    const TileAddr* nx = has_next ? &pf.t : nullptr;
    f32x4 acc[MT][4];
    if (nt < 16) {
        gemm_tile<false, MT>(t, lds, acc, tid, pre, nx);
        const bool isq = nt < 8;
        const float* g = isq ? (p.o_qg + j * 64) : (p.o_kg + j * 64);
        const float sc = isq ? 0.125f * 1.4426950408889634f : 1.f;
        f32x4 gv[4];
#pragma unroll
        for (int n = 0; n < 4; ++n) gv[n] = *(const f32x4*)(g + 32 * (n >> 1) + 8 * fq + 4 * (n & 1));
#pragma unroll
        for (int m = 0; m < MT; ++m) {
            float ss = 0.f;
#pragma unroll
            for (int n = 0; n < 4; ++n) { const f32x4 v = acc[m][n]; ss += v[0] * v[0] + v[1] * v[1] + v[2] * v[2] + v[3] * v[3]; }
            ss = rows_sum(ss);
            const float rinv = frsq(ss * (1.f / 64.f) + 1e-6f) * sc;
            const int row = row0 + wr * 16 * MT + m * 16 + fr;
            bf16_t* dst;
            if (isq) dst = p.zo() + (size_t)row * 1024 + nt * 128 + wc * 64 + fq * 8;
            else { const int b = row / L_, tk = row - b * L_; dst = p.kh() + ((size_t)(b * 16 + (nt - 8) * 2 + wc) * L_ + tk) * 64 + fq * 8; }
#pragma unroll
            for (int pr = 0; pr < 2; ++pr) {
                const f32x4 v0 = acc[m][2 * pr], v1 = acc[m][2 * pr + 1], g0 = gv[2 * pr], g1 = gv[2 * pr + 1];
                u32x4 pk; pk.x = pk2(v0[0] * rinv * g0[0], v0[1] * rinv * g0[1]); pk.y = pk2(v0[2] * rinv * g0[2], v0[3] * rinv * g0[3]);
                pk.z = pk2(v1[0] * rinv * g1[0], v1[1] * rinv * g1[1]); pk.w = pk2(v1[2] * rinv * g1[2], v1[3] * rinv * g1[3]);
                *(u32x4*)(dst + pr * 32) = pk;
            }
        }
    } else {
        gemm_tile<true, MT>(t, lds, acc, tid, pre, nx);
        const int head = (nt - 16) * 2 + wc;
#pragma unroll
        for (int m = 0; m < MT; ++m) {
            const int row = row0 + wr * 16 * MT + m * 16 + fq * 4;
            const int b = row / L_, tk = row - b * L_;
#pragma unroll
            for (int n = 0; n < 4; ++n) {
                const int d = n * 16 + fr;
                const f32x4 v = acc[m][n];
                u32x2 pk; pk.x = pk2(v[0], v[1]); pk.y = pk2(v[2], v[3]);
                *(u32x2*)(p.vT() + ((size_t)(b * 16 + head) * 64 + d) * L_ + tk) = pk;
            }
        }
    }
}
__device__ __forceinline__ void phase_odd_in(const P& p, int layer, unsigned char* lds, int bid, int nb) {
    const int tid = opaque_tid();
    const int x = bid & 7, l = bid >> 3, nbx = nb >> 3;
    const int j = layer >> 1;
    const bf16_t* W = p.WinO() + (size_t)j * 3072 * 1024;
    const int nt0 = 6 * (x >> 1), par = x & 1;
#if PROBE_GEMM
    for (int rep = 0; rep < 2; ++rep)
#endif
    { Prefetch pf; pf.have = false;
      for (int s = l; s < 246; s += nbx) { const int sn = s + nbx; odd_in_unit<6>(p, j, W, lds, (2 * (s / 6) + par) * 192, nt0 + (s % 6), tid, pf, sn < 246, (2 * (sn / 6) + par) * 192, nt0 + (sn % 6)); } }
    Prefetch pf0; pf0.have = false;
    if (nbx == 64) { for (int s = l - 54; s >= 0 && s < 18; s += 10) odd_in_unit<4>(p, j, W, lds, 15744 + (2 * (s / 6) + par) * 128, nt0 + (s % 6), tid, pf0); }
    else           { for (int s = l; s < 18; s += nbx) odd_in_unit<4>(p, j, W, lds, 15744 + (2 * (s / 6) + par) * 128, nt0 + (s % 6), tid, pf0); }
}

#define NA_VSTRIDE 1200
#define NA_RPB 76800
__device__ __forceinline__ void na_dma16(unsigned voff, const char* sbase, unsigned ldsaddr) {
    unsigned keep;
    asm volatile("s_nop 4\n\ts_mov_b32 %0, m0\n\ts_mov_b32 m0, %2\n\ts_nop 0\n\tglobal_load_lds_dwordx4 %1, %3\n\ts_mov_b32 m0, %0"
                 : "=&s"(keep) : "v"(voff), "s"(ldsaddr), "s"(sbase) : "memory");
}
__device__ __forceinline__ const char* na_uni(const void* q) {
    const unsigned long long v = (unsigned long long)q;
    const unsigned lo = (unsigned)__builtin_amdgcn_readfirstlane((int)(unsigned)v), hi = (unsigned)__builtin_amdgcn_readfirstlane((int)(unsigned)(v >> 32));
    return (const char*)(((unsigned long long)hi << 32) | lo);
}
__device__ __forceinline__ int na_key(int row) { return ((row >> 1) & 1) | ((row >> 2) & 6); }
__device__ __forceinline__ void phase_natten(const P& p, int layer, unsigned char* lds, int bid, int nb) {
    const int tid = opaque_tid(), lane = tid & 63, wid = tid >> 6, fr = lane & 15, fq = lane >> 4;
    const int h = bid & 15, jb = bid >> 4, njb = nb >> 4;
    const float* rpbh = p.o_rpb + ((size_t)(layer >> 1) * 16 + h) * 15 * 31;
    float* rtab = (float*)(lds + NA_RPB);
    __syncthreads();
    for (int i = tid; i < 15 * 31; i += NTHR) rtab[i] = rpbh[i] * 1.4426950408889634f;
    const int w = __builtin_amdgcn_readfirstlane(wid);
    const int kc0 = (w == 0) ? 0 : (w == 1) ? 8 : (w == 2) ? 24 : 32;
    const int c = 16 * w + fr;
    const int cs = min(max(c - 8, 0), 48);
    bool vld[8];
#pragma unroll
    for (int pj = 0; pj < 8; ++pj) { const int kc = kc0 + 8 * fq + pj; vld[pj] = (kc >= cs) && (kc < cs + 16); }
    const int lanepart = kc0 + 8 * fq - c + 15;
    const unsigned lbase = (unsigned)(size_t)lds;
    const char* zob = na_uni(p.kh()); const char* vtb = na_uni(p.vT());
    for (int it = jb; it < B_ * 16; it += njb) {
        const int b = it >> 4, r0 = 2 * (it & 15);
        const int rsA = min(max(r0 - 4, 0), 24), rsB = min(max(r0 - 3, 0), 24), off = rsB - rsA;
        const size_t tokb = (size_t)b * L_;
        __syncthreads();
        for (int q = w; q < 74; q += 4) {
            if (q >= 64 && q < 72 && off == 0) continue;
            const int row = 8 * q + (lane >> 3), pc = lane & 7;
            const int tok = row < 576 ? NM + rsA * 64 + row : row - 576;
            const unsigned voff = (unsigned)((b * 16 + h) * L_ + tok) * 128u + (unsigned)((pc ^ na_key(row)) << 4);
            na_dma16(voff, zob, lbase + q * 1024);
        }
        const bf16_t* qp = p.zo() + (tokb + NM + r0 * 64 + c) * 1024 + h * 64 + fq * 8;
        bf16x8 qA0 = *(const bf16x8*)qp, qA1 = *(const bf16x8*)(qp + 32), qB0 = *(const bf16x8*)(qp + 65536), qB1 = *(const bf16x8*)(qp + 65536 + 32);
        f32x4 S[17];
        auto s_init = [&](int dr0) {
            const float* rb = rtab + dr0 * 31 + lanepart;
#pragma unroll
            for (int n = 0; n < 16; ++n)
#pragma unroll
                for (int jj = 0; jj < 4; ++jj) S[n][jj] = rb[(n >> 1) * 31 + 4 * (n & 1) + jj];
#pragma unroll
            for (int n = 0; n < 16; ++n) asm("" : "+v"(S[n]));
#pragma unroll
            for (int n = 0; n < 16; ++n)
#pragma unroll
                for (int jj = 0; jj < 4; ++jj) S[n][jj] = vld[4 * (n & 1) + jj] ? S[n][jj] : -3.0e38f;
            S[16] = (f32x4){0.f, 0.f, 0.f, 0.f};
        };
        auto qk = [&](const bf16x8& q0, const bf16x8& q1, int boff) {
            const int rowe = kc0 + 8 * (fr >> 2) + (fr & 3), rowo = rowe + 4;
            const unsigned char* be = lds + boff + rowe * 128; const unsigned char* bo = lds + boff + rowo * 128;
            const int ce0 = ((0 + fq) ^ na_key(rowe)) << 4, ce1 = ((4 + fq) ^ na_key(rowe)) << 4, co0 = ((0 + fq) ^ na_key(rowo)) << 4, co1 = ((4 + fq) ^ na_key(rowo)) << 4;
            const unsigned char* pe0 = be + ce0; const unsigned char* pe1 = be + ce1; const unsigned char* po0 = bo + co0; const unsigned char* po1 = bo + co1;
#pragma unroll
            for (int n = 0; n < 16; ++n) {
                const bf16x8 k0 = *(const bf16x8*)(((n & 1) ? po0 : pe0) + (n >> 1) * 8192), k1 = *(const bf16x8*)(((n & 1) ? po1 : pe1) + (n >> 1) * 8192);
                S[n] = __builtin_amdgcn_mfma_f32_16x16x32_bf16(k0, q0, S[n], 0, 0, 0);
                S[n] = __builtin_amdgcn_mfma_f32_16x16x32_bf16(k1, q1, S[n], 0, 0, 0);
            }
            {
                const int row = 576 + fr, ky = na_key(row);
                const bf16x8 k0 = *(const bf16x8*)(lds + row * 128 + (((0 + fq) ^ ky) << 4)), k1 = *(const bf16x8*)(lds + row * 128 + (((4 + fq) ^ ky) << 4));
                S[16] = __builtin_amdgcn_mfma_f32_16x16x32_bf16(k0, q0, S[16], 0, 0, 0);
                S[16] = __builtin_amdgcn_mfma_f32_16x16x32_bf16(k1, q1, S[16], 0, 0, 0);
            }
        };
        auto softmax_pack = [&](u32x4 (&Pk)[8], u32x2& Pm) -> float {
            float mx = -3.0e38f;
#pragma unroll
            for (int n = 0; n < 17; ++n) mx = fmax3_raw(fmax3_raw(mx, S[n][0], S[n][1]), S[n][2], S[n][3]);
            mx = rows_max(mx);
            float sum = 0.f;
#pragma unroll
            for (int n = 0; n < 17; ++n)
#pragma unroll
                for (int jj = 0; jj < 4; ++jj) { const float e = __builtin_amdgcn_exp2f(S[n][jj] - mx); S[n][jj] = e; sum += e; }
#pragma unroll
            for (int t = 0; t < 8; ++t) {
                Pk[t].x = pk2(S[2 * t][0], S[2 * t][1]); Pk[t].y = pk2(S[2 * t][2], S[2 * t][3]); Pk[t].z = pk2(S[2 * t + 1][0], S[2 * t + 1][1]); Pk[t].w = pk2(S[2 * t + 1][2], S[2 * t + 1][3]);
            }
            Pm.x = pk2(S[16][0], S[16][1]); Pm.y = pk2(S[16][2], S[16][3]);
            sum = rows_sum(sum);
            return frcp(sum);
        };
        s_init(rsA - r0 + 7);
        asm volatile("s_waitcnt vmcnt(0)" : "+v"(qA0), "+v"(qA1), "+v"(qB0), "+v"(qB1) :: "memory");
        __syncthreads();
        u32x4 PA[8], PB[8]; u32x2 PAm, PBm;
        __builtin_amdgcn_sched_barrier(0);
        qk(qA0, qA1, 0);
        __builtin_amdgcn_sched_barrier(0);
        const float rinvA = softmax_pack(PA, PAm);
        __builtin_amdgcn_sched_barrier(0);
        s_init(rsB - r0 + 6);
        __builtin_amdgcn_sched_barrier(0);
        qk(qB0, qB1, off * 64 * 128);
        __builtin_amdgcn_sched_barrier(0);
        __syncthreads();
        const bf16_t* vrow = p.vT() + (size_t)(b * 16 + h) * 64 * L_;
        u32x4 vmeta = (u32x4){0u, 0u, 0u, 0u}, v9a = vmeta, v9b = vmeta;
        if (tid < 128) vmeta = *(const u32x4*)(vrow + (size_t)(tid >> 1) * L_ + (tid & 1) * 8);
        if (off) { const bf16_t* s9 = vrow + (size_t)(tid >> 2) * L_ + NM + (rsA + 8) * 64 + (tid & 3) * 16; v9a = *(const u32x4*)s9; v9b = *(const u32x4*)(s9 + 8); }
        for (int d = w; d < 64; d += 4) {
            const unsigned voff = (unsigned)((b * 16 + h) * 64 + d) * 4128u + (unsigned)((NM + rsA * 64) * 2 + lane * 16);
            na_dma16(voff, vtb, lbase + d * NA_VSTRIDE);
        }
        __builtin_amdgcn_sched_barrier(0);
        const float rinvB = softmax_pack(PB, PBm);
        __builtin_amdgcn_sched_barrier(0);
        if (tid < 128) *(u32x4*)(lds + (tid >> 1) * NA_VSTRIDE + 1152 + (tid & 1) * 16) = vmeta;
        if (off) { unsigned char* d9 = lds + (tid >> 2) * NA_VSTRIDE + 1024 + (tid & 3) * 32; *(u32x4*)d9 = v9a; *(u32x4*)(d9 + 16) = v9b; }
        asm volatile("s_waitcnt vmcnt(0)" ::: "memory");
        __syncthreads();
        f32x4 OA[4], OB[4];
#pragma unroll
        for (int nd = 0; nd < 4; ++nd) { OA[nd] = (f32x4){0.f, 0.f, 0.f, 0.f}; OB[nd] = OA[nd]; }
        const unsigned char* vbA = lds + fr * NA_VSTRIDE + (kc0 + 8 * fq) * 2;
        const unsigned char* vbB = vbA + off * 128;
#pragma unroll
        for (int t = 0; t < 8; ++t) {
            const bf16x8 pfa = __builtin_bit_cast(bf16x8, PA[t]), pfb = __builtin_bit_cast(bf16x8, PB[t]);
#pragma unroll
            for (int nd = 0; nd < 4; ++nd) {
                const bf16x8 va = *(const bf16x8*)(vbA + nd * 16 * NA_VSTRIDE + t * 128), vb = *(const bf16x8*)(vbB + nd * 16 * NA_VSTRIDE + t * 128);
                OA[nd] = __builtin_amdgcn_mfma_f32_16x16x32_bf16(va, pfa, OA[nd], 0, 0, 0);
                OB[nd] = __builtin_amdgcn_mfma_f32_16x16x32_bf16(vb, pfb, OB[nd], 0, 0, 0);
            }
        }
        {
            u32x4 pa, pb; pa.x = PAm.x; pa.y = PAm.y; pa.z = 0u; pa.w = 0u; pb.x = PBm.x; pb.y = PBm.y; pb.z = 0u; pb.w = 0u;
            const bf16x8 pfa = __builtin_bit_cast(bf16x8, pa), pfb = __builtin_bit_cast(bf16x8, pb);
#pragma unroll
            for (int nd = 0; nd < 4; ++nd) {
                const u32x2 v2 = *(const u32x2*)(lds + (16 * nd + fr) * NA_VSTRIDE + 1152 + 8 * fq);
                u32x4 vw; vw.x = v2.x; vw.y = v2.y; vw.z = 0u; vw.w = 0u;
                OA[nd] = __builtin_amdgcn_mfma_f32_16x16x32_bf16(__builtin_bit_cast(bf16x8, vw), pfa, OA[nd], 0, 0, 0);
                OB[nd] = __builtin_amdgcn_mfma_f32_16x16x32_bf16(__builtin_bit_cast(bf16x8, vw), pfb, OB[nd], 0, 0, 0);
            }
        }
        bf16_t* op = p.mix() + (tokb + NM + r0 * 64 + c) * D_ + h * 64 + fq * 4;
#pragma unroll
        for (int nd = 0; nd < 4; ++nd) {
            u32x2 pk; pk.x = pk2(OA[nd][0] * rinvA, OA[nd][1] * rinvA); pk.y = pk2(OA[nd][2] * rinvA, OA[nd][3] * rinvA);
            *(u32x2*)(op + nd * 16) = pk;
            pk.x = pk2(OB[nd][0] * rinvB, OB[nd][1] * rinvB); pk.y = pk2(OB[nd][2] * rinvB, OB[nd][3] * rinvB);
            *(u32x2*)(op + 64 * D_ + nd * 16) = pk;
        }
    }
    for (int mi = bid * 4 + wid; mi < B_ * 16; mi += nb * 4) {
        const int hm = mi & 15, b = mi >> 4;
        const size_t tokb = (size_t)b * L_;
        const bf16_t* qp = p.zo() + (tokb + fr) * 1024 + hm * 64 + fq * 8;
        const bf16x8 qf0 = *(const bf16x8*)qp, qf1 = *(const bf16x8*)(qp + 32);
        const bf16_t* kp = p.kh() + ((size_t)(b * 16 + hm) * L_ + fr) * 64 + fq * 8;
        const bf16x8 kf0 = *(const bf16x8*)kp, kf1 = *(const bf16x8*)(kp + 32);
        f32x4 a = (f32x4){0.f, 0.f, 0.f, 0.f};
        a = __builtin_amdgcn_mfma_f32_16x16x32_bf16(kf0, qf0, a, 0, 0, 0);
        a = __builtin_amdgcn_mfma_f32_16x16x32_bf16(kf1, qf1, a, 0, 0, 0);
        float mx = fmaxf(fmaxf(a[0], a[1]), fmaxf(a[2], a[3]));
        mx = fmaxf(mx, __shfl_xor(mx, 16)); mx = fmaxf(mx, __shfl_xor(mx, 32));
        float sum = 0.f;
#pragma unroll
        for (int jj = 0; jj < 4; ++jj) { a[jj] = __builtin_amdgcn_exp2f(a[jj] - mx); sum += a[jj]; }
        sum += __shfl_xor(sum, 16); sum += __shfl_xor(sum, 32);
        const float rinv = frcp(sum);
        u32x4 pw; pw.x = pk2(a[0], a[1]); pw.y = pk2(a[2], a[3]); pw.z = 0u; pw.w = 0u;
        const bf16x8 pf = __builtin_bit_cast(bf16x8, pw);
        const bf16_t* vb = p.vT() + ((size_t)(b * 16 + hm) * 64 + fr) * L_;
        bf16_t* op = p.mix() + (tokb + fr) * D_ + hm * 64 + fq * 4;
#pragma unroll
        for (int nd = 0; nd < 4; ++nd) {
            const u32x2 v2 = *(const u32x2*)(vb + (size_t)nd * 16 * L_ + 4 * fq);
            u32x4 vw; vw.x = v2.x; vw.y = v2.y; vw.z = 0u; vw.w = 0u;
            f32x4 o = (f32x4){0.f, 0.f, 0.f, 0.f};
            o = __builtin_amdgcn_mfma_f32_16x16x32_bf16(__builtin_bit_cast(bf16x8, vw), pf, o, 0, 0, 0);
            u32x2 pk; pk.x = pk2(o[0] * rinv, o[1] * rinv); pk.y = pk2(o[2] * rinv, o[3] * rinv);
            *(u32x2*)(op + nd * 16) = pk;
        }
    }
}

template <int MT>
__device__ __forceinline__ void outproj_unit(const P& p, const bf16_t* W, unsigned char* lds, int row0, int nt, int tid, Prefetch& pf, bool has_next = false, int row2 = 0, int nt2 = 0) {
    const int lane = tid & 63, wid = tid >> 6, wr = wid >> 1, wc = wid & 1, fr = lane & 15, fq = lane >> 4;
    TileAddr t; const bool pre = pf.have;
    if (pre) t = pf.t; else tile_addr_rows<MT>(t, p.mix(), row0, W, nt, tid);
    if (has_next) tile_addr_rows<MT>(pf.t, p.mix(), row2, W, nt2, tid);
    pf.have = has_next;
    f32x4 acc[MT][4];
    gemm_tile<false, MT>(t, lds, acc, tid, pre, has_next ? &pf.t : nullptr);
#pragma unroll
    for (int m = 0; m < MT; ++m) {
        const size_t row = (size_t)row0 + wr * 16 * MT + m * 16 + fr;
#pragma unroll
        for (int pr = 0; pr < 2; ++pr) {
            bf16_t* hp = p.h() + row * D_ + nt * 128 + wc * 64 + pr * 32 + fq * 8;
            const u32x4 hw = *(const u32x4*)hp; const f32x4 a0 = acc[m][2 * pr], a1 = acc[m][2 * pr + 1];
            u32x4 ow;
            ow.x = pk2(bflo(hw.x) + a0[0], bfhi(hw.x) + a0[1]); ow.y = pk2(bflo(hw.y) + a0[2], bfhi(hw.y) + a0[3]);
            ow.z = pk2(bflo(hw.z) + a1[0], bfhi(hw.z) + a1[1]); ow.w = pk2(bflo(hw.w) + a1[2], bfhi(hw.w) + a1[3]);
            *(u32x4*)hp = ow;
        }
        if (MT > 4) __builtin_amdgcn_sched_barrier(0);
    }
}
__device__ __forceinline__ void phase_outproj(const P& p, const bf16_t* W, unsigned char* lds, int bid, int nb) {
    const int tid = opaque_tid();
    const int x = bid & 7, l = bid >> 3, nbx = nb >> 3;
    { Prefetch pf; pf.have = false;
      for (int s = l; s < 64; s += nbx) { const int sn = s + nbx; outproj_unit<6>(p, W, lds, (8 * (s >> 3) + x) * 192, s & 7, tid, pf, sn < 64, (8 * (sn >> 3) + x) * 192, sn & 7); } }
    for (int s = l; s < 40; s += nbx) { const int m4 = 8 * (s >> 3) + x; Prefetch pf; pf.have = false; if (m4 < 33) outproj_unit<4>(p, W, lds, 12288 + m4 * 128, s & 7, tid, pf); }
}

__device__ __forceinline__ void phase_tables(const P& p, int bid, int nb) {
    for (int i = bid * NTHR + opaque_tid(); i < L_ * 64; i += nb * NTHR) {
        const int pos = i >> 6, k = i & 63;
        const float inv = powf(10000.f, -(float)k / 64.f);
        const float ang = (float)pos * inv;
        p.costab()[i] = cosf(ang); p.sintab()[i] = sinf(ang);
    }
}

template <int MT>
__device__ __forceinline__ void even_in_unit(const P& p, const bf16_t* W, unsigned char* lds, int row0, int nt, int tid, Prefetch& pf, bool has_next = false, int row2 = 0, int nt2 = 0) {
    const int lane = tid & 63, wid = tid >> 6, wr = wid >> 1, wc = wid & 1, fr = lane & 15, fq = lane >> 4;
    TileAddr t; const bool pre = pf.have;
    if (pre) t = pf.t; else tile_addr_rows<MT>(t, p.u(), row0, W, nt, tid);
    if (has_next) tile_addr_rows<MT>(pf.t, p.u(), row2, W, nt2, tid);
    pf.have = has_next;
    f32x4 acc[MT][4];
    gemm_tile<false, MT>(t, lds, acc, tid, pre, has_next ? &pf.t : nullptr);
    const int seg = nt >> 2;
    if (seg == 4 || seg == 5) {
        const float sc = (seg == 5) ? 0.08838834764831845f : 1.f;
#pragma unroll
        for (int m = 0; m < MT; ++m) {
            const int row = row0 + wr * 16 * MT + m * 16 + fr;
            const int pos = row % L_;
            const int idx = 32 * wc + 8 * fq;
            u32x4 k1, k2;
#pragma unroll
            for (int pp = 0; pp < 2; ++pp) {
                const f32x4 cv = *(const f32x4*)(p.costab() + pos * 64 + idx + 4 * pp), sv = *(const f32x4*)(p.sintab() + pos * 64 + idx + 4 * pp);
                const f32x4 x1 = acc[m][2 * pp], x2 = acc[m][2 * pp + 1];
                const f32x4 y1 = (x1 * cv - x2 * sv) * sc, y2 = (x2 * cv + x1 * sv) * sc;
                if (pp == 0) { k1.x = pk2(y1[0], y1[1]); k1.y = pk2(y1[2], y1[3]); k2.x = pk2(y2[0], y2[1]); k2.y = pk2(y2[2], y2[3]); }
                else         { k1.z = pk2(y1[0], y1[1]); k1.w = pk2(y1[2], y1[3]); k2.z = pk2(y2[0], y2[1]); k2.w = pk2(y2[2], y2[3]); }
            }
            bf16_t* zp = p.ze() + (size_t)row * 4096 + nt * 128 + idx;
            *(u32x4*)zp = k1; *(u32x4*)(zp + 64) = k2;
            if (MT > 4) __builtin_amdgcn_sched_barrier(0);
        }
    } else {
#pragma unroll
        for (int m = 0; m < MT; ++m) {
            const size_t row = (size_t)row0 + wr * 16 * MT + m * 16 + fr;
#pragma unroll
            for (int pr = 0; pr < 2; ++pr) {
                const f32x4 v0 = acc[m][2 * pr], v1 = acc[m][2 * pr + 1];
                u32x4 pk; pk.x = pk2(v0[0], v0[1]); pk.y = pk2(v0[2], v0[3]); pk.z = pk2(v1[0], v1[1]); pk.w = pk2(v1[2], v1[3]);
                *(u32x4*)(p.ze() + row * 4096 + nt * 128 + wc * 64 + pr * 32 + fq * 8) = pk;
            }
        }
    }
}
__device__ __forceinline__ void phase_even_in(const P& p, int layer, unsigned char* lds, int bid, int nb) {
    const int tid = opaque_tid();
    const int x = bid & 7, l = bid >> 3, nbx = nb >> 3;
    const bf16_t* W = p.WinE() + (size_t)(layer >> 1) * 4096 * 1024;
    const int nt0 = 8 * (x >> 1), par = x & 1;
#if PROBE_GEMM
    for (int rep = 0; rep < 2; ++rep)
#endif
    { Prefetch pf; pf.have = false;
      for (int s = l; s < 320; s += nbx) { const int sn = s + nbx; even_in_unit<6>(p, W, lds, (2 * (s >> 3) + par) * 192, nt0 + (s & 7), tid, pf, sn < 320, (2 * (sn >> 3) + par) * 192, nt0 + (sn & 7)); } }
    for (int s = l; s < 40; s += nbx) { const int m4 = 2 * (s >> 3) + par; Prefetch pf; pf.have = false; if (m4 < 9) even_in_unit<4>(p, W, lds, 15360 + m4 * 128, nt0 + (s & 7), tid, pf); }
}

__device__ __forceinline__ void phase_conv(const P& p, int layer, int bid, int nb) {
    const int tid = opaque_tid(), cg = tid & 127, th = tid >> 7;
    const int c0 = cg * 8;
    const float* w = p.e_conv + (size_t)(layer >> 1) * 5 * 1024 + c0;
    float wv[5][8];
#pragma unroll
    for (int jj = 0; jj < 5; ++jj) { const float4 a = *(const float4*)(w + jj * 1024), b2 = *(const float4*)(w + jj * 1024 + 4);
        wv[jj][0] = a.x; wv[jj][1] = a.y; wv[jj][2] = a.z; wv[jj][3] = a.w; wv[jj][4] = b2.x; wv[jj][5] = b2.y; wv[jj][6] = b2.z; wv[jj][7] = b2.w; }
    const float sc = (c0 >= 512) ? 0.08838834764831845f : 1.f;
    u32x4 rows[12], nrows[12];
    auto request = [&](int it, u32x4 (&rw)[12]) {
        const int tok0 = it * 16 + th * 8;
        const int b = tok0 / L_, t0 = tok0 - b * L_;
#pragma unroll
        for (int r = 0; r < 12; ++r) {
            const int tt = t0 - 2 + r;
            rw[r] = (u32x4){0u, 0u, 0u, 0u};
            if (tt >= 0 && tt < L_) rw[r] = *(const u32x4*)(p.ze() + ((size_t)b * L_ + tt) * 4096 + c0);
        }
    };
    int it = bid;
    if (it < T_ / 16) request(it, nrows);
    for (; it < T_ / 16; it += nb) {
#pragma unroll
        for (int r = 0; r < 12; ++r) rows[r] = nrows[r];
        if (it + nb < T_ / 16) request(it + nb, nrows);
        const int tok0 = it * 16 + th * 8;
        float win[5][8];
#pragma unroll
        for (int r = 0; r < 4; ++r) {
            const u32x4 raw = rows[r];
            win[r + 1][0] = bflo(raw.x); win[r + 1][1] = bfhi(raw.x); win[r + 1][2] = bflo(raw.y); win[r + 1][3] = bfhi(raw.y);
            win[r + 1][4] = bflo(raw.z); win[r + 1][5] = bfhi(raw.z); win[r + 1][6] = bflo(raw.w); win[r + 1][7] = bfhi(raw.w);
        }
#pragma unroll
        for (int i = 0; i < 8; ++i) {
#pragma unroll
            for (int r = 0; r < 4; ++r)
#pragma unroll
                for (int c = 0; c < 8; ++c) win[r][c] = win[r + 1][c];
            const u32x4 raw = rows[i + 4];
            win[4][0] = bflo(raw.x); win[4][1] = bfhi(raw.x); win[4][2] = bflo(raw.y); win[4][3] = bfhi(raw.y);
            win[4][4] = bflo(raw.z); win[4][5] = bfhi(raw.z); win[4][6] = bflo(raw.w); win[4][7] = bfhi(raw.w);
            float o[8];
#pragma unroll
            for (int c = 0; c < 8; ++c) {
                float s = 0.f;
#pragma unroll
                for (int jj = 0; jj < 5; ++jj) s += wv[jj][c] * win[jj][c];
                o[c] = s * frcp(1.f + __expf(-s)) * sc;
            }
            u32x4 pk; pk.x = pk2(o[0], o[1]); pk.y = pk2(o[2], o[3]); pk.z = pk2(o[4], o[5]); pk.w = pk2(o[6], o[7]);
            *(u32x4*)(p.qc() + (size_t)(tok0 + i) * 1024 + c0) = pk;
        }
    }
}

#define SC_QS 0
#define SC_KS 17408
#define SC_VS 34816
#define SC_VW 39936
#define SC_CT 45056
#define SC_NS 53760
#define SC_KW 54272
#define SC_AK 54528
#define SC_CONV 55296
__device__ __forceinline__ void tr_read8(unsigned a0, unsigned a1, unsigned a2, unsigned a3, unsigned a4, unsigned a5, unsigned a6, unsigned a7,
                                         u32x2& r0, u32x2& r1, u32x2& r2, u32x2& r3, u32x2& r4, u32x2& r5, u32x2& r6, u32x2& r7) {
    asm volatile("ds_read_b64_tr_b16 %0, %8\n\tds_read_b64_tr_b16 %1, %9\n\tds_read_b64_tr_b16 %2, %10\n\tds_read_b64_tr_b16 %3, %11\n\t"
                 "ds_read_b64_tr_b16 %4, %12\n\tds_read_b64_tr_b16 %5, %13\n\tds_read_b64_tr_b16 %6, %14\n\tds_read_b64_tr_b16 %7, %15\n\ts_waitcnt lgkmcnt(0)"
                 : "=&v"(r0), "=&v"(r1), "=&v"(r2), "=&v"(r3), "=&v"(r4), "=&v"(r5), "=&v"(r6), "=&v"(r7)
                 : "v"(a0), "v"(a1), "v"(a2), "v"(a3), "v"(a4), "v"(a5), "v"(a6), "v"(a7) : "memory");
}
__device__ __forceinline__ void tr_read4(unsigned a0, unsigned a1, unsigned a2, unsigned a3, u32x2& r0, u32x2& r1, u32x2& r2, u32x2& r3) {
    asm volatile("ds_read_b64_tr_b16 %0, %4\n\tds_read_b64_tr_b16 %1, %5\n\tds_read_b64_tr_b16 %2, %6\n\tds_read_b64_tr_b16 %3, %7\n\ts_waitcnt lgkmcnt(0)"
                 : "=&v"(r0), "=&v"(r1), "=&v"(r2), "=&v"(r3) : "v"(a0), "v"(a1), "v"(a2), "v"(a3) : "memory");
}
__device__ __forceinline__ void tr_read2(unsigned a0, unsigned a1, u32x2& r0, u32x2& r1) {
    asm volatile("ds_read_b64_tr_b16 %0, %2\n\tds_read_b64_tr_b16 %1, %3\n\ts_waitcnt lgkmcnt(0)" : "=&v"(r0), "=&v"(r1) : "v"(a0), "v"(a1) : "memory");
}
__device__ __forceinline__ bf16x8 cat8(u32x2 lo, u32x2 hi) { u32x4 w; w.x = lo.x; w.y = lo.y; w.z = hi.x; w.w = hi.y; return __builtin_bit_cast(bf16x8, w); }
template <bool RET>
__device__ void scan_item(const P& p, int layer, unsigned char* lds, int b, int hh, int dir, int eq, int conv_q0, int conv_stride) {
    const int tid = opaque_tid(), lane = tid & 63, w = tid >> 6, fr = lane & 15, fq = lane >> 4;
    const unsigned lbase = (unsigned)(size_t)lds;
    const size_t tokb = (size_t)b * L_;
    const bf16_t* qsrc = RET ? (p.ze() + 2048 + hh * 128) : (p.qc() + hh * 128);
    const bf16_t* ksrc = RET ? (p.ze() + 2560 + hh * 128) : (p.qc() + 512 + hh * 128);
    const bf16_t* vsrc = p.ze() + (RET ? 3072 : 1024) + hh * 128 + eq * 32;
    const int qld = RET ? 4096 : 1024;
    const float lgam = RET ? logsigmoidf_(p.e_decay[(layer >> 1) * 8 + dir * 4 + hh]) : 0.f;
    const int lr = tid >> 4, lc = tid & 15;
    const int vr = tid >> 2, vc = tid & 3;
    u32x4 rq[4], rk[4], rv; float rli = 0.f, rlf = 0.f;
    auto tok_of = [&](int n, int pp) -> int {
        if (n == 0) return pp < 48 ? -1 : pp - 48;
        const int rr = 64 * (n - 1) + pp;
        return NM + (dir ? 2047 - rr : rr);
    };
    const long tstep = dir ? -64 : 64;
    const bf16_t* pq[4]; const bf16_t* pk[4]; const bf16_t* pv; const float* pg;
#pragma unroll
    for (int i = 0; i < 4; ++i) { const int t1 = tok_of(1, lr + 16 * i); pq[i] = qsrc + (tokb + t1) * qld + lc * 8; pk[i] = ksrc + (tokb + t1) * qld + lc * 8; }
    pv = vsrc + (tokb + tok_of(1, vr)) * 4096 + vc * 8;
    pg = p.gts() + (tokb + tok_of(1, lane)) * 16 + dir * 8 + hh;
    auto load_chunk = [&](int n) {
        if (n == 0) {
#pragma unroll
            for (int i = 0; i < 4; ++i) {
                const int t = max(tok_of(0, lr + 16 * i), 0);
                rq[i] = *(const u32x4*)(qsrc + (tokb + t) * qld + lc * 8); rk[i] = *(const u32x4*)(ksrc + (tokb + t) * qld + lc * 8);
            }
            { const int t = max(tok_of(0, vr), 0); rv = *(const u32x4*)(vsrc + (tokb + t) * 4096 + vc * 8); }
            if (!RET) {
                const int t = tok_of(0, lane); rli = 0.f; rlf = 0.f;
                if (t >= 0) { const float* gp = p.gts() + (tokb + t) * 16 + dir * 8 + hh; rli = gp[0]; rlf = logsigmoidf_(gp[4]); }
            }
        } else {
#pragma unroll
            for (int i = 0; i < 4; ++i) { rq[i] = *(const u32x4*)pq[i]; rk[i] = *(const u32x4*)pk[i]; pq[i] += tstep * qld; pk[i] += tstep * qld; }
            rv = *(const u32x4*)pv; pv += tstep * 4096;
            if (!RET) { rli = pg[0]; rlf = logsigmoidf_(pg[4]); pg += tstep * 16; }
        }
    };
    float bb, a_, cm;
    auto local_scan = [&]() {
        const float lf = RET ? lgam : rlf, li = RET ? 0.f : rli;
        bb = wave_prefix_sum(lf);
        a_ = li - bb; cm = a_;
        if (!RET) cm = wave_prefix_max(a_);
    };
    f32x4 Cacc[2][2];
#pragma unroll
    for (int a = 0; a < 2; ++a)
#pragma unroll
        for (int c = 0; c < 2; ++c) Cacc[a][c] = (f32x4){0.f, 0.f, 0.f, 0.f};
    float m_prev = 0.f, w_state = 0.f;
    f32x4 Cn[2] = {(f32x4){0.f, 0.f, 0.f, 0.f}, (f32x4){0.f, 0.f, 0.f, 0.f}};
    ConvTile cvt;
    load_chunk(0);
    local_scan();
    const int tq = (lane >> 2) & 3, tp = lane & 3;
    const unsigned trK = lbase + SC_KS + (8 * fq + tq) * 272 + (32 * w + 4 * tp) * 2;
    const unsigned trV = lbase + SC_VS + (8 * fq + tq) * 80 + (4 * tp) * 2;
    const int qrow = 16 * w + fr;
    float r_kw = 0.f, r_ws = 0.f, r_winter_q = 0.f, r_b63 = 0.f; f32x4 r_dm[4];
    if (RET) {
        r_b63 = lane_bcast(bb, 63);
        r_kw = __expf(r_b63 + a_); r_ws = __expf(r_b63);
        r_winter_q = __expf(lgam * (float)(qrow + 1));
#pragma unroll
        for (int nn = 0; nn < 4; ++nn)
#pragma unroll
            for (int jj = 0; jj < 4; ++jj) { const int key = 32 * (nn >> 1) + 8 * fq + 4 * (nn & 1) + jj; r_dm[nn][jj] = (key <= qrow) ? __expf(lgam * (float)(qrow - key)) : 0.f; }
    }
    for (int n = 0; n < 33; ++n) {
        float mm, b63, m_new, bm_, winter_, kw_, em_;
        if (RET) { mm = 0.f; b63 = r_b63; m_new = 0.f; bm_ = bb; winter_ = 0.f; em_ = 1.f; kw_ = (n == 0 && lane < 48) ? 0.f : r_kw; }
        else {
            mm = bb + fmaxf(m_prev, cm);
            b63 = lane_bcast(bb, 63); m_new = lane_bcast(mm, 63);
            bm_ = bb - mm; winter_ = __expf(bb + m_prev - mm); kw_ = (n == 0 && lane < 48) ? 0.f : __expf(b63 + a_ - m_new); em_ = __expf(-mm);
        }
        const int kpad = (n == 0) ? 48 : 0;
#pragma unroll
        for (int mt = 0; mt < 2; ++mt)
#pragma unroll
            for (int ne = 0; ne < 2; ++ne) {
                const f32x4 v = Cacc[mt][ne];
                u32x2 pk; pk.x = pk2(v[0], v[1]); pk.y = pk2(v[2], v[3]);
                *(u32x2*)(lds + SC_CT + (16 * ne + fr) * 272 + (32 * w + 16 * mt + 4 * fq) * 2) = pk;
            }
        if (!RET && fr == 0) {
#pragma unroll
            for (int mt = 0; mt < 2; ++mt) { u32x2 pk; pk.x = pk2(Cn[mt][0], Cn[mt][1]); pk.y = pk2(Cn[mt][2], Cn[mt][3]); *(u32x2*)(lds + SC_CT + 32 * 272 + (32 * w + 16 * mt + 4 * fq) * 2) = pk; }
        }
        w_state = RET ? r_ws : __expf(b63 + m_prev - m_new);
#pragma unroll
        for (int i = 0; i < 4; ++i) {
            const int row = lr + 16 * i;
            *(u32x4*)(lds + SC_QS + row * 272 + lc * 16) = rq[i];
            *(u32x4*)(lds + SC_KS + row * 272 + lc * 16) = rk[i];
        }
        {
            const float kwr = __shfl(kw_, vr & 63);
            *(u32x4*)(lds + SC_VS + vr * 80 + vc * 16) = rv;
            u32x4 sv;
            sv.x = pk2(bflo(rv.x) * kwr, bfhi(rv.x) * kwr); sv.y = pk2(bflo(rv.y) * kwr, bfhi(rv.y) * kwr);
            sv.z = pk2(bflo(rv.z) * kwr, bfhi(rv.z) * kwr); sv.w = pk2(bflo(rv.w) * kwr, bfhi(rv.w) * kwr);
            *(u32x4*)(lds + SC_VW + vr * 80 + vc * 16) = sv;
            if (!RET && vc == 0) *(unsigned*)(lds + SC_VW + vr * 80 + 64) = pk2(kwr, 0.f);
            if (!RET && w == 0) ((float*)(lds + SC_AK))[lane] = a_ * 1.4426950408889634f;
        }
        __syncthreads();
        if (n + 1 < 33) load_chunk(n + 1);
        float4 cv[4];
        deferred_load(p, conv_q0 + n * conv_stride, tid, cv, cvt);
        bf16x8 qf[4];
#pragma unroll
        for (int ks = 0; ks < 4; ++ks) qf[ks] = *(const bf16x8*)(lds + SC_QS + qrow * 272 + (32 * ks + 8 * fq) * 2);
        float bm_q = 0.f, winter_q = r_winter_q, em_q = 1.f;
        f32x4 dm[4];
        if (RET) {
#pragma unroll
            for (int nn = 0; nn < 4; ++nn) dm[nn] = r_dm[nn];
            if (n == 0) {
#pragma unroll
                for (int nn = 0; nn < 4; ++nn)
#pragma unroll
                    for (int jj = 0; jj < 4; ++jj) if (32 * (nn >> 1) + 8 * fq + 4 * (nn & 1) + jj < 48) dm[nn][jj] = 0.f;
            }
        } else {
            bm_q = __shfl(bm_, qrow); winter_q = __shfl(winter_, qrow); em_q = __shfl(em_, qrow);
            const float bm2 = bm_q * 1.4426950408889634f;
#pragma unroll
            for (int nn = 0; nn < 4; ++nn) {
                const int key0 = 32 * (nn >> 1) + 8 * fq + 4 * (nn & 1);
                const f32x4 ak = *(const f32x4*)(lds + SC_AK + key0 * 4);
#pragma unroll
                for (int jj = 0; jj < 4; ++jj) dm[nn][jj] = (key0 + jj <= qrow && key0 + jj >= kpad) ? __builtin_amdgcn_exp2f(bm2 + ak[jj]) : 0.f;
            }
        }
        f32x4 S[4];
#pragma unroll
        for (int nn = 0; nn < 4; ++nn) {
            const int krow = 32 * (nn >> 1) + 8 * (fr >> 2) + 4 * (nn & 1) + (fr & 3);
            f32x4 acc = (f32x4){0.f, 0.f, 0.f, 0.f};
#pragma unroll
            for (int ks = 0; ks < 4; ++ks) {
                const bf16x8 kf = *(const bf16x8*)(lds + SC_KS + krow * 272 + (32 * ks + 8 * fq) * 2);
                acc = __builtin_amdgcn_mfma_f32_16x16x32_bf16(kf, qf[ks], acc, 0, 0, 0);
            }
            S[nn] = acc;
        }
        float rsum = 0.f;
#pragma unroll
        for (int nn = 0; nn < 4; ++nn)
#pragma unroll
            for (int jj = 0; jj < 4; ++jj) { const float sv = S[nn][jj] * dm[nn][jj]; S[nn][jj] = sv; rsum += sv; }
        f32x4 O[2], OC[2];
#pragma unroll
        for (int ne = 0; ne < 2; ++ne) { O[ne] = (f32x4){0.f, 0.f, 0.f, 0.f}; OC[ne] = (f32x4){0.f, 0.f, 0.f, 0.f}; }
        {
            u32x2 v00a, v00b, v01a, v01b, v10a, v10b, v11a, v11b;
            tr_read8(trV, trV + 4 * 80, trV + 32, trV + 32 + 4 * 80, trV + 32 * 80, trV + 36 * 80, trV + 32 * 80 + 32, trV + 36 * 80 + 32,
                     v00a, v00b, v01a, v01b, v10a, v10b, v11a, v11b);
            u32x4 pw; bf16x8 pf;
            pw.x = pk2(S[0][0], S[0][1]); pw.y = pk2(S[0][2], S[0][3]); pw.z = pk2(S[1][0], S[1][1]); pw.w = pk2(S[1][2], S[1][3]); pf = __builtin_bit_cast(bf16x8, pw);
            O[0] = __builtin_amdgcn_mfma_f32_16x16x32_bf16(cat8(v00a, v00b), pf, O[0], 0, 0, 0);
            O[1] = __builtin_amdgcn_mfma_f32_16x16x32_bf16(cat8(v01a, v01b), pf, O[1], 0, 0, 0);
            pw.x = pk2(S[2][0], S[2][1]); pw.y = pk2(S[2][2], S[2][3]); pw.z = pk2(S[3][0], S[3][1]); pw.w = pk2(S[3][2], S[3][3]); pf = __builtin_bit_cast(bf16x8, pw);
            O[0] = __builtin_amdgcn_mfma_f32_16x16x32_bf16(cat8(v10a, v10b), pf, O[0], 0, 0, 0);
            O[1] = __builtin_amdgcn_mfma_f32_16x16x32_bf16(cat8(v11a, v11b), pf, O[1], 0, 0, 0);
        }
#pragma unroll
        for (int ks = 0; ks < 4; ++ks)
#pragma unroll
            for (int ne = 0; ne < 2; ++ne) {
                const bf16x8 cf = *(const bf16x8*)(lds + SC_CT + (16 * ne + fr) * 272 + (32 * ks + 8 * fq) * 2);
                OC[ne] = __builtin_amdgcn_mfma_f32_16x16x32_bf16(cf, qf[ks], OC[ne], 0, 0, 0);
            }
        float scC = winter_q, scS = 1.f;
        if (!RET) {
            f32x4 OCn = (f32x4){0.f, 0.f, 0.f, 0.f};
#pragma unroll
            for (int ks = 0; ks < 4; ++ks) {
                const bf16x8 cf = *(const bf16x8*)(lds + SC_CT + (32 + fr) * 272 + (32 * ks + 8 * fq) * 2);
                OCn = __builtin_amdgcn_mfma_f32_16x16x32_bf16(cf, qf[ks], OCn, 0, 0, 0);
            }
            const float qn = row_bcast_w(OCn[0], 0);
            rsum = rows_sum(rsum);
            const float den = winter_q * qn + rsum;
            const float rden = frcp(fmaxf(fabsf(den), em_q));
            scC = winter_q * rden; scS = rden;
        }
        {
            const int t = tok_of(n, qrow);
            if (t >= 0) {
                bf16_t* op = p.osc() + ((size_t)dir * T_ + tokb + t) * 1024 + (RET ? 512 : 0) + hh * 128 + eq * 32 + 4 * fq;
#pragma unroll
                for (int ne = 0; ne < 2; ++ne) {
                    const f32x4 o = OC[ne] * scC + O[ne] * scS;
                    u32x2 pk; pk.x = pk2(o[0], o[1]); pk.y = pk2(o[2], o[3]);
                    *(u32x2*)(op + 16 * ne) = pk;
                }
            }
        }
#pragma unroll
        for (int mt = 0; mt < 2; ++mt)
#pragma unroll
            for (int ne = 0; ne < 2; ++ne) Cacc[mt][ne] = Cacc[mt][ne] * w_state;
        if (!RET) { Cn[0] = Cn[0] * w_state; Cn[1] = Cn[1] * w_state; }
#pragma unroll
        for (int t = 0; t < 2; ++t) {
            u32x2 k0a, k0b, k1a, k1b, w0a, w0b, w1a, w1b;
            const unsigned ka = trK + 32 * t * 272, wa = trV + (SC_VW - SC_VS) + 32 * t * 80;
            tr_read8(ka, ka + 4 * 272, ka + 32, ka + 32 + 4 * 272, wa, wa + 4 * 80, wa + 32, wa + 32 + 4 * 80, k0a, k0b, k1a, k1b, w0a, w0b, w1a, w1b);
            const bf16x8 kf0 = cat8(k0a, k0b), kf1 = cat8(k1a, k1b), vf0 = cat8(w0a, w0b), vf1 = cat8(w1a, w1b);
            Cacc[0][0] = __builtin_amdgcn_mfma_f32_16x16x32_bf16(kf0, vf0, Cacc[0][0], 0, 0, 0);
            Cacc[0][1] = __builtin_amdgcn_mfma_f32_16x16x32_bf16(kf0, vf1, Cacc[0][1], 0, 0, 0);
            Cacc[1][0] = __builtin_amdgcn_mfma_f32_16x16x32_bf16(kf1, vf0, Cacc[1][0], 0, 0, 0);
            Cacc[1][1] = __builtin_amdgcn_mfma_f32_16x16x32_bf16(kf1, vf1, Cacc[1][1], 0, 0, 0);
            if (!RET) {
                u32x2 n0a, n0b;
                tr_read2(wa + 64, wa + 64 + 4 * 80, n0a, n0b);
                const bf16x8 vfn = cat8(n0a, n0b);
                Cn[0] = __builtin_amdgcn_mfma_f32_16x16x32_bf16(kf0, vfn, Cn[0], 0, 0, 0);
                Cn[1] = __builtin_amdgcn_mfma_f32_16x16x32_bf16(kf1, vfn, Cn[1], 0, 0, 0);
            }
        }
        m_prev = m_new;
        if (!RET && n + 1 < 33) local_scan();
        conv_lds((float*)(lds + SC_CONV), cv, tid);
        __syncthreads();
        conv_store((const float*)(lds + SC_CONV), cvt, tid);
    }
}
__device__ __forceinline__ void phase_scan(const P& p, int layer, unsigned char* lds, int bid, int nb) {
    for (int it = bid; it < 512; it += nb) {
        const int x = it & 7, y = it >> 3;
        const int ch = (y >> 2) * 8 + x, eq = y & 3;
        const int type = ch >> 6, b = (ch >> 3) & 7, hh = (ch >> 1) & 3, dir = ch & 1;
        const int q0 = (layer >> 1) * DEF_PER_SCAN + it;
        if (type == 0) scan_item<false>(p, layer, lds, b, hh, dir, eq, q0, 512);
        else scan_item<true>(p, layer, lds, b, hh, dir, eq, q0, 512);
    }
}

__device__ __forceinline__ void phase_mixfin(const P& p, int layer, int bid, int nb) {
    const int tid = opaque_tid(), lane = tid & 63, wid = tid >> 6, j = layer >> 1;
    float g[2][8];
    ld_f8(p.e_mg + j * 512 + 8 * lane, g[0]); ld_f8(p.e_rg + j * 512 + 8 * lane, g[1]);
    int tok = bid * 4 + wid;
    const int stride = nb * 4;
    u32x4 an[2], cn_[2], gzn[2], an2[2], cn2[2], gzn2[2];
    auto ld = [&](int tk, u32x4 (&A)[2], u32x4 (&C)[2], u32x4 (&G)[2]) {
#pragma unroll
        for (int i = 0; i < 2; ++i) {
            const int f = 512 * i + 8 * lane;
            const int gcol = (i == 0) ? (1536 + 8 * lane) : (3584 + 8 * lane);
            A[i] = *(const u32x4*)(p.osc() + (size_t)tk * 1024 + f);
            C[i] = *(const u32x4*)(p.osc() + ((size_t)T_ + tk) * 1024 + f);
            G[i] = *(const u32x4*)(p.ze() + (size_t)tk * 4096 + gcol);
        }
    };
    if (tok < T_) ld(tok, an, cn_, gzn);
    if (tok + stride < T_) ld(tok + stride, an2, cn2, gzn2);
#pragma unroll 1
    for (; tok < T_; tok += stride) {
        u32x4 a[2], c[2], gz[2];
#pragma unroll
        for (int i = 0; i < 2; ++i) { a[i] = an[i]; c[i] = cn_[i]; gz[i] = gzn[i]; an[i] = an2[i]; cn_[i] = cn2[i]; gzn[i] = gzn2[i]; }
        if (tok + 2 * stride < T_) ld(tok + 2 * stride, an2, cn2, gzn2);
#pragma unroll
        for (int i = 0; i < 2; ++i) {
            const float v[8] = {bflo(a[i].x) + bflo(c[i].x), bfhi(a[i].x) + bfhi(c[i].x), bflo(a[i].y) + bflo(c[i].y), bfhi(a[i].y) + bfhi(c[i].y),
                                bflo(a[i].z) + bflo(c[i].z), bfhi(a[i].z) + bfhi(c[i].z), bflo(a[i].w) + bflo(c[i].w), bfhi(a[i].w) + bfhi(c[i].w)};
            const float gzv[8] = {bflo(gz[i].x), bfhi(gz[i].x), bflo(gz[i].y), bfhi(gz[i].y), bflo(gz[i].z), bfhi(gz[i].z), bflo(gz[i].w), bfhi(gz[i].w)};
            float ss = 0.f;
#pragma unroll
            for (int c2 = 0; c2 < 8; ++c2) ss += v[c2] * v[c2];
            ss += __shfl_xor(ss, 8); ss += __shfl_xor(ss, 4); ss += __shfl_xor(ss, 2); ss += __shfl_xor(ss, 1);
            const float r = frsq(ss * (1.f / 128.f) + 1e-6f);
            float o8[8];
#pragma unroll
            for (int c2 = 0; c2 < 8; ++c2) {
                const float sg = frcp(1.f + __expf(-gzv[c2]));
                const float gate = (i == 0) ? sg : gzv[c2] * sg;
                o8[c2] = gate * (v[c2] * r * g[i][c2]);
            }
            st_bf8(p.mix() + (size_t)tok * 1024 + 512 * i + 8 * lane, o8);
        }
    }
}

__device__ __forceinline__ void phase_cn(const P& p, int nl, unsigned char* lds, int bid, int nb, bool dry = false) {
    const int tid = opaque_tid(), lane = tid & 63, wid = tid >> 6;
    const bool even = (nl & 1) == 0 && nl < 4;
    const float* g = p.attn_g + (nl < 4 ? nl : 0) * D_;
    if (even) {
        __syncthreads();
        stage_proj16(lds, p.e_win + (size_t)(nl >> 1) * D_ * EVEN_IN + 2048, EVEN_IN, g, tid);
        __syncthreads();
    }
    Row16 gg; ld_f8(g + 8 * lane, gg.v[0]); ld_f8(g + 512 + 8 * lane, gg.v[1]);
    const int eme = e_of_lane(lane);
    const float gbias = p.e_gb[(nl < 4 ? (nl >> 1) : 0) * 16 + eme];
    auto ld_row = [&](int tk, Row16& dst) {
        if (nl != 0) ld_row_bf(p.h() + (size_t)tk * D_, lane, dst);
        else {
            const int b2 = tk / L_, t2 = tk - b2 * L_;
            const float* src = t2 < NM ? p.meta + (size_t)t2 * D_ : p.x + ((size_t)b2 * 2048 + (t2 - NM)) * D_;
            ld_f8(src + 8 * lane, dst.v[0]); ld_f8(src + 512 + 8 * lane, dst.v[1]);
        }
    };
    int tok = bid * 4 + wid;
    Row16 hn; int seln = -1;
    if (tok < T_) {
        ld_row(tok, hn);
        if (nl != 0) seln = p.sel()[(size_t)tok * 16 + (lane & 15)];
    }
#pragma unroll 1
    for (; tok < T_; tok += nb * 4) {
        const int b = tok / L_, t = tok - b * L_;
        Row16 hv = hn;
        const int sel_l = seln;
        {
            const int tn = tok + nb * 4;
            if (tn < T_) {
                ld_row(tn, hn);
                if (nl != 0) seln = p.sel()[(size_t)tn * 16 + (lane & 15)];
            }
        }
        if (nl != 0) {
            unsigned long long msk = __ballot(sel_l >= 0 && lane < 16);
            while (msk) {
                const int e0 = __builtin_ctzll(msk); msk &= msk - 1;
                int e1 = -1; if (msk) { e1 = __builtin_ctzll(msk); msk &= msk - 1; }
                const int s0 = __shfl(sel_l, e0), s1 = __shfl(sel_l, e1 < 0 ? e0 : e1);
                const bf16_t* y0 = p.ys() + ((size_t)(e0 * B_ + b) * CAP + s0) * D_;
                const bf16_t* y1 = p.ys() + ((size_t)((e1 < 0 ? e0 : e1) * B_ + b) * CAP + s1) * D_;
                Row16 a0, a1;
                ld_row_bf(y0, lane, a0); ld_row_bf(y1, lane, a1);
                const float w1 = e1 < 0 ? 0.f : 1.f;
#pragma unroll
                for (int i = 0; i < 2; ++i)
#pragma unroll
                    for (int c = 0; c < 8; ++c) hv.v[i][c] += a0.v[i][c] + w1 * a1.v[i][c];
            }
        }
        if (nl == 4) {
            if (t >= NM) {
                float* op = p.out + ((size_t)b * 2048 + (t - NM)) * D_;
#pragma unroll
                for (int i = 0; i < 2; ++i) {
                    *(float4*)(op + 512 * i + 8 * lane) = make_float4(hv.v[i][0], hv.v[i][1], hv.v[i][2], hv.v[i][3]);
                    *(float4*)(op + 512 * i + 8 * lane + 4) = make_float4(hv.v[i][4], hv.v[i][5], hv.v[i][6], hv.v[i][7]);
                }
            }
            continue;
        }
        if (!dry) {
#pragma unroll
            for (int i = 0; i < 2; ++i) st_bf8(p.h() + (size_t)tok * D_ + 512 * i + 8 * lane, hv.v[i]);
        }
        const float r = frsq(wave_sum(row_sumsq(hv)) * (1.f / D_) + 1e-6f);
#pragma unroll
        for (int i = 0; i < 2; ++i) {
            float uu[8];
#pragma unroll
            for (int c = 0; c < 8; ++c) uu[c] = hv.v[i][c] * r * gg.v[i][c];
            st_bf8(p.u() + (size_t)tok * D_ + 512 * i + 8 * lane, uu);
        }
        if (even) {
            float acc[16];
            proj16_accum(lds, hv, lane, acc);
            const float gv = reduce_scatter16(acc, lane) * r + gbias;
            if ((lane & 3) == 0) p.gts()[(size_t)tok * 16 + eme] = gv;
        }
    }
}

#define XB_TMO      128
#define XB_XCNT(j)  (256  + 64 * (j))
#define XB_XSUB(j)  (1280 + 64 * (j))
#define XB_XGEN(j)  (2304 + 64 * (j))
#define XB_TOP      3328
#define XB_TOPGEN   3392
#define XB_SPIN_CAP (1u << 22)
#define LAS __attribute__((address_space(3)))
__device__ __forceinline__ unsigned xb_ld(unsigned* p)              { return __hip_atomic_load(p, __ATOMIC_RELAXED, __HIP_MEMORY_SCOPE_AGENT); }
__device__ __forceinline__ unsigned xb_add(unsigned* p, unsigned v) { return __hip_atomic_fetch_add(p, v, __ATOMIC_RELAXED, __HIP_MEMORY_SCOPE_AGENT); }
__device__ __forceinline__ unsigned xb_xcc_id() { return (unsigned)__builtin_amdgcn_s_getreg((3 << 11) | 20) & 0xFu; }
#define XB_SPIN(cond, bar) do { unsigned _sp = 0; while (cond) { __builtin_amdgcn_s_sleep(1); \
    if ((++_sp & 255u) == 0u) { if (xb_ld(&(bar)[XB_TMO])) break; if (_sp > XB_SPIN_CAP) { atomicAdd(&(bar)[XB_TMO], 1u); break; } } } } while (0)
struct XcdBarrier { unsigned* bar; unsigned x; unsigned nloc, nx, epoch; };
__device__ __forceinline__ XcdBarrier xcd_barrier_post(unsigned* bar) {
    XcdBarrier b; b.bar = bar; b.x = xb_xcc_id(); b.nloc = 0u; b.nx = 0u; b.epoch = 0u;
    if (threadIdx.x == 0) (void)xb_add(&bar[XB_XCNT(b.x)], 1u);
    return b;
}
__device__ __forceinline__ void xcd_barrier_complete(unsigned* bar, unsigned x, unsigned& nloc, unsigned& nx) {
    const unsigned G = gridDim.x * gridDim.y * gridDim.z;
    unsigned sum, cnt, mine, sp = 0u;
    for (;;) {
        sum = 0u; cnt = 0u; mine = 0u;
#pragma unroll
        for (unsigned j = 0; j < 16; ++j) { const unsigned c = xb_ld(&bar[XB_XCNT(j)]); sum += c; cnt += (c > 0u) ? 1u : 0u; mine = (j == x) ? c : mine; }
        if (sum == G) break;
        __builtin_amdgcn_s_sleep(1);
        if ((++sp & 255u) == 0u) { if (xb_ld(&bar[XB_TMO])) break; if (sp > XB_SPIN_CAP) { atomicAdd(&bar[XB_TMO], 1u); break; } }
    }
    nloc = mine > 0u ? mine : 1u; nx = cnt > 0u ? cnt : 1u;
}
__device__ __forceinline__ void xcd_barrier(XcdBarrier& b) {
    asm volatile("s_waitcnt vmcnt(0)" ::: "memory");
    __syncthreads();
    if (threadIdx.x == 0) {
        unsigned* bar = b.bar; unsigned bx = b.x;
        asm volatile("" : "+s"(bar), "+s"(bx));
        __builtin_amdgcn_s_waitcnt(0);
        const unsigned nloc = b.nloc, nx = b.nx;
        const unsigned old = xb_add(&bar[XB_XSUB(bx)], 1u);
        const unsigned gen = b.epoch;
        if (old + 1u == (gen + 1u) * nloc) {
            __builtin_amdgcn_fence(__ATOMIC_RELEASE, "agent");
            asm volatile("s_waitcnt vmcnt(0)" ::: "memory");
            const unsigned og = xb_add(&bar[XB_TOP], 1u);
            const unsigned tg = b.epoch;
            if (og + 1u == (tg + 1u) * nx) xb_add(&bar[XB_TOPGEN], 1u);
            else XB_SPIN(xb_ld(&bar[XB_TOPGEN]) == tg, bar);
            __builtin_amdgcn_fence(__ATOMIC_ACQUIRE, "agent");
            xb_add(&bar[XB_XGEN(bx)], 1u);
            asm volatile("s_waitcnt vmcnt(0)" ::: "memory");
        } else {
            XB_SPIN(xb_ld(&bar[XB_XGEN(bx)]) == gen, bar);
            __builtin_amdgcn_fence(__ATOMIC_ACQUIRE, "agent");
            asm volatile("s_waitcnt vmcnt(0)" ::: "memory");
        }
    }
    b.epoch += 1u;
    __syncthreads();
}

typedef const __attribute__((address_space(4))) unsigned long long* KArg;
__device__ __forceinline__ P load_args(KArg k) {
    asm volatile("" : "+s"(k));
    P p;
    p.x = (const float*)k[0]; p.meta = (const float*)k[1]; p.attn_g = (const float*)k[2]; p.ffn_g = (const float*)k[3]; p.e_win = (const float*)k[4];
    p.e_conv = (const float*)k[5]; p.e_gb = (const float*)k[6]; p.e_mg = (const float*)k[7]; p.e_decay = (const float*)k[8]; p.e_rg = (const float*)k[9];
    p.e_wout = (const float*)k[10]; p.o_win = (const float*)k[11]; p.o_qg = (const float*)k[12]; p.o_kg = (const float*)k[13]; p.o_rpb = (const float*)k[14];
    p.o_wout = (const float*)k[15]; p.router_w = (const float*)k[16]; p.w_gate = (const float*)k[17]; p.w_up = (const float*)k[18]; p.w_down = (const float*)k[19];
    p.out = (float*)k[20]; p.ws = (unsigned char*)k[21];
    return p;
}
#define PH(call) { const P p = load_args(kp); int bid = bid_, nb = nb_; asm volatile("" : "+s"(bid), "+s"(nb)); call; }
__global__ void __launch_bounds__(NTHR, 2) k_mega(P p_unused) {
    extern __shared__ __attribute__((aligned(16))) unsigned char lds_raw[];
    unsigned char* lds = lds_raw;
    const KArg kp = (KArg)__builtin_amdgcn_kernarg_segment_ptr();
    const int bid_ = blockIdx.x, nb_ = gridDim.x;
    XcdBarrier xb;
    { const P p = load_args(kp); xb = xcd_barrier_post(p.bar()); }
    if (threadIdx.x == 0) { unsigned nloc, nx; xcd_barrier_complete(xb.bar, xb.x, nloc, nx); ((volatile unsigned*)lds)[0] = nloc; ((volatile unsigned*)lds)[1] = nx; }
    __syncthreads();
    xb.nloc = (unsigned)__builtin_amdgcn_readfirstlane((int)((volatile unsigned*)lds)[0]);
    xb.nx = (unsigned)__builtin_amdgcn_readfirstlane((int)((volatile unsigned*)lds)[1]);
    __syncthreads();
#define GB() xcd_barrier(xb)
    PH(phase_tables(p, bid, nb));
    PH(phase_convert(p, lds, bid, nb));
    PH(phase_cn(p, 0, lds, bid, nb));
    GB();
#if PROBE_BARRIER
    for (int i = 0; i < 100; ++i) GB();
#endif
#pragma nounroll
    for (int layer = 0; layer < 4; ++layer) {
        if ((layer & 1) == 0) {
            PH(phase_even_in(p, layer, lds, bid, nb)); GB();
            PH(phase_conv(p, layer, bid, nb)); GB();
#if PROBE_CONV
            PH(phase_conv(p, layer, bid, nb)); GB();
#endif
            PH(phase_scan(p, layer, lds, bid, nb)); GB();
#if PROBE_SCAN
            PH(phase_scan(p, layer, lds, bid, nb)); GB();
#endif
            PH(phase_mixfin(p, layer, bid, nb)); GB();
#if PROBE_MIXFIN
            PH(phase_mixfin(p, layer, bid, nb)); GB();
#endif
            PH(phase_outproj(p, p.WoutE() + (size_t)(layer >> 1) * 1024 * 1024, lds, bid, nb)); GB();
        } else {
            PH(phase_odd_in(p, layer, lds, bid, nb)); GB();
            PH(phase_natten(p, layer, lds, bid, nb)); GB();
            PH(phase_outproj(p, p.WoutO() + (size_t)(layer >> 1) * 1024 * 1024, lds, bid, nb)); GB();
        }
        PH(phase_router(p, layer, lds, bid, nb)); GB();
        PH(phase_topk(p, lds, bid, nb)); GB();
        PH(phase_gateup(p, layer, lds, bid, nb)); GB();
        PH(phase_down(p, layer, lds, bid, nb)); GB();
#if PROBE_CN
        PH(phase_cn(p, layer + 1, lds, bid, nb, true)); GB();
#endif
        PH(phase_cn(p, layer + 1, lds, bid, nb));
        if (layer < 3) GB();
    }
}

static inline size_t al256(size_t x) { return (x + 255) & ~(size_t)255; }

extern "C" void kernel_launch(void* const* d_in, const int* in_sizes, int n_in, void* d_out, int out_size, void* d_ws, size_t ws_size, hipStream_t stream) {
    P p; memset(&p, 0, sizeof(p));
    p.x = (const float*)d_in[0]; p.meta = (const float*)d_in[1]; p.attn_g = (const float*)d_in[2]; p.ffn_g = (const float*)d_in[3];
    p.e_win = (const float*)d_in[4]; p.e_conv = (const float*)d_in[5]; p.e_gb = (const float*)d_in[6]; p.e_mg = (const float*)d_in[7];
    p.e_decay = (const float*)d_in[8]; p.e_rg = (const float*)d_in[9]; p.e_wout = (const float*)d_in[10]; p.o_win = (const float*)d_in[11];
    p.o_qg = (const float*)d_in[12]; p.o_kg = (const float*)d_in[13]; p.o_rpb = (const float*)d_in[14]; p.o_wout = (const float*)d_in[15];
    p.router_w = (const float*)d_in[16]; p.w_gate = (const float*)d_in[17]; p.w_up = (const float*)d_in[18]; p.w_down = (const float*)d_in[19];
    p.out = (float*)d_out;

    p.ws = (unsigned char*)d_ws;
    if (WS_NEEDED > ws_size) return;

    static int grid_blocks = 0;
    if (!grid_blocks) {
        int dev = 0, cus = 0, per_cu = 0;
        if (hipGetDevice(&dev) != hipSuccess) return;
        if (hipDeviceGetAttribute(&cus, hipDeviceAttributeMultiprocessorCount, dev) != hipSuccess) return;
        if (hipFuncSetAttribute((const void*)k_mega, hipFuncAttributeMaxDynamicSharedMemorySize, LDS_BYTES) != hipSuccess) return;
        if (hipOccupancyMaxActiveBlocksPerMultiprocessor(&per_cu, (const void*)k_mega, NTHR, LDS_BYTES) != hipSuccess || per_cu < 1) return;
        if (per_cu > 2) per_cu = 2;
        cus &= ~7;
        if (cus < 8) return;
        grid_blocks = cus * per_cu;
    }
    (void)hipMemsetAsync(p.ws + OFF_BAR, 0, 16384, stream);
    hipLaunchKernelGGL(k_mega, dim3(grid_blocks), dim3(NTHR), LDS_BYTES, stream, p);
}
```

```cpp
#include <hip/hip_runtime.h>
#include <stdint.h>
#include <string.h>

#ifndef PROBE_CONV
#define PROBE_CONV 0
#endif
#ifndef PROBE_GEMM
#define PROBE_GEMM 0
#endif
#ifndef PROBE_SCAN
#define PROBE_SCAN 0
#endif
#ifndef PROBE_CONVERT
#define PROBE_CONVERT 0
#endif
#ifndef PROBE_NATTEN
#define PROBE_NATTEN 0
#endif
#ifndef PROBE_MISC
#define PROBE_MISC 0
#endif
#ifndef PROBE_MIXFIN
#define PROBE_MIXFIN 0
#endif
#ifndef PROBE_ROUTER
#define PROBE_ROUTER 0
#endif
#ifndef PROBE_TOPK
#define PROBE_TOPK 0
#endif
#ifndef PROBE_BARRIER
#define PROBE_BARRIER 0
#endif
#ifndef PROBE_CN
#define PROBE_CN 0
#endif
#ifndef PROBE_DMA
#define PROBE_DMA 0
#endif
#ifndef PROBE_STAGE
#define PROBE_STAGE 0
#endif
#ifndef PROBE_KLOOP
#define PROBE_KLOOP 0
#endif
#ifndef PROBE_EPI
#define PROBE_EPI 0
#endif
#define B_ 8
#define L_ 2064
#define T_ (B_ * L_)
#define D_ 1024
#define NM 16
#define EVEN_IN 4112
#define ODD_IN 3072
#define NE 16
#define CAP 258
#define NG (B_ * NE)

__device__ __forceinline__ float block_sum256(float v, float* red) {
    for (int o = 32; o > 0; o >>= 1) v += __shfl_xor(v, o);
    __syncthreads();
    if ((threadIdx.x & 63) == 0) red[threadIdx.x >> 6] = v;
    __syncthreads();
    return red[0] + red[1] + red[2] + red[3];
}
__device__ __forceinline__ float sigmoidf_(float x) { return 1.f / (1.f + expf(-x)); }
__device__ __forceinline__ float siluf_(float x) { return x / (1.f + expf(-x)); }
__device__ __forceinline__ float fmax_nc(float a, float b) { return __builtin_amdgcn_fmed3f(a, b, __builtin_inff()); }
__device__ __forceinline__ float fmax3_raw(float a, float b, float c) { float r; asm("v_max3_f32 %0, %1, %2, %3" : "=v"(r) : "v"(a), "v"(b), "v"(c)); return r; }
__device__ __forceinline__ float frcp(float x) { return __builtin_amdgcn_rcpf(x); }
__device__ __forceinline__ float frsq(float x) { return __builtin_amdgcn_rsqf(x); }
__device__ __forceinline__ float logsigmoidf_(float x) { return fminf(x, 0.f) - __logf(1.f + __expf(-fabsf(x))); }


typedef unsigned short bf16_t;
typedef short bf16x8 __attribute__((ext_vector_type(8)));
typedef float f32x4 __attribute__((ext_vector_type(4)));
typedef unsigned u32x4 __attribute__((ext_vector_type(4)));
typedef unsigned u32x2 __attribute__((ext_vector_type(2)));

#define NTHR 256
#define ESLOTS 2064
#define LDS_BYTES (80 * 1024)

__device__ __forceinline__ unsigned f2bf(float f) { unsigned u = __builtin_bit_cast(unsigned, f); return (u + 0x7fffu + ((u >> 16) & 1u)) >> 16; }
typedef __attribute__((ext_vector_type(2))) __bf16 bf16pair_t;
typedef __attribute__((ext_vector_type(2))) float f32pair_t;
__device__ __forceinline__ unsigned pk2(float lo, float hi) { const f32pair_t v = {lo, hi}; const bf16pair_t r = __builtin_convertvector(v, bf16pair_t); return __builtin_bit_cast(unsigned, r); }
__device__ __forceinline__ float bf2f(unsigned short b) { return __builtin_bit_cast(float, (unsigned)b << 16); }
__device__ __forceinline__ float bflo(unsigned w) { return __builtin_bit_cast(float, w << 16); }
__device__ __forceinline__ float bfhi(unsigned w) { return __builtin_bit_cast(float, w & 0xffff0000u); }
__device__ __forceinline__ float4 ldnt_f4(const float* q) { const f32x4 v = __builtin_nontemporal_load((const f32x4*)q); return make_float4(v[0], v[1], v[2], v[3]); }
__device__ __forceinline__ void stnt_f4(float* q, float a, float b, float c, float d) { __builtin_nontemporal_store((f32x4){a, b, c, d}, (f32x4*)q); }
__device__ __forceinline__ u32x4 ldnt_u4(const void* q) { return __builtin_nontemporal_load((const u32x4*)q); }
__device__ __forceinline__ void stnt_u4(void* q, u32x4 v) { __builtin_nontemporal_store(v, (u32x4*)q); }

#define AL256(x) (((x) + 255) & ~(size_t)255)
constexpr size_t OFF_BAR = 0;
constexpr size_t OFF_WGU = 16384;
constexpr size_t OFF_WD = OFF_WGU + AL256((size_t)4 * 16 * 2048 * 1024 * 2);
constexpr size_t OFF_WINE = OFF_WD + AL256((size_t)4 * 16 * 1024 * 1024 * 2);
constexpr size_t OFF_WINO = OFF_WINE + AL256((size_t)2 * 4096 * 1024 * 2);
constexpr size_t OFF_WOUTE = OFF_WINO + AL256((size_t)2 * 3072 * 1024 * 2);
constexpr size_t OFF_WOUTO = OFF_WOUTE + AL256((size_t)2 * 1024 * 1024 * 2);
constexpr size_t OFF_H = OFF_WOUTO + AL256((size_t)2 * 1024 * 1024 * 2);
constexpr size_t OFF_U = OFF_H + AL256((size_t)T_ * D_ * 4);
constexpr size_t OFF_ZE = OFF_U + AL256((size_t)T_ * D_ * 2);
constexpr size_t OFF_QC = OFF_ZE + AL256((size_t)T_ * 4096 * 2);
constexpr size_t OFF_OSC = OFF_QC + AL256((size_t)T_ * D_ * 2);
constexpr size_t OFF_MIX = OFF_OSC + AL256((size_t)2 * T_ * D_ * 2);
constexpr size_t OFF_GTS = OFF_MIX + AL256((size_t)T_ * D_ * 2);
constexpr size_t OFF_AFF = OFF_GTS + AL256((size_t)T_ * 16 * 4);
constexpr size_t OFF_GATE = OFF_AFF + AL256((size_t)T_ * 16 * 4);
constexpr size_t OFF_IDX = OFF_GATE + AL256((size_t)NE * ESLOTS * 4);
constexpr size_t OFF_SEL = OFF_IDX + AL256((size_t)NE * ESLOTS * 4);
constexpr size_t OFF_COS = OFF_SEL + AL256((size_t)T_ * 16 * 4);
constexpr size_t OFF_SIN = OFF_COS + AL256((size_t)L_ * 64 * 4);
constexpr size_t OFF_RTW = OFF_SIN + AL256((size_t)L_ * 64 * 4);
constexpr size_t WS_NEEDED = OFF_RTW + (size_t)4 * 65536;

__device__ __forceinline__ int opaque_tid() { int t = threadIdx.x; asm volatile("" : "+v"(t)); return t; }

struct P {
    const float *x, *meta, *attn_g, *ffn_g, *e_win, *e_conv, *e_gb, *e_mg, *e_decay, *e_rg, *e_wout, *o_win, *o_qg, *o_kg, *o_rpb, *o_wout, *router_w, *w_gate, *w_up, *w_down;
    float* out;
    unsigned char* ws;
    __device__ __forceinline__ unsigned* bar() const { return (unsigned*)(ws + OFF_BAR); }
    __device__ __forceinline__ bf16_t* Wgu() const { return (bf16_t*)(ws + OFF_WGU); }
    __device__ __forceinline__ bf16_t* Wd() const { return (bf16_t*)(ws + OFF_WD); }
    __device__ __forceinline__ bf16_t* WinE() const { return (bf16_t*)(ws + OFF_WINE); }
    __device__ __forceinline__ bf16_t* WinO() const { return (bf16_t*)(ws + OFF_WINO); }
    __device__ __forceinline__ bf16_t* WoutE() const { return (bf16_t*)(ws + OFF_WOUTE); }
    __device__ __forceinline__ bf16_t* WoutO() const { return (bf16_t*)(ws + OFF_WOUTO); }
    __device__ __forceinline__ bf16_t* h() const { return (bf16_t*)(ws + OFF_H); }
    __device__ __forceinline__ bf16_t* u() const { return (bf16_t*)(ws + OFF_U); }
    __device__ __forceinline__ bf16_t* ze() const { return (bf16_t*)(ws + OFF_ZE); }
    __device__ __forceinline__ bf16_t* zo() const { return (bf16_t*)(ws + OFF_ZE); }
    __device__ __forceinline__ bf16_t* kh() const { return (bf16_t*)(ws + OFF_ZE) + (size_t)T_ * 1024; }
    __device__ __forceinline__ bf16_t* vT() const { return (bf16_t*)(ws + OFF_ZE) + (size_t)T_ * 2048; }
    __device__ __forceinline__ bf16_t* ys() const { return (bf16_t*)(ws + OFF_ZE); }
    __device__ __forceinline__ bf16_t* qc() const { return (bf16_t*)(ws + OFF_QC); }
    __device__ __forceinline__ bf16_t* osc() const { return (bf16_t*)(ws + OFF_OSC); }
    __device__ __forceinline__ bf16_t* hdn() const { return (bf16_t*)(ws + OFF_OSC); }
    __device__ __forceinline__ bf16_t* mix() const { return (bf16_t*)(ws + OFF_MIX); }
    __device__ __forceinline__ float* gts() const { return (float*)(ws + OFF_GTS); }
    __device__ __forceinline__ float* aff() const { return (float*)(ws + OFF_AFF); }
    __device__ __forceinline__ float* gate() const { return (float*)(ws + OFF_GATE); }
    __device__ __forceinline__ int* idx() const { return (int*)(ws + OFF_IDX); }
    __device__ __forceinline__ int* sel() const { return (int*)(ws + OFF_SEL); }
    __device__ __forceinline__ float* costab() const { return (float*)(ws + OFF_COS); }
    __device__ __forceinline__ float* sintab() const { return (float*)(ws + OFF_SIN); }
    __device__ __forceinline__ unsigned char* rtw() const { return ws + OFF_RTW; }
};

__device__ __forceinline__ void conv_desc(const P& p, int rt, const float*& src_base, size_t& le_off, int& ld, bf16_t*& dst, int& kind, int& n0) {
    le_off = 0;
    if (rt < 2048) { const int le = rt >> 5, t = rt & 31; kind = 1; ld = 1024; src_base = p.w_gate; le_off = (size_t)le * 1024 * 1024; dst = p.Wgu() + (size_t)le * 2048 * 1024; n0 = t * 64; return; }
    rt -= 2048;
    if (rt < 1024) { const int le = rt >> 4, t = rt & 15; kind = 3; ld = 1024; src_base = p.w_down + (size_t)le * 1024 * 1024; dst = p.Wd() + (size_t)le * 1024 * 1024; n0 = t * 64; return; }
    rt -= 1024;
    if (rt < 128) { const int j = rt >> 6, t = rt & 63; kind = 2; ld = EVEN_IN; src_base = p.e_win + (size_t)j * 1024 * EVEN_IN; dst = p.WinE() + (size_t)j * 4096 * 1024; n0 = t * 64; return; }
    rt -= 128;
    if (rt < 96) { const int j = rt / 48, t = rt % 48; kind = (t < 32) ? 3 : 0; ld = ODD_IN; src_base = p.o_win + (size_t)j * 1024 * ODD_IN; dst = p.WinO() + (size_t)j * 3072 * 1024; n0 = t * 64; return; }
    rt -= 96;
    if (rt < 32) { const int j = rt >> 4, t = rt & 15; kind = 3; ld = 1024; src_base = p.e_wout + (size_t)j * 1024 * 1024; dst = p.WoutE() + (size_t)j * 1024 * 1024; n0 = t * 64; return; }
    rt -= 32;
    { const int j = rt >> 4, t = rt & 15; kind = 3; ld = 1024; src_base = p.o_wout + (size_t)j * 1024 * 1024; dst = p.WoutO() + (size_t)j * 1024 * 1024; n0 = t * 64; return; }
}
#define N_CONV_ROWTILES 3360
struct ConvTile { bf16_t* dst; int n0, k0; };
__device__ __forceinline__ void conv_load(const P& p, int rt, int kt, int tid, float4 (&cv)[4], ConvTile& ct) {
    const int tn4 = tid & 15, tk = tid >> 4, k0 = kt * 64;
    const float* src_base; size_t le_off; int ld, kind, n0; bf16_t* dst;
    conv_desc(p, rt, src_base, le_off, ld, dst, kind, n0);
    const int n = n0 + tn4 * 4;
    const float* sp;
    if (kind == 0) sp = src_base + n;
    else if (kind == 3) {
        const int r = n & 31, nn = r >> 4, i = r & 15;
        sp = src_base + (n & ~31) + 8 * (i >> 2) + 4 * nn + (i & 3);
    }
    else if (kind == 1) {
        const int tn = n >> 7, r = n & 127, wc = r >> 6, nn = (r >> 4) & 3, i = r & 15;
        const int col = 64 * tn + 32 * wc + 8 * (i >> 2) + 4 * (nn & 1) + (i & 3);
        sp = ((nn < 2) ? p.w_gate : p.w_up) + le_off + col;
    } else {
        const int seg = n >> 9, j = n & 511;
        const int base = seg < 4 ? seg * 512 : 2064 + (seg - 4) * 512;
        int col;
        if (seg == 4 || seg == 5) {
            const int head = j >> 7, r = j & 127, wc = r >> 6, nn = (r >> 4) & 3, i = r & 15;
            col = head * 128 + (nn & 1) * 64 + 32 * wc + 8 * (i >> 2) + 4 * (nn >> 1) + (i & 3);
        } else {
            const int r = j & 31, nn = r >> 4, i = r & 15;
            col = (j & ~31) + 8 * (i >> 2) + 4 * nn + (i & 3);
        }
        sp = src_base + base + col;
    }
#pragma unroll
    for (int i = 0; i < 4; ++i) cv[i] = ldnt_f4(sp + (size_t)(k0 + tk + 16 * i) * ld);
    ct.dst = dst; ct.n0 = n0; ct.k0 = k0;
}
__device__ __forceinline__ void conv_lds(float* tile, const float4 (&cv)[4], int tid) {
    const int tn4 = tid & 15, tk = tid >> 4;
#pragma unroll
    for (int i = 0; i < 4; ++i) {
        const int kk = tk + 16 * i;
        tile[(tn4 * 4 + 0) * 65 + kk] = cv[i].x; tile[(tn4 * 4 + 1) * 65 + kk] = cv[i].y; tile[(tn4 * 4 + 2) * 65 + kk] = cv[i].z; tile[(tn4 * 4 + 3) * 65 + kk] = cv[i].w;
    }
}
__device__ __forceinline__ void conv_store(const float* tile, const ConvTile& ct, int tid) {
    const int row = tid >> 2, sg = tid & 3;
    const float* tr = tile + row * 65 + sg * 16;
    u32x4 w0, w1;
    w0.x = pk2(tr[0], tr[1]); w0.y = pk2(tr[2], tr[3]); w0.z = pk2(tr[4], tr[5]); w0.w = pk2(tr[6], tr[7]);
    w1.x = pk2(tr[8], tr[9]); w1.y = pk2(tr[10], tr[11]); w1.z = pk2(tr[12], tr[13]); w1.w = pk2(tr[14], tr[15]);
    bf16_t* dp = ct.dst + (size_t)(ct.n0 + row) * 1024 + ct.k0 + sg * 16;
    stnt_u4(dp, w0); stnt_u4(dp + 8, w1);
}
#define DEF_PER_LAYER 12288
#define DEF_PER_SCAN (33 * 512)
#define DEF_TOTAL (3 * DEF_PER_LAYER)
__device__ __forceinline__ void deferred_tile(int q, int& rt, int& kt) {
    const int layer = 1 + q / DEF_PER_LAYER, r = q % DEF_PER_LAYER, rtl = r >> 4;
    kt = r & 15;
    rt = (rtl < 512) ? (512 * layer + rtl) : (2048 + 256 * layer + (rtl - 512));
}
__device__ __forceinline__ void deferred_load(const P& p, int q, int tid, float4 (&cv)[4], ConvTile& ct) {
    const int tn4 = tid & 15, tk = tid >> 4;
    const int layer = 1 + q / DEF_PER_LAYER, r = q - (layer - 1) * DEF_PER_LAYER, rtl = r >> 4, k0 = (r & 15) * 64;
    const float* sp; bf16_t* dst; int n0;
    if (rtl < 512) {
        const int le = layer * 16 + (rtl >> 5); n0 = (rtl & 31) * 64;
        const int n = n0 + tn4 * 4, tn = n >> 7, rr = n & 127, wc = rr >> 6, nn = (rr >> 4) & 3, i = rr & 15;
        const int col = 64 * tn + 32 * wc + 8 * (i >> 2) + 4 * (nn & 1) + (i & 3);
        sp = ((nn < 2) ? p.w_gate : p.w_up) + (size_t)le * 1024 * 1024 + col;
        dst = p.Wgu() + (size_t)le * 2048 * 1024;
    } else {
        const int rd = rtl - 512, le = layer * 16 + (rd >> 4); n0 = (rd & 15) * 64;
        const int n = n0 + tn4 * 4, r2 = n & 31, nn = r2 >> 4, i = r2 & 15;
        sp = p.w_down + (size_t)le * 1024 * 1024 + (n & ~31) + 8 * (i >> 2) + 4 * nn + (i & 3);
        dst = p.Wd() + (size_t)le * 1024 * 1024;
    }
#pragma unroll
    for (int i = 0; i < 4; ++i) cv[i] = ldnt_f4(sp + (size_t)(k0 + tk + 16 * i) * 1024);
    ct.dst = dst; ct.n0 = n0; ct.k0 = k0;
}
#define P0_RTS (512 + 256 + 288)
#define P0_TILES (P0_RTS * 16)
#define TOPK_TILES ((DEF_TOTAL - 2 * DEF_PER_SCAN) / 3)
__device__ __forceinline__ void phase_convert(const P& p, unsigned char* lds, int bid, int nb) {
    float* tile = (float*)lds;
    const int tid = opaque_tid();
    float4 c0[4], c1[4], c2[4]; ConvTile t0, t1, t2; bool v0, v1, v2;
    auto request = [&](int it, float4 (&cv)[4], ConvTile& ct, bool& valid) {
        valid = it < P0_TILES;
        if (valid) {
            int rt, kt;
            { const int r = it >> 4; kt = it & 15; rt = r < 512 ? r : (r < 768 ? 2048 + (r - 512) : 3072 + (r - 768)); }
            conv_load(p, rt, kt, tid, cv, ct);
        }
    };
    auto finish = [&](const float4 (&cv)[4], const ConvTile& ct, bool valid) {
        if (valid) {
            __syncthreads();
            conv_lds(tile, cv, tid);
            __syncthreads();
            conv_store(tile, ct, tid);
        }
    };
    int it = bid;
    request(it, c0, t0, v0); request(it + nb, c1, t1, v1);
    while (v0) {
        request(it + 2 * nb, c2, t2, v2); finish(c0, t0, v0);
        request(it + 3 * nb, c0, t0, v0); finish(c1, t1, v1);
        request(it + 4 * nb, c1, t1, v1); finish(c2, t2, v2);
        it += 3 * nb;
    }
}

struct TileAddr { const char* ab; const char* bb; unsigned ao[6]; unsigned bo; };
struct Prefetch { bool have; TileAddr t; float r0, r1; };
typedef __attribute__((address_space(3))) unsigned LdsU;
typedef const __attribute__((address_space(1))) unsigned GlbU;
__device__ __forceinline__ unsigned gemm_chunk_off(int tid) { return (unsigned)(((tid & 7) ^ ((tid >> 4) & 7)) * 16); }
#define GLDS_STEP(voff, sbase) "s_nop 0\n\tglobal_load_lds_dwordx4 " voff ", " sbase "\n\ts_add_u32 m0, m0, 0x1000\n\t"
template <int MT>
__device__ __forceinline__ void gemm_stage(const TileAddr& t, unsigned char* lds, int st, int ko, int tid) {
    constexpr int ABYTES = 4096 * MT, SBYTES = ABYTES + 16384;
    const char* a_ = t.ab + ko * 2;
    const char* b0 = t.bb + ko * 2; const char* b1 = b0 + 65536; const char* b2 = b0 + 131072; const char* b3 = b0 + 196608;
    const int wfirst = __builtin_amdgcn_readfirstlane(tid) & ~63;
    const unsigned ld0 = (unsigned)(size_t)(lds + st * SBYTES + wfirst * 16);
    unsigned keep;
    if (MT == 6) {
        asm volatile("s_nop 4\n\ts_mov_b32 %[keep], m0\n\ts_mov_b32 m0, %[ld]\n\t"
                     GLDS_STEP("%[a0]", "%[ab]") GLDS_STEP("%[a1]", "%[ab]") GLDS_STEP("%[a2]", "%[ab]") GLDS_STEP("%[a3]", "%[ab]") GLDS_STEP("%[a4]", "%[ab]") GLDS_STEP("%[a5]", "%[ab]")
                     GLDS_STEP("%[bo]", "%[b0]") GLDS_STEP("%[bo]", "%[b1]") GLDS_STEP("%[bo]", "%[b2]") GLDS_STEP("%[bo]", "%[b3]")
                     "s_mov_b32 m0, %[keep]"
                     : [keep] "=&s"(keep)
                     : [ld] "s"(ld0), [ab] "s"(a_), [b0] "s"(b0), [b1] "s"(b1), [b2] "s"(b2), [b3] "s"(b3),
                       [a0] "v"(t.ao[0]), [a1] "v"(t.ao[1]), [a2] "v"(t.ao[2]), [a3] "v"(t.ao[3]), [a4] "v"(t.ao[4]), [a5] "v"(t.ao[5]), [bo] "v"(t.bo)
                     : "memory", "scc");
    } else if (MT == 4) {
        asm volatile("s_nop 4\n\ts_mov_b32 %[keep], m0\n\ts_mov_b32 m0, %[ld]\n\t"
                     GLDS_STEP("%[a0]", "%[ab]") GLDS_STEP("%[a1]", "%[ab]") GLDS_STEP("%[a2]", "%[ab]") GLDS_STEP("%[a3]", "%[ab]")
                     GLDS_STEP("%[bo]", "%[b0]") GLDS_STEP("%[bo]", "%[b1]") GLDS_STEP("%[bo]", "%[b2]") GLDS_STEP("%[bo]", "%[b3]")
                     "s_mov_b32 m0, %[keep]"
                     : [keep] "=&s"(keep)
                     : [ld] "s"(ld0), [ab] "s"(a_), [b0] "s"(b0), [b1] "s"(b1), [b2] "s"(b2), [b3] "s"(b3),
                       [a0] "v"(t.ao[0]), [a1] "v"(t.ao[1]), [a2] "v"(t.ao[2]), [a3] "v"(t.ao[3]), [bo] "v"(t.bo)
                     : "memory", "scc");
    } else {
        asm volatile("s_nop 4\n\ts_mov_b32 %[keep], m0\n\ts_mov_b32 m0, %[ld]\n\t"
                     GLDS_STEP("%[a0]", "%[ab]")
                     GLDS_STEP("%[bo]", "%[b0]") GLDS_STEP("%[bo]", "%[b1]") GLDS_STEP("%[bo]", "%[b2]") GLDS_STEP("%[bo]", "%[b3]")
                     "s_mov_b32 m0, %[keep]"
                     : [keep] "=&s"(keep)
                     : [ld] "s"(ld0), [ab] "s"(a_), [b0] "s"(b0), [b1] "s"(b1), [b2] "s"(b2), [b3] "s"(b3), [a0] "v"(t.ao[0]), [bo] "v"(t.bo)
                     : "memory", "scc");
    }
}
#define GT_DMA_WAIT() asm volatile("s_waitcnt vmcnt(0)" ::: "memory")
__device__ __forceinline__ const char* uni_ptr(const void* q) {
    const unsigned long long v = (unsigned long long)q;
    const unsigned lo = (unsigned)__builtin_amdgcn_readfirstlane((int)(unsigned)v), hi = (unsigned)__builtin_amdgcn_readfirstlane((int)(unsigned)(v >> 32));
    return (const char*)(((unsigned long long)hi << 32) | lo);
}
template <int MT>
__device__ __forceinline__ void rv_load(const float* tab, int rbase, int rmax, int fr, int fq, float& r0, float& r1) {
    const char* base = uni_ptr(tab);
    const unsigned o0 = (unsigned)min(rbase + 16 * fq + fr, rmax) * 4u, o1 = (unsigned)min(rbase + 16 * (fq + 4) + fr, rmax) * 4u;
    asm volatile("s_nop 4\n\tglobal_load_dword %0, %2, %4\n\tglobal_load_dword %1, %3, %4" : "=&v"(r0), "=&v"(r1) : "v"(o0), "v"(o1), "s"(base));
}
#define RV_PIN(r0, r1) asm volatile("" : "+v"(r0), "+v"(r1))
#define RV_DONE(r0, r1) asm volatile("s_waitcnt vmcnt(0)" : "+v"(r0), "+v"(r1) :: "memory")
__device__ __forceinline__ float rv_get(float r0, float r1, int m, int fr) { return __shfl(m < 4 ? r0 : r1, fr + 16 * (m & 3)); }
struct NoHook { __device__ __forceinline__ void operator()() const {} };
template <typename T> struct hook_is_none { static constexpr bool value = false; };
template <> struct hook_is_none<NoHook> { static constexpr bool value = true; };
template <bool SWAP, int MT, typename Hook = NoHook>
__device__ __forceinline__ void gemm_tile(const TileAddr& t, unsigned char* lds, f32x4 (&acc)[MT][4], int tid, bool prestaged = false, const TileAddr* next = nullptr, Hook hook = Hook()) {
    constexpr int K = 1024, ABYTES = 4096 * MT, SBYTES = ABYTES + 16384;
    const int lane = tid & 63, wid = tid >> 6, wr = wid >> 1, wc = wid & 1, fr = lane & 15, fq = lane >> 4;
    const int sw = (fr >> 1) & 7;
    const int aofs = (wr * 16 * MT + fr) * 128, bofs = ABYTES + (wc * 64 + fr) * 128;
    const int c0 = ((0 + fq) ^ sw) << 4, c1 = ((4 + fq) ^ sw) << 4;
#pragma unroll
    for (int m = 0; m < MT; ++m)
#pragma unroll
        for (int n = 0; n < 4; ++n) acc[m][n] = (f32x4){0.f, 0.f, 0.f, 0.f};
#define GT_READ(st) const unsigned char* sA = lds + (st) * SBYTES + aofs; const unsigned char* sB = lds + (st) * SBYTES + bofs; \
        bf16x8 af0[MT], bf0[4], af1[MT], bf1[4]; \
        _Pragma("unroll") for (int n = 0; n < 4; ++n) bf0[n] = *(const bf16x8*)(sB + n * 2048 + c0); \
        _Pragma("unroll") for (int m = 0; m < MT; ++m) af0[m] = *(const bf16x8*)(sA + m * 2048 + c0); \
        _Pragma("unroll") for (int n = 0; n < 4; ++n) bf1[n] = *(const bf16x8*)(sB + n * 2048 + c1); \
        _Pragma("unroll") for (int m = 0; m < MT; ++m) af1[m] = *(const bf16x8*)(sA + m * 2048 + c1);
#define GT_MMA() __builtin_amdgcn_s_setprio(1); \
        _Pragma("unroll") for (int m = 0; m < MT; ++m) _Pragma("unroll") for (int n = 0; n < 4; ++n) { \
            if (SWAP) acc[m][n] = __builtin_amdgcn_mfma_f32_16x16x32_bf16(af0[m], bf0[n], acc[m][n], 0, 0, 0); \
            else      acc[m][n] = __builtin_amdgcn_mfma_f32_16x16x32_bf16(bf0[n], af0[m], acc[m][n], 0, 0, 0); } \
        _Pragma("unroll") for (int m = 0; m < MT; ++m) _Pragma("unroll") for (int n = 0; n < 4; ++n) { \
            if (SWAP) acc[m][n] = __builtin_amdgcn_mfma_f32_16x16x32_bf16(af1[m], bf1[n], acc[m][n], 0, 0, 0); \
            else      acc[m][n] = __builtin_amdgcn_mfma_f32_16x16x32_bf16(bf1[n], af1[m], acc[m][n], 0, 0, 0); } \
        __builtin_amdgcn_s_setprio(0);
    constexpr int nk = K >> 6;
    if (!prestaged) gemm_stage<MT>(t, lds, 0, 0, tid);
    GT_DMA_WAIT(); __syncthreads();
#pragma unroll 1
    for (int kt = 0; kt < nk - 2; kt += 2) {
        { GT_READ(0) gemm_stage<MT>(t, lds, 1, (kt + 1) * 64, tid); GT_MMA() }
        GT_DMA_WAIT(); __syncthreads();
        { GT_READ(1) gemm_stage<MT>(t, lds, 0, (kt + 2) * 64, tid); GT_MMA() }
        GT_DMA_WAIT(); __syncthreads();
    }
    { GT_READ(0) gemm_stage<MT>(t, lds, 1, (nk - 1) * 64, tid); GT_MMA() }
    GT_DMA_WAIT(); __syncthreads();
    { GT_READ(1) GT_MMA() }
    __syncthreads();
    if (!hook_is_none<Hook>::value) { __builtin_amdgcn_sched_barrier(0); hook(); __builtin_amdgcn_sched_barrier(0); }
    if (next) gemm_stage<MT>(*next, lds, 0, 0, tid);
#undef GT_READ
#undef GT_MMA
}
template <int MT>
__device__ __forceinline__ void tile_addr_rows(TileAddr& t, const bf16_t* A, int row0, const bf16_t* W, int nt, int tid) {
    const int lrow = tid >> 3; const unsigned ch = gemm_chunk_off(tid);
    t.ab = (const char*)A; t.bb = (const char*)W; t.bo = (unsigned)(nt * 128 + lrow) * 2048u + ch;
#pragma unroll
    for (int i = 0; i < MT; ++i) t.ao[i] = (unsigned)(row0 + lrow + 32 * i) * 2048u + ch;
}

__device__ __forceinline__ void rows_swap16(float x, float& a, float& b) { const auto r = __builtin_amdgcn_permlane16_swap(__builtin_bit_cast(unsigned, x), __builtin_bit_cast(unsigned, x), false, false); const unsigned ua = r[0], ub = r[1]; a = __builtin_bit_cast(float, ua); b = __builtin_bit_cast(float, ub); }
__device__ __forceinline__ void rows_swap32(float x, float& a, float& b) { const auto r = __builtin_amdgcn_permlane32_swap(__builtin_bit_cast(unsigned, x), __builtin_bit_cast(unsigned, x), false, false); const unsigned ua = r[0], ub = r[1]; a = __builtin_bit_cast(float, ua); b = __builtin_bit_cast(float, ub); }
__device__ __forceinline__ float row_bcast_w(float x, int w) {
    float a, b; rows_swap16(x, a, b);
    const float y = (w & 1) ? b : a;
    float c, d; rows_swap32(y, c, d);
    return (w & 2) ? d : c;
}
__device__ __forceinline__ u32x4 widen_pair(u32x2 a, u32x2 b) {
    const auto rx = __builtin_amdgcn_permlane16_swap(a.x, b.x, false, false); const unsigned ax = rx[0], bx = rx[1];
    const auto ry = __builtin_amdgcn_permlane16_swap(a.y, b.y, false, false); const unsigned ay = ry[0], by = ry[1];
    return (u32x4){ax, ay, bx, by};
}
__device__ __forceinline__ float rows_sum(float x) { float a, b; rows_swap16(x, a, b); x = a + b; rows_swap32(x, a, b); return a + b; }
__device__ __forceinline__ float rows_max(float x) { float a, b; rows_swap16(x, a, b); x = fmaxf(a, b); rows_swap32(x, a, b); return fmaxf(a, b); }

struct Row16 { float v[2][8]; };
__device__ __forceinline__ void ld_bf8(const bf16_t* q, float (&d)[8]) {
    const u32x4 w = *(const u32x4*)q;
    d[0] = bflo(w.x); d[1] = bfhi(w.x); d[2] = bflo(w.y); d[3] = bfhi(w.y); d[4] = bflo(w.z); d[5] = bfhi(w.z); d[6] = bflo(w.w); d[7] = bfhi(w.w);
}
__device__ __forceinline__ void st_bf8(bf16_t* q, const float (&d)[8]) {
    u32x4 w; w.x = pk2(d[0], d[1]); w.y = pk2(d[2], d[3]); w.z = pk2(d[4], d[5]); w.w = pk2(d[6], d[7]); *(u32x4*)q = w;
}
__device__ __forceinline__ void ld_f8(const float* q, float (&d)[8]) {
    const float4 a = *(const float4*)q, b = *(const float4*)(q + 4);
    d[0] = a.x; d[1] = a.y; d[2] = a.z; d[3] = a.w; d[4] = b.x; d[5] = b.y; d[6] = b.z; d[7] = b.w;
}
__device__ __forceinline__ void ld_row_bf(const bf16_t* row, int lane, Row16& r) { ld_bf8(row + 8 * lane, r.v[0]); ld_bf8(row + 512 + 8 * lane, r.v[1]); }
__device__ __forceinline__ float row_sumsq(const Row16& r) {
    float s = 0.f;
#pragma unroll
    for (int i = 0; i < 2; ++i)
#pragma unroll
        for (int c = 0; c < 8; ++c) s += r.v[i][c] * r.v[i][c];
    return s;
}
__device__ __forceinline__ void stage_proj16(unsigned char* lds, const float* W, int ldw, const float* g, int tid) {
#pragma unroll
    for (int r = 0; r < 4; ++r) {
        const int k = tid + 256 * r;
        const int i = k >> 9, ln = (k >> 3) & 63, c = k & 7;
        const int rho = 64 * (8 * i + c) + ln;
        const float gk = g[k];
        const float4* wp = (const float4*)(W + (size_t)k * ldw);
#pragma unroll
        for (int ch = 0; ch < 4; ++ch) {
            float4 w = wp[ch]; w.x *= gk; w.y *= gk; w.z *= gk; w.w *= gk;
            *(float4*)(lds + rho * 64 + ((ch ^ ((rho >> 2) & 3)) << 4)) = w;
        }
    }
}
__device__ __forceinline__ void proj16_accum(const unsigned char* lds, const Row16& h, int lane, float (&acc)[16]) {
#pragma unroll
    for (int e = 0; e < 16; ++e) acc[e] = 0.f;
#pragma unroll
    for (int i = 0; i < 2; ++i) {
#pragma unroll
        for (int c = 0; c < 8; ++c) {
            const int rho = 64 * (8 * i + c) + lane;
            const unsigned char* rp = lds + rho * 64;
            const int sw = (rho >> 2) & 3;
#pragma unroll
            for (int ch = 0; ch < 4; ++ch) {
                const float4 w = *(const float4*)(rp + ((ch ^ sw) << 4));
                const f32pair_t hh = {h.v[i][c], h.v[i][c]};
                f32pair_t a01 = {acc[ch * 4 + 0], acc[ch * 4 + 1]}, a23 = {acc[ch * 4 + 2], acc[ch * 4 + 3]};
                a01 = __builtin_elementwise_fma(hh, (f32pair_t){w.x, w.y}, a01); a23 = __builtin_elementwise_fma(hh, (f32pair_t){w.z, w.w}, a23);
                acc[ch * 4 + 0] = a01[0]; acc[ch * 4 + 1] = a01[1]; acc[ch * 4 + 2] = a23[0]; acc[ch * 4 + 3] = a23[1];
            }
            if (c == 3) __builtin_amdgcn_sched_barrier(0);
        }
        __builtin_amdgcn_sched_barrier(0);
    }
}
__device__ __forceinline__ void proj16_accum2(const unsigned char* lds, const Row16& ha, const Row16& hb, int lane, float (&acca)[16], float (&accb)[16]) {
#pragma unroll
    for (int e = 0; e < 16; ++e) { acca[e] = 0.f; accb[e] = 0.f; }
#pragma unroll
    for (int i = 0; i < 2; ++i) {
#pragma unroll
        for (int c = 0; c < 8; ++c) {
            const int rho = 64 * (8 * i + c) + lane;
            const unsigned char* rp = lds + rho * 64;
            const int sw = (rho >> 2) & 3;
#pragma unroll
            for (int ch = 0; ch < 4; ++ch) {
                const float4 w = *(const float4*)(rp + ((ch ^ sw) << 4));
                acca[ch * 4 + 0] += ha.v[i][c] * w.x; acca[ch * 4 + 1] += ha.v[i][c] * w.y; acca[ch * 4 + 2] += ha.v[i][c] * w.z; acca[ch * 4 + 3] += ha.v[i][c] * w.w;
                accb[ch * 4 + 0] += hb.v[i][c] * w.x; accb[ch * 4 + 1] += hb.v[i][c] * w.y; accb[ch * 4 + 2] += hb.v[i][c] * w.z; accb[ch * 4 + 3] += hb.v[i][c] * w.w;
            }
            if (c == 3) __builtin_amdgcn_sched_barrier(0);
        }
        __builtin_amdgcn_sched_barrier(0);
    }
}
__device__ __forceinline__ int e_of_lane(int lane) { return ((lane >> 5) & 1) * 8 + ((lane >> 4) & 1) * 4 + ((lane >> 3) & 1) * 2 + ((lane >> 2) & 1); }
__device__ __forceinline__ float reduce_scatter16(const float (&a)[16], int lane) {
    float b8[8], b4[4], b2[2];
#pragma unroll
    for (int e = 0; e < 8; ++e) {
        const auto r = __builtin_amdgcn_permlane32_swap(__builtin_bit_cast(unsigned, a[e]), __builtin_bit_cast(unsigned, a[e + 8]), false, false);
        const unsigned ux = r[0], uy = r[1]; b8[e] = __builtin_bit_cast(float, ux) + __builtin_bit_cast(float, uy);
    }
#pragma unroll
    for (int e = 0; e < 4; ++e) {
        const auto r = __builtin_amdgcn_permlane16_swap(__builtin_bit_cast(unsigned, b8[e]), __builtin_bit_cast(unsigned, b8[e + 4]), false, false);
        const unsigned ux = r[0], uy = r[1]; b4[e] = __builtin_bit_cast(float, ux) + __builtin_bit_cast(float, uy);
    }
    { const bool up = (lane & 8) != 0;
#pragma unroll
      for (int e = 0; e < 2; ++e) { const float keep = up ? b4[e + 2] : b4[e], send = up ? b4[e] : b4[e + 2]; b2[e] = keep + __shfl_xor(send, 8); } }
    float b1;
    { const bool up = (lane & 4) != 0; const float keep = up ? b2[1] : b2[0], send = up ? b2[0] : b2[1]; b1 = keep + __shfl_xor(send, 4); }
    b1 += __shfl_xor(b1, 2); b1 += __shfl_xor(b1, 1);
    return b1;
}
__device__ __forceinline__ float4 ld_bf4(const bf16_t* q) { const u32x2 w = *(const u32x2*)q; return make_float4(bflo(w.x), bfhi(w.x), bflo(w.y), bfhi(w.y)); }
__device__ __forceinline__ void st_bf4(bf16_t* q, float4 v) { u32x2 w; w.x = pk2(v.x, v.y); w.y = pk2(v.z, v.w); *(u32x2*)q = w; }
#define DPP_F(x, ctrl, rmask, oldv) __builtin_bit_cast(float, __builtin_amdgcn_update_dpp(__builtin_bit_cast(int, (float)(oldv)), __builtin_bit_cast(int, (x)), (ctrl), (rmask), 0xf, false))
__device__ __forceinline__ float wave_sum(float v) {
    v += DPP_F(v, 0x111, 0xf, 0.f); v += DPP_F(v, 0x112, 0xf, 0.f); v += DPP_F(v, 0x114, 0xf, 0.f); v += DPP_F(v, 0x118, 0xf, 0.f);
    v += DPP_F(v, 0x142, 0xa, 0.f);
    v += DPP_F(v, 0x143, 0xc, 0.f);
    return __builtin_bit_cast(float, __builtin_amdgcn_readlane(__builtin_bit_cast(int, v), 63));
}
__device__ __forceinline__ float wave_prefix_sum(float v) {
    v += DPP_F(v, 0x111, 0xf, 0.f); v += DPP_F(v, 0x112, 0xf, 0.f); v += DPP_F(v, 0x114, 0xf, 0.f); v += DPP_F(v, 0x118, 0xf, 0.f);
    v += DPP_F(v, 0x142, 0xa, 0.f);
    v += DPP_F(v, 0x143, 0xc, 0.f);
    return v;
}
__device__ __forceinline__ float wave_prefix_max(float v) {
    const float ninf = -3.0e38f;
    v = fmaxf(v, DPP_F(v, 0x111, 0xf, ninf)); v = fmaxf(v, DPP_F(v, 0x112, 0xf, ninf)); v = fmaxf(v, DPP_F(v, 0x114, 0xf, ninf)); v = fmaxf(v, DPP_F(v, 0x118, 0xf, ninf));
    v = fmaxf(v, DPP_F(v, 0x142, 0xa, ninf));
    v = fmaxf(v, DPP_F(v, 0x143, 0xc, ninf));
    return v;
}
__device__ __forceinline__ float lane_bcast(float v, int l) { return __builtin_bit_cast(float, __builtin_amdgcn_readlane(__builtin_bit_cast(int, v), l)); }
__device__ __forceinline__ float wave_max(float v) {
    const float ninf = -3.0e38f;
    v = fmaxf(v, DPP_F(v, 0x111, 0xf, ninf)); v = fmaxf(v, DPP_F(v, 0x112, 0xf, ninf)); v = fmaxf(v, DPP_F(v, 0x114, 0xf, ninf)); v = fmaxf(v, DPP_F(v, 0x118, 0xf, ninf));
    v = fmaxf(v, DPP_F(v, 0x142, 0xa, ninf));
    v = fmaxf(v, DPP_F(v, 0x143, 0xc, ninf));
    return __builtin_bit_cast(float, __builtin_amdgcn_readlane(__builtin_bit_cast(int, v), 63));
}

#define RT_LO 32768
#define RT_G 65536
typedef __attribute__((ext_vector_type(2))) __bf16 bf16x2_t;
__device__ __forceinline__ float dot2_self(unsigned w, float acc) {
    return __builtin_amdgcn_fdot2_f32_bf16(__builtin_bit_cast(bf16x2_t, w), __builtin_bit_cast(bf16x2_t, w), acc, false);
}
__device__ __forceinline__ const char* router_uni(const void* q) {
    const unsigned long long v = (unsigned long long)q;
    const unsigned lo = (unsigned)__builtin_amdgcn_readfirstlane((int)(unsigned)v), hi = (unsigned)__builtin_amdgcn_readfirstlane((int)(unsigned)(v >> 32));
    return (const char*)(((unsigned long long)hi << 32) | lo);
}
__device__ __forceinline__ void router_dma16(unsigned voff, const char* sbase, unsigned ldsaddr) {
    unsigned keep;
    asm volatile("s_nop 4\n\ts_mov_b32 %0, m0\n\ts_mov_b32 m0, %2\n\ts_nop 0\n\tglobal_load_lds_dwordx4 %1, %3\n\ts_mov_b32 m0, %0"
                 : "=&s"(keep) : "v"(voff), "s"(ldsaddr), "s"(sbase) : "memory");
}
__device__ __forceinline__ void router_frags(const P& p, int bid, int nb) {
    for (int idx = bid * NTHR + opaque_tid(); idx < 4 * 2048; idx += nb * NTHR) {
        const int layer = idx >> 11, pi = idx & 2047, s = pi >> 6, fl = pi & 63, lq = fl >> 4, e = fl & 15, k0 = 32 * s + 8 * lq;
        const float* g = p.ffn_g + layer * D_;
        const float* wr = p.router_w + (size_t)layer * D_ * 16;
        unsigned hi[4], lo[4];
#pragma unroll
        for (int jp = 0; jp < 4; ++jp) {
            const float w0 = g[k0 + 2 * jp] * wr[(size_t)(k0 + 2 * jp) * 16 + e], w1 = g[k0 + 2 * jp + 1] * wr[(size_t)(k0 + 2 * jp + 1) * 16 + e];
            const unsigned hw = pk2(w0, w1);
            hi[jp] = hw; lo[jp] = pk2(w0 - bflo(hw), w1 - bfhi(hw));
        }
        unsigned char* dst = p.rtw() + (size_t)layer * 65536 + (s * 64 + fl) * 16;
        *(u32x4*)dst = (u32x4){hi[0], hi[1], hi[2], hi[3]};
        *(u32x4*)(dst + RT_LO) = (u32x4){lo[0], lo[1], lo[2], lo[3]};
    }
}
__device__ __forceinline__ void phase_router(const P& p, int layer, unsigned char* lds, int bid, int nb) {
    const int tid = opaque_tid(), lane = tid & 63, wid = tid >> 6, r = lane & 15, q = lane >> 4;
    const float* g = p.ffn_g + layer * D_;
    constexpr int NT = T_ / 16;
#if PROBE_ROUTER
    for (int rep = 0; rep < 2; ++rep) {
#endif
    int tile = bid + nb * wid;
    u32x4 hv[32];
    auto load_tile = [&](int tl) {
        const bf16_t* hp = p.h() + (size_t)(tl * 16 + r) * D_ + 8 * q;
#pragma unroll
        for (int s = 0; s < 32; ++s) hv[s] = *(const u32x4*)(hp + 32 * s);
    };
    if (tile < NT) load_tile(tile);
    __syncthreads();
    {
        const char* fb = router_uni(p.rtw() + (size_t)layer * 65536);
        const char* gb = router_uni(g);
        const unsigned lb = (unsigned)(size_t)lds, w_ = (unsigned)__builtin_amdgcn_readfirstlane(wid);
        for (unsigned j = w_; j < 64; j += 4) router_dma16(j * 1024 + lane * 16, fb, lb + j * 1024);
        router_dma16(w_ * 1024 + lane * 16, gb, lb + RT_G + w_ * 1024);
        asm volatile("s_waitcnt vmcnt(0)" ::: "memory");
    }
    __syncthreads();
#pragma unroll 1
    while (tile < NT) {
        const int token = tile * 16 + r;
        float ss0 = 0.f, ss1 = 0.f;
#pragma unroll
        for (int s = 0; s < 32; ++s) {
            const u32x4 w = hv[s];
            ss0 = dot2_self(w.x, ss0); ss1 = dot2_self(w.y, ss1); ss0 = dot2_self(w.z, ss0); ss1 = dot2_self(w.w, ss1);
        }
        float ss = ss0 + ss1;
        ss = rows_sum(ss);
        const float rinv = frsq(ss * (1.f / D_) + 1e-6f);
        f32x4 a0 = (f32x4){0.f, 0.f, 0.f, 0.f}, a1 = a0, a2 = a0, a3 = a0;
        bf16_t* up = p.u() + (size_t)token * D_ + 8 * q;
#pragma unroll
        for (int s = 0; s < 32; s += 2) {
            const bf16x8 wh0 = *(const bf16x8*)(lds + (s * 64 + lane) * 16), wl0 = *(const bf16x8*)(lds + RT_LO + (s * 64 + lane) * 16);
            const bf16x8 wh1 = *(const bf16x8*)(lds + ((s + 1) * 64 + lane) * 16), wl1 = *(const bf16x8*)(lds + RT_LO + ((s + 1) * 64 + lane) * 16);
            a0 = __builtin_amdgcn_mfma_f32_16x16x32_bf16(wh0, __builtin_bit_cast(bf16x8, hv[s]), a0, 0, 0, 0);
            a1 = __builtin_amdgcn_mfma_f32_16x16x32_bf16(wl0, __builtin_bit_cast(bf16x8, hv[s]), a1, 0, 0, 0);
            a2 = __builtin_amdgcn_mfma_f32_16x16x32_bf16(wh1, __builtin_bit_cast(bf16x8, hv[s + 1]), a2, 0, 0, 0);
            a3 = __builtin_amdgcn_mfma_f32_16x16x32_bf16(wl1, __builtin_bit_cast(bf16x8, hv[s + 1]), a3, 0, 0, 0);
#pragma unroll
            for (int s2 = s; s2 < s + 2; ++s2) {
                const float4 g0 = *(const float4*)(lds + RT_G + (32 * s2 + 8 * q) * 4), g1 = *(const float4*)(lds + RT_G + (32 * s2 + 8 * q + 4) * 4);
                const u32x4 w = hv[s2];
                u32x4 o;
                o.x = pk2(bflo(w.x) * rinv * g0.x, bfhi(w.x) * rinv * g0.y); o.y = pk2(bflo(w.y) * rinv * g0.z, bfhi(w.y) * rinv * g0.w);
                o.z = pk2(bflo(w.z) * rinv * g1.x, bfhi(w.z) * rinv * g1.y); o.w = pk2(bflo(w.w) * rinv * g1.z, bfhi(w.w) * rinv * g1.w);
                *(u32x4*)(up + 32 * s2) = o;
            }
            __builtin_amdgcn_sched_barrier(0);
        }
        {
            const f32x4 lg = ((a0 + a1) + (a2 + a3)) * rinv;
            float m = fmaxf(fmaxf(lg[0], lg[1]), fmaxf(lg[2], lg[3]));
            m = rows_max(m);
            const float e0 = __expf(lg[0] - m), e1 = __expf(lg[1] - m), e2 = __expf(lg[2] - m), e3 = __expf(lg[3] - m);
            float sm = (e0 + e1) + (e2 + e3);
            sm = rows_sum(sm);
            const float ri = frcp(sm);
            const int b = token / L_, t = token - b * L_;
            float* ap = p.aff() + (size_t)(b * 16 + 4 * q) * L_ + t;
            ap[0] = e0 * ri; ap[L_] = e1 * ri; ap[2 * L_] = e2 * ri; ap[3 * L_] = e3 * ri;
        }
        tile += nb * 4;
        if (tile < NT) load_tile(tile);
    }
#if PROBE_ROUTER
    }
#endif
}

__device__ __forceinline__ void phase_topk(const P& p, int layer, unsigned char* lds, int bid, int nb) {
    const int tid = opaque_tid(), lane = tid & 63, wid = tid >> 6;
    {
        const int nconv = nb > NG ? nb - NG : nb, cid = nb > NG ? bid - NG : bid;
        if (cid >= 0 && layer < 3) {
            float* tile = (float*)lds;
            for (int j = cid; j < TOPK_TILES; j += nconv) {
                int rt, kt; deferred_tile(2 * DEF_PER_SCAN + layer * TOPK_TILES + j, rt, kt);
                float4 cv[4]; ConvTile ct;
                conv_load(p, rt, kt, tid, cv, ct);
                __syncthreads();
                conv_lds(tile, cv, tid);
                __syncthreads();
                conv_store(tile, ct, tid);
            }
            __syncthreads();
        }
        if (bid >= NG) return;
    }
    unsigned* wc = (unsigned*)lds;
#if PROBE_TOPK
    for (int rep = 0; rep < 4; ++rep)
#endif
    for (int g = bid; g < NG; g += nb) {
        const int e = 2 * (g & 7) + ((g >> 3) & 1), b = g >> 4;
        const float* ap = p.aff() + (size_t)(b * 16 + e) * L_;
        unsigned key[9];
#pragma unroll
        for (int m = 0; m < 9; ++m) { const int i = tid + 256 * m; key[m] = (i < L_) ? __builtin_bit_cast(unsigned, ap[i]) : 0u; }
        unsigned T = 0u;
        for (int lo = 30; lo >= 0; lo -= 2) {
            const unsigned c1 = T | (1u << lo), c2 = T | (2u << lo), c3 = T | (3u << lo);
            unsigned n1 = 0, n2 = 0, n3 = 0;
#pragma unroll
            for (int m = 0; m < 9; ++m) {
                n1 += (unsigned)__popcll(__ballot(key[m] >= c1)); n2 += (unsigned)__popcll(__ballot(key[m] >= c2)); n3 += (unsigned)__popcll(__ballot(key[m] >= c3));
            }
            unsigned* w = wc + ((lo >> 1) & 1) * 16;
            if (lane == 0) { w[wid] = n1; w[4 + wid] = n2; w[8 + wid] = n3; }
            __syncthreads();
            const unsigned t1 = w[0] + w[1] + w[2] + w[3], t2 = w[4] + w[5] + w[6] + w[7], t3 = w[8] + w[9] + w[10] + w[11];
            T = (t3 >= CAP) ? c3 : (t2 >= CAP) ? c2 : (t1 >= CAP) ? c1 : T;
        }
        __syncthreads();
        unsigned cg = 0;
#pragma unroll
        for (int m = 0; m < 9; ++m) cg += (unsigned)__popcll(__ballot(key[m] > T));
        if (lane == 0) wc[wid] = cg;
        __syncthreads();
        const unsigned n_gt = wc[0] + wc[1] + wc[2] + wc[3];
        const unsigned need = CAP - n_gt;
        __syncthreads();
        unsigned base_sel = 0, base_tie = 0;
#pragma unroll
        for (int m = 0; m < 9; ++m) {
            const int i = tid + 256 * m;
            const bool gt = key[m] > T, tie = (key[m] == T) && (i < L_);
            const unsigned long long bt = __ballot(tie);
            const unsigned long long lower = (1ull << lane) - 1ull;
            if (lane == 0) { wc[8 + wid] = (unsigned)__popcll(bt); }
            __syncthreads();
            unsigned tie_before = base_tie + (unsigned)__popcll(bt & lower);
            for (int w2 = 0; w2 < wid; ++w2) tie_before += wc[8 + w2];
            const unsigned tie_row = wc[8] + wc[9] + wc[10] + wc[11];
            const bool take = gt || (tie && tie_before < need);
            const unsigned long long bs = __ballot(take);
            if (lane == 0) { wc[12 + wid] = (unsigned)__popcll(bs); }
            __syncthreads();
            unsigned slot = base_sel + (unsigned)__popcll(bs & lower);
            for (int w2 = 0; w2 < wid; ++w2) slot += wc[12 + w2];
            const unsigned sel_row = wc[12] + wc[13] + wc[14] + wc[15];
            if (i < L_) {
                if (take) { const int sl = (e * B_ + b) * CAP + (int)slot; p.idx()[sl] = b * L_ + i; p.gate()[sl] = __builtin_bit_cast(float, key[m]); }
                p.sel()[((size_t)b * L_ + i) * 16 + e] = take ? (int)slot : -1;
            }
            base_sel += sel_row; base_tie += tie_row;
            __syncthreads();
        }
    }
}

template <int MT>
__device__ __forceinline__ void gateup_addr(const P& p, int layer, int e, int srow0, int nt, int tid, TileAddr& t) {
    const int lrow = tid >> 3;
#pragma unroll
    for (int i = 0; i < MT; ++i) { int srow = srow0 + lrow + 32 * i; if (srow > ESLOTS - 1) srow = ESLOTS - 1; t.ao[i] = (unsigned)p.idx()[e * ESLOTS + srow] * 2048u + gemm_chunk_off(tid); }
    t.ab = (const char*)p.u();
    t.bb = (const char*)(p.Wgu() + (size_t)(layer * 16 + e) * 2048 * 1024); t.bo = (unsigned)(nt * 128 + lrow) * 2048u + gemm_chunk_off(tid);
}
template <int MT>
__device__ __forceinline__ void gateup_unit(const P& p, int layer, unsigned char* lds, int e, int srow0, int nt, int tid, Prefetch& pf, bool has_next = false, int e2 = 0, int srow2 = 0, int nt2 = 0) {
    const int lane = tid & 63, wid = tid >> 6, wr = wid >> 1, wc = wid & 1, fr = lane & 15, fq = lane >> 4;
    TileAddr t; const bool pre = pf.have;
    if (pre) t = pf.t; else gateup_addr<MT>(p, layer, e, srow0, nt, tid, t);
    if (has_next) gateup_addr<MT>(p, layer, e2, srow2, nt2, tid, pf.t);
    pf.have = has_next;
    f32x4 acc[MT][4];
    gemm_tile<false, MT>(t, lds, acc, tid, pre, has_next ? &pf.t : nullptr);
#pragma unroll
    for (int m = 0; m < MT; ++m) {
        const int srow = srow0 + wr * 16 * MT + m * 16 + fr;
        if (srow < ESLOTS) {
            float o[8];
#pragma unroll
            for (int n = 0; n < 2; ++n) {
                const f32x4 gv = acc[m][n], uv = acc[m][n + 2];
#pragma unroll
                for (int j = 0; j < 4; ++j) o[4 * n + j] = gv[j] * frcp(1.f + __expf(-gv[j])) * uv[j];
            }
            u32x4 pk; pk.x = pk2(o[0], o[1]); pk.y = pk2(o[2], o[3]); pk.z = pk2(o[4], o[5]); pk.w = pk2(o[6], o[7]);
            *(u32x4*)(p.hdn() + ((size_t)e * ESLOTS + srow) * D_ + nt * 64 + wc * 32 + fq * 8) = pk;
        }
    }
}
__device__ __forceinline__ void phase_gateup(const P& p, int layer, unsigned char* lds, int bid, int nb) {
    const int tid = opaque_tid();
    const int x = bid & 7, l = bid >> 3, nbx = nb >> 3;
#if PROBE_GEMM
    for (int rep = 0; rep < 2; ++rep)
#endif
    {
        Prefetch pf; pf.have = false;
        for (int s = l; s < 320; s += nbx) {
            const int e = 2 * x + s / 160, s2 = s % 160, mt = s2 >> 4, nt = s2 & 15;
            const int sn = s + nbx, en = 2 * x + sn / 160, sn2 = sn % 160;
            gateup_unit<6>(p, layer, lds, e, mt * 192, nt, tid, pf, sn < 320, en, (sn2 >> 4) * 192, sn2 & 15);
        }
    }
    for (int s = l; s < 64; s += nbx) {
        const int u = s & 31, e = 2 * x + (u >> 4), nt = u & 15;
        Prefetch pf; pf.have = false;
        if (s < 32) gateup_unit<4>(p, layer, lds, e, 1920, nt, tid, pf); else gateup_unit<1>(p, layer, lds, e, 2048, nt, tid, pf);
    }
}

template <int MT>
__device__ __forceinline__ void down_addr(const P& p, int layer, int e, int srow0, int nt, int tid, TileAddr& t) {
    const int lrow = tid >> 3;
#pragma unroll
    for (int i = 0; i < MT; ++i) { int srow = srow0 + lrow + 32 * i; if (srow > ESLOTS - 1) srow = ESLOTS - 1; t.ao[i] = (unsigned)srow * 2048u + gemm_chunk_off(tid); }
    t.ab = (const char*)(p.hdn() + (size_t)e * ESLOTS * D_);
    t.bb = (const char*)(p.Wd() + (size_t)(layer * 16 + e) * 1024 * 1024); t.bo = (unsigned)(nt * 128 + lrow) * 2048u + gemm_chunk_off(tid);
}
template <int MT>
__device__ __forceinline__ void down_unit(const P& p, int layer, unsigned char* lds, int e, int srow0, int nt, int tid, Prefetch& pf, bool has_next = false, int e2 = 0, int srow2 = 0, int nt2 = 0) {
    const int lane = tid & 63, wid = tid >> 6, wr = wid >> 1, wc = wid & 1, fr = lane & 15, fq = lane >> 4;
    TileAddr t; const bool pre = pf.have;
    if (pre) t = pf.t; else down_addr<MT>(p, layer, e, srow0, nt, tid, t);
    if (has_next) down_addr<MT>(p, layer, e2, srow2, nt2, tid, pf.t);
    pf.have = has_next;
    float gt0, gt1;
    if (pre) { gt0 = pf.r0; gt1 = pf.r1; } else rv_load<MT>(p.gate(), e * ESLOTS + srow0 + wr * 16 * MT, e * ESLOTS + ESLOTS - 1, fr, fq, gt0, gt1);
    f32x4 acc[MT][4];
    gemm_tile<false, MT>(t, lds, acc, tid, pre, has_next ? &pf.t : nullptr);
    RV_PIN(gt0, gt1);
    if (has_next) rv_load<MT>(p.gate(), e2 * ESLOTS + srow2 + wr * 16 * MT, e2 * ESLOTS + ESLOTS - 1, fr, fq, pf.r0, pf.r1);
#pragma unroll
    for (int m = 0; m < MT; ++m) {
        const int srow = srow0 + wr * 16 * MT + m * 16 + fr;
        const float gt = rv_get(gt0, gt1, m, fr);
        if (srow < ESLOTS) {
#pragma unroll
            for (int pr = 0; pr < 2; ++pr) {
                const f32x4 v0 = acc[m][2 * pr], v1 = acc[m][2 * pr + 1];
                u32x4 pk; pk.x = pk2(v0[0] * gt, v0[1] * gt); pk.y = pk2(v0[2] * gt, v0[3] * gt); pk.z = pk2(v1[0] * gt, v1[1] * gt); pk.w = pk2(v1[2] * gt, v1[3] * gt);
                *(u32x4*)(p.ys() + ((size_t)e * ESLOTS + srow) * D_ + nt * 128 + wc * 64 + pr * 32 + fq * 8) = pk;
            }
        }
        if (MT > 4) __builtin_amdgcn_sched_barrier(0);
    }
    if (has_next) RV_DONE(pf.r0, pf.r1);
}
__device__ __forceinline__ void phase_down(const P& p, int layer, unsigned char* lds, int bid, int nb) {
    const int tid = opaque_tid();
    const int x = bid & 7, l = bid >> 3, nbx = nb >> 3;
#if PROBE_GEMM
    for (int rep = 0; rep < 2; ++rep)
#endif
    Prefetch pf; pf.have = false;
    for (int s = l; s < 160 + 32; s += nbx) {
        if (s < 160) {
            const int e = 2 * x + s / 80, s2 = s % 80, mt = s2 >> 3, nt = s2 & 7;
            const int sn = s + nbx, en = 2 * x + sn / 80, sn2 = sn % 80;
            down_unit<6>(p, layer, lds, e, mt * 192, nt, tid, pf, sn < 160, en, (sn2 >> 3) * 192, sn2 & 7);
        } else {
            const int u = (s - 160) & 15, e = 2 * x + (u >> 3), nt = u & 7;
            if (s < 176) down_unit<4>(p, layer, lds, e, 1920, nt, tid, pf); else down_unit<1>(p, layer, lds, e, 2048, nt, tid, pf);
        }
    }
}


template <int MT>
__device__ __forceinline__ void odd_in_unit(const P& p, int j, const bf16_t* W, unsigned char* lds, int row0, int nt, int tid, Prefetch& pf, bool has_next = false, int row2 = 0, int nt2 = 0) {
    const int lane = tid & 63, wid = tid >> 6, wr = wid >> 1, wc = wid & 1, fr = lane & 15, fq = lane >> 4;
    TileAddr t; const bool pre = pf.have;
    if (pre) t = pf.t; else tile_addr_rows<MT>(t, p.u(), row0, W, nt, tid);
    if (has_next) tile_addr_rows<MT>(pf.t, p.u(), row2, W, nt2, tid);
    pf.have = has_next;
    const TileAddr* nx = has_next ? &pf.t : nullptr;
    f32x4 acc[MT][4];
    if (nt < 16) {
        gemm_tile<false, MT>(t, lds, acc, tid, pre, nx);
        const bool isq = nt < 8;
        const float* g = isq ? (p.o_qg + j * 64) : (p.o_kg + j * 64);
        const float sc = isq ? 0.125f * 1.4426950408889634f : 1.f;
        f32x4 gv[4];
#pragma unroll
        for (int n = 0; n < 4; ++n) gv[n] = *(const f32x4*)(g + 32 * (n >> 1) + 8 * fq + 4 * (n & 1));
#pragma unroll
        for (int m = 0; m < MT; ++m) {
            float ss = 0.f;
#pragma unroll
            for (int n = 0; n < 4; ++n) { const f32x4 v = acc[m][n]; ss += v[0] * v[0] + v[1] * v[1] + v[2] * v[2] + v[3] * v[3]; }
            ss = rows_sum(ss);
            const float rinv = frsq(ss * (1.f / 64.f) + 1e-6f) * sc;
            const int row = row0 + wr * 16 * MT + m * 16 + fr;
            bf16_t* dst;
            if (isq) dst = p.zo() + (size_t)row * 1024 + nt * 128 + wc * 64 + fq * 8;
            else { const int b = row / L_, tk = row - b * L_; dst = p.kh() + ((size_t)(b * 16 + (nt - 8) * 2 + wc) * L_ + tk) * 64 + fq * 8; }
#pragma unroll
            for (int pr = 0; pr < 2; ++pr) {
                const f32x4 v0 = acc[m][2 * pr], v1 = acc[m][2 * pr + 1], g0 = gv[2 * pr], g1 = gv[2 * pr + 1];
                u32x4 pk; pk.x = pk2(v0[0] * rinv * g0[0], v0[1] * rinv * g0[1]); pk.y = pk2(v0[2] * rinv * g0[2], v0[3] * rinv * g0[3]);
                pk.z = pk2(v1[0] * rinv * g1[0], v1[1] * rinv * g1[1]); pk.w = pk2(v1[2] * rinv * g1[2], v1[3] * rinv * g1[3]);
                *(u32x4*)(dst + pr * 32) = pk;
            }
        }
    } else {
        gemm_tile<true, MT>(t, lds, acc, tid, pre, nx);
        const int head = (nt - 16) * 2 + wc;
#pragma unroll
        for (int mp = 0; mp < MT / 2; ++mp) {
            const int row = row0 + wr * 16 * MT + (2 * mp + (fq & 1)) * 16 + 8 * (fq >> 1);
            const int b = row / L_, tk = row - b * L_;
#pragma unroll
            for (int n = 0; n < 4; ++n) {
                const int d = n * 16 + fr;
                const f32x4 v0 = acc[2 * mp][n], v1 = acc[2 * mp + 1][n];
                u32x2 p0, p1; p0.x = pk2(v0[0], v0[1]); p0.y = pk2(v0[2], v0[3]); p1.x = pk2(v1[0], v1[1]); p1.y = pk2(v1[2], v1[3]);
                *(u32x4*)(p.vT() + ((size_t)(b * 16 + head) * 64 + d) * L_ + tk) = widen_pair(p0, p1);
            }
        }
        static_assert(MT % 2 == 0, "the transposed-store epilogue pairs 16-token fragments");
    }
}
__device__ __forceinline__ void phase_odd_in(const P& p, int layer, unsigned char* lds, int bid, int nb) {
    const int tid = opaque_tid();
    const int x = bid & 7, l = bid >> 3, nbx = nb >> 3;
    const int j = layer >> 1;
    const bf16_t* W = p.WinO() + (size_t)j * 3072 * 1024;
    const int nt0 = 6 * (x >> 1), par = x & 1;
#if PROBE_GEMM
    for (int rep = 0; rep < 2; ++rep)
#endif
    { Prefetch pf; pf.have = false;
      for (int s = l; s < 246; s += nbx) { const int sn = s + nbx; odd_in_unit<6>(p, j, W, lds, (2 * (s / 6) + par) * 192, nt0 + (s % 6), tid, pf, sn < 246, (2 * (sn / 6) + par) * 192, nt0 + (sn % 6)); } }
    Prefetch pf0; pf0.have = false;
    if (nbx == 64) { for (int s = l - 54; s >= 0 && s < 18; s += 10) odd_in_unit<4>(p, j, W, lds, 15744 + (2 * (s / 6) + par) * 128, nt0 + (s % 6), tid, pf0); }
    else           { for (int s = l; s < 18; s += nbx) odd_in_unit<4>(p, j, W, lds, 15744 + (2 * (s / 6) + par) * 128, nt0 + (s % 6), tid, pf0); }
}

#define NA_VSTRIDE 1200
#define NA_RPB 76800
__device__ __forceinline__ void na_dma16(unsigned voff, const char* sbase, unsigned ldsaddr) {
    unsigned keep;
    asm volatile("s_nop 4\n\ts_mov_b32 %0, m0\n\ts_mov_b32 m0, %2\n\ts_nop 0\n\tglobal_load_lds_dwordx4 %1, %3\n\ts_mov_b32 m0, %0"
                 : "=&s"(keep) : "v"(voff), "s"(ldsaddr), "s"(sbase) : "memory");
}
__device__ __forceinline__ const char* na_uni(const void* q) {
    const unsigned long long v = (unsigned long long)q;
    const unsigned lo = (unsigned)__builtin_amdgcn_readfirstlane((int)(unsigned)v), hi = (unsigned)__builtin_amdgcn_readfirstlane((int)(unsigned)(v >> 32));
    return (const char*)(((unsigned long long)hi << 32) | lo);
}
__device__ __forceinline__ int na_key(int row) { return ((row >> 1) & 1) | ((row >> 2) & 6); }
__device__ __forceinline__ void phase_natten(const P& p, int layer, unsigned char* lds, int bid, int nb) {
    const int tid = opaque_tid(), lane = tid & 63, wid = tid >> 6, fr = lane & 15, fq = lane >> 4;
    const int h = bid & 15, jb = bid >> 4, njb = nb >> 4;
    const float* rpbh = p.o_rpb + ((size_t)(layer >> 1) * 16 + h) * 15 * 31;
    float* rtab = (float*)(lds + NA_RPB);
    __syncthreads();
    for (int i = tid; i < 15 * 31; i += NTHR) rtab[i] = rpbh[i] * 1.4426950408889634f;
    const int w = __builtin_amdgcn_readfirstlane(wid);
    const int kc0 = (w == 0) ? 0 : (w == 1) ? 8 : (w == 2) ? 24 : 32;
    const int c = 16 * w + fr;
    const int cs = min(max(c - 8, 0), 48);
    bool vld[8];
#pragma unroll
    for (int pj = 0; pj < 8; ++pj) { const int kc = kc0 + 8 * fq + pj; vld[pj] = (kc >= cs) && (kc < cs + 16); }
    const int lanepart = kc0 + 8 * fq - c + 15;
    const unsigned lbase = (unsigned)(size_t)lds;
    const char* zob = na_uni(p.kh()); const char* vtb = na_uni(p.vT());
    for (int it = jb; it < B_ * 16; it += njb) {
        const int b = it >> 4, r0 = 2 * (it & 15);
        const int rsA = min(max(r0 - 4, 0), 24), rsB = min(max(r0 - 3, 0), 24), off = rsB - rsA;
        const size_t tokb = (size_t)b * L_;
        __syncthreads();
        for (int q = w; q < 74; q += 4) {
            if (q >= 64 && q < 72 && off == 0) continue;
            const int row = 8 * q + (lane >> 3), pc = lane & 7;
            const int tok = row < 576 ? NM + rsA * 64 + row : row - 576;
            const unsigned voff = (unsigned)((b * 16 + h) * L_ + tok) * 128u + (unsigned)((pc ^ na_key(row)) << 4);
            na_dma16(voff, zob, lbase + q * 1024);
        }
        const bf16_t* qp = p.zo() + (tokb + NM + r0 * 64 + c) * 1024 + h * 64 + fq * 8;
        bf16x8 qA0 = *(const bf16x8*)qp, qA1 = *(const bf16x8*)(qp + 32), qB0 = *(const bf16x8*)(qp + 65536), qB1 = *(const bf16x8*)(qp + 65536 + 32);
        f32x4 S[17];
        auto s_init = [&](int dr0) {
            const float* rb = rtab + dr0 * 31 + lanepart;
#pragma unroll
            for (int n = 0; n < 16; ++n)
#pragma unroll
                for (int jj = 0; jj < 4; ++jj) S[n][jj] = rb[(n >> 1) * 31 + 4 * (n & 1) + jj];
#pragma unroll
            for (int n = 0; n < 16; ++n) asm("" : "+v"(S[n]));
#pragma unroll
            for (int n = 0; n < 16; ++n)
#pragma unroll
                for (int jj = 0; jj < 4; ++jj) S[n][jj] = vld[4 * (n & 1) + jj] ? S[n][jj] : -3.0e38f;
            S[16] = (f32x4){0.f, 0.f, 0.f, 0.f};
        };
        auto qk = [&](const bf16x8& q0, const bf16x8& q1, int boff) {
            const int rowe = kc0 + 8 * (fr >> 2) + (fr & 3), rowo = rowe + 4;
            const unsigned char* be = lds + boff + rowe * 128; const unsigned char* bo = lds + boff + rowo * 128;
            const int ce0 = ((0 + fq) ^ na_key(rowe)) << 4, ce1 = ((4 + fq) ^ na_key(rowe)) << 4, co0 = ((0 + fq) ^ na_key(rowo)) << 4, co1 = ((4 + fq) ^ na_key(rowo)) << 4;
            const unsigned char* pe0 = be + ce0; const unsigned char* pe1 = be + ce1; const unsigned char* po0 = bo + co0; const unsigned char* po1 = bo + co1;
#pragma unroll
            for (int n = 0; n < 16; ++n) {
                const bf16x8 k0 = *(const bf16x8*)(((n & 1) ? po0 : pe0) + (n >> 1) * 8192), k1 = *(const bf16x8*)(((n & 1) ? po1 : pe1) + (n >> 1) * 8192);
                S[n] = __builtin_amdgcn_mfma_f32_16x16x32_bf16(k0, q0, S[n], 0, 0, 0);
                S[n] = __builtin_amdgcn_mfma_f32_16x16x32_bf16(k1, q1, S[n], 0, 0, 0);
            }
            {
                const int row = 576 + fr, ky = na_key(row);
                const bf16x8 k0 = *(const bf16x8*)(lds + row * 128 + (((0 + fq) ^ ky) << 4)), k1 = *(const bf16x8*)(lds + row * 128 + (((4 + fq) ^ ky) << 4));
                S[16] = __builtin_amdgcn_mfma_f32_16x16x32_bf16(k0, q0, S[16], 0, 0, 0);
                S[16] = __builtin_amdgcn_mfma_f32_16x16x32_bf16(k1, q1, S[16], 0, 0, 0);
            }
        };
        auto softmax_pack = [&](u32x4 (&Pk)[8], u32x2& Pm) -> float {
            float mx = -3.0e38f;
#pragma unroll
            for (int n = 0; n < 17; ++n) mx = fmax3_raw(fmax3_raw(mx, S[n][0], S[n][1]), S[n][2], S[n][3]);
            mx = rows_max(mx);
            float sum = 0.f;
#pragma unroll
            for (int n = 0; n < 17; ++n)
#pragma unroll
                for (int jj = 0; jj < 4; ++jj) { const float e = __builtin_amdgcn_exp2f(S[n][jj] - mx); S[n][jj] = e; sum += e; }
#pragma unroll
            for (int t = 0; t < 8; ++t) {
                Pk[t].x = pk2(S[2 * t][0], S[2 * t][1]); Pk[t].y = pk2(S[2 * t][2], S[2 * t][3]); Pk[t].z = pk2(S[2 * t + 1][0], S[2 * t + 1][1]); Pk[t].w = pk2(S[2 * t + 1][2], S[2 * t + 1][3]);
            }
            Pm.x = pk2(S[16][0], S[16][1]); Pm.y = pk2(S[16][2], S[16][3]);
            sum = rows_sum(sum);
            return frcp(sum);
        };
        s_init(rsA - r0 + 7);
        asm volatile("s_waitcnt vmcnt(0)" : "+v"(qA0), "+v"(qA1), "+v"(qB0), "+v"(qB1) :: "memory");
        __syncthreads();
        u32x4 PA[8], PB[8]; u32x2 PAm, PBm;
        __builtin_amdgcn_sched_barrier(0);
        qk(qA0, qA1, 0);
        __builtin_amdgcn_sched_barrier(0);
        const float rinvA = softmax_pack(PA, PAm);
        __builtin_amdgcn_sched_barrier(0);
        s_init(rsB - r0 + 6);
        __builtin_amdgcn_sched_barrier(0);
        qk(qB0, qB1, off * 64 * 128);
        __builtin_amdgcn_sched_barrier(0);
        __syncthreads();
        const bf16_t* vrow = p.vT() + (size_t)(b * 16 + h) * 64 * L_;
        u32x4 vmeta = (u32x4){0u, 0u, 0u, 0u}, v9a = vmeta, v9b = vmeta;
        if (tid < 128) vmeta = *(const u32x4*)(vrow + (size_t)(tid >> 1) * L_ + (tid & 1) * 8);
        if (off) { const bf16_t* s9 = vrow + (size_t)(tid >> 2) * L_ + NM + (rsA + 8) * 64 + (tid & 3) * 16; v9a = *(const u32x4*)s9; v9b = *(const u32x4*)(s9 + 8); }
        for (int d = w; d < 64; d += 4) {
            const unsigned voff = (unsigned)((b * 16 + h) * 64 + d) * 4128u + (unsigned)((NM + rsA * 64) * 2 + lane * 16);
            na_dma16(voff, vtb, lbase + d * NA_VSTRIDE);
        }
        __builtin_amdgcn_sched_barrier(0);
        const float rinvB = softmax_pack(PB, PBm);
        __builtin_amdgcn_sched_barrier(0);
        if (tid < 128) *(u32x4*)(lds + (tid >> 1) * NA_VSTRIDE + 1152 + (tid & 1) * 16) = vmeta;
        if (off) { unsigned char* d9 = lds + (tid >> 2) * NA_VSTRIDE + 1024 + (tid & 3) * 32; *(u32x4*)d9 = v9a; *(u32x4*)(d9 + 16) = v9b; }
        asm volatile("s_waitcnt vmcnt(0)" ::: "memory");
        __syncthreads();
        f32x4 OA[4], OB[4];
#pragma unroll
        for (int nd = 0; nd < 4; ++nd) { OA[nd] = (f32x4){0.f, 0.f, 0.f, 0.f}; OB[nd] = OA[nd]; }
        const unsigned char* vbA = lds + fr * NA_VSTRIDE + (kc0 + 8 * fq) * 2;
        const unsigned char* vbB = vbA + off * 128;
#pragma unroll
        for (int t = 0; t < 8; ++t) {
            const bf16x8 pfa = __builtin_bit_cast(bf16x8, PA[t]), pfb = __builtin_bit_cast(bf16x8, PB[t]);
#pragma unroll
            for (int nd = 0; nd < 4; ++nd) {
                const bf16x8 va = *(const bf16x8*)(vbA + nd * 16 * NA_VSTRIDE + t * 128), vb = *(const bf16x8*)(vbB + nd * 16 * NA_VSTRIDE + t * 128);
                OA[nd] = __builtin_amdgcn_mfma_f32_16x16x32_bf16(va, pfa, OA[nd], 0, 0, 0);
                OB[nd] = __builtin_amdgcn_mfma_f32_16x16x32_bf16(vb, pfb, OB[nd], 0, 0, 0);
            }
        }
        {
            u32x4 pa, pb; pa.x = PAm.x; pa.y = PAm.y; pa.z = 0u; pa.w = 0u; pb.x = PBm.x; pb.y = PBm.y; pb.z = 0u; pb.w = 0u;
            const bf16x8 pfa = __builtin_bit_cast(bf16x8, pa), pfb = __builtin_bit_cast(bf16x8, pb);
#pragma unroll
            for (int nd = 0; nd < 4; ++nd) {
                const u32x2 v2 = *(const u32x2*)(lds + (16 * nd + fr) * NA_VSTRIDE + 1152 + 8 * fq);
                u32x4 vw; vw.x = v2.x; vw.y = v2.y; vw.z = 0u; vw.w = 0u;
                OA[nd] = __builtin_amdgcn_mfma_f32_16x16x32_bf16(__builtin_bit_cast(bf16x8, vw), pfa, OA[nd], 0, 0, 0);
                OB[nd] = __builtin_amdgcn_mfma_f32_16x16x32_bf16(__builtin_bit_cast(bf16x8, vw), pfb, OB[nd], 0, 0, 0);
            }
        }
        bf16_t* op = p.mix() + (tokb + NM + r0 * 64 + c) * D_ + h * 64 + 16 * (fq & 1) + 8 * (fq >> 1);
        u32x2 pa[4], pb[4];
#pragma unroll
        for (int nd = 0; nd < 4; ++nd) {
            pa[nd].x = pk2(OA[nd][0] * rinvA, OA[nd][1] * rinvA); pa[nd].y = pk2(OA[nd][2] * rinvA, OA[nd][3] * rinvA);
            pb[nd].x = pk2(OB[nd][0] * rinvB, OB[nd][1] * rinvB); pb[nd].y = pk2(OB[nd][2] * rinvB, OB[nd][3] * rinvB);
        }
#pragma unroll
        for (int pr2 = 0; pr2 < 2; ++pr2) {
            *(u32x4*)(op + 32 * pr2) = widen_pair(pa[2 * pr2], pa[2 * pr2 + 1]);
            *(u32x4*)(op + 64 * D_ + 32 * pr2) = widen_pair(pb[2 * pr2], pb[2 * pr2 + 1]);
        }
    }
    for (int mi = bid * 4 + wid; mi < B_ * 16; mi += nb * 4) {
        const int hm = mi & 15, b = mi >> 4;
        const size_t tokb = (size_t)b * L_;
        const bf16_t* qp = p.zo() + (tokb + fr) * 1024 + hm * 64 + fq * 8;
        const bf16x8 qf0 = *(const bf16x8*)qp, qf1 = *(const bf16x8*)(qp + 32);
        const bf16_t* kp = p.kh() + ((size_t)(b * 16 + hm) * L_ + fr) * 64 + fq * 8;
        const bf16x8 kf0 = *(const bf16x8*)kp, kf1 = *(const bf16x8*)(kp + 32);
        f32x4 a = (f32x4){0.f, 0.f, 0.f, 0.f};
        a = __builtin_amdgcn_mfma_f32_16x16x32_bf16(kf0, qf0, a, 0, 0, 0);
        a = __builtin_amdgcn_mfma_f32_16x16x32_bf16(kf1, qf1, a, 0, 0, 0);
        float mx = fmaxf(fmaxf(a[0], a[1]), fmaxf(a[2], a[3]));
        mx = fmaxf(mx, __shfl_xor(mx, 16)); mx = fmaxf(mx, __shfl_xor(mx, 32));
        float sum = 0.f;
#pragma unroll
        for (int jj = 0; jj < 4; ++jj) { a[jj] = __builtin_amdgcn_exp2f(a[jj] - mx); sum += a[jj]; }
        sum += __shfl_xor(sum, 16); sum += __shfl_xor(sum, 32);
        const float rinv = frcp(sum);
        u32x4 pw; pw.x = pk2(a[0], a[1]); pw.y = pk2(a[2], a[3]); pw.z = 0u; pw.w = 0u;
        const bf16x8 pf = __builtin_bit_cast(bf16x8, pw);
        const bf16_t* vb = p.vT() + ((size_t)(b * 16 + hm) * 64 + fr) * L_;
        bf16_t* op = p.mix() + (tokb + fr) * D_ + hm * 64 + fq * 4;
#pragma unroll
        for (int nd = 0; nd < 4; ++nd) {
            const u32x2 v2 = *(const u32x2*)(vb + (size_t)nd * 16 * L_ + 4 * fq);
            u32x4 vw; vw.x = v2.x; vw.y = v2.y; vw.z = 0u; vw.w = 0u;
            f32x4 o = (f32x4){0.f, 0.f, 0.f, 0.f};
            o = __builtin_amdgcn_mfma_f32_16x16x32_bf16(__builtin_bit_cast(bf16x8, vw), pf, o, 0, 0, 0);
            u32x2 pk; pk.x = pk2(o[0] * rinv, o[1] * rinv); pk.y = pk2(o[2] * rinv, o[3] * rinv);
            *(u32x2*)(op + nd * 16) = pk;
        }
    }
}

template <int MT>
__device__ __forceinline__ void outproj_unit(const P& p, const bf16_t* W, unsigned char* lds, int row0, int nt, int tid, Prefetch& pf, bool has_next = false, int row2 = 0, int nt2 = 0) {
    const int lane = tid & 63, wid = tid >> 6, wr = wid >> 1, wc = wid & 1, fr = lane & 15, fq = lane >> 4;
    TileAddr t; const bool pre = pf.have;
    if (pre) t = pf.t; else tile_addr_rows<MT>(t, p.mix(), row0, W, nt, tid);
    if (has_next) tile_addr_rows<MT>(pf.t, p.mix(), row2, W, nt2, tid);
    pf.have = has_next;
    f32x4 acc[MT][4];
    u32x4 hres[MT][2];
    bf16_t* const hbase = p.h() + ((size_t)row0 + wr * 16 * MT + fr) * D_ + nt * 128 + wc * 64 + fq * 8;
    auto hook = [&]() {
#pragma unroll
        for (int m = 0; m < MT; ++m)
#pragma unroll
            for (int pr = 0; pr < 2; ++pr) hres[m][pr] = *(const u32x4*)(hbase + (size_t)m * 16 * D_ + pr * 32);
    };
    gemm_tile<false, MT>(t, lds, acc, tid, pre, has_next ? &pf.t : nullptr, hook);
#pragma unroll
    for (int m = 0; m < MT; ++m) {
#pragma unroll
        for (int pr = 0; pr < 2; ++pr) {
            bf16_t* hp = hbase + (size_t)m * 16 * D_ + pr * 32;
            const u32x4 hw = hres[m][pr]; const f32x4 a0 = acc[m][2 * pr], a1 = acc[m][2 * pr + 1];
            u32x4 ow;
            ow.x = pk2(bflo(hw.x) + a0[0], bfhi(hw.x) + a0[1]); ow.y = pk2(bflo(hw.y) + a0[2], bfhi(hw.y) + a0[3]);
            ow.z = pk2(bflo(hw.z) + a1[0], bfhi(hw.z) + a1[1]); ow.w = pk2(bflo(hw.w) + a1[2], bfhi(hw.w) + a1[3]);
            *(u32x4*)hp = ow;
        }
    }
}
__device__ __forceinline__ void phase_outproj(const P& p, const bf16_t* W, unsigned char* lds, int bid, int nb) {
    const int tid = opaque_tid();
    const int x = bid & 7, l = bid >> 3, nbx = nb >> 3;
    { Prefetch pf; pf.have = false;
      for (int s = l; s < 64; s += nbx) { const int sn = s + nbx; outproj_unit<6>(p, W, lds, (8 * (s >> 3) + x) * 192, s & 7, tid, pf, sn < 64, (8 * (sn >> 3) + x) * 192, sn & 7); } }
    for (int s = l; s < 40; s += nbx) { const int m4 = 8 * (s >> 3) + x; Prefetch pf; pf.have = false; if (m4 < 33) outproj_unit<4>(p, W, lds, 12288 + m4 * 128, s & 7, tid, pf); }
}

__device__ __forceinline__ void phase_tables(const P& p, int bid, int nb) {
    for (int i = bid * NTHR + opaque_tid(); i < L_ * 64; i += nb * NTHR) {
        const int pos = i >> 6, k = i & 63;
        const float inv = powf(10000.f, -(float)k / 64.f);
        const float ang = (float)pos * inv;
        p.costab()[i] = cosf(ang); p.sintab()[i] = sinf(ang);
    }
}

template <int MT>
__device__ __forceinline__ void even_in_unit(const P& p, const bf16_t* W, unsigned char* lds, int row0, int nt, int tid, Prefetch& pf, bool has_next = false, int row2 = 0, int nt2 = 0) {
    const int lane = tid & 63, wid = tid >> 6, wr = wid >> 1, wc = wid & 1, fr = lane & 15, fq = lane >> 4;
    TileAddr t; const bool pre = pf.have;
    if (pre) t = pf.t; else tile_addr_rows<MT>(t, p.u(), row0, W, nt, tid);
    if (has_next) tile_addr_rows<MT>(pf.t, p.u(), row2, W, nt2, tid);
    pf.have = has_next;
    f32x4 acc[MT][4];
    gemm_tile<false, MT>(t, lds, acc, tid, pre, has_next ? &pf.t : nullptr);
    const int seg = nt >> 2;
    if (seg == 4 || seg == 5) {
        const float sc = (seg == 5) ? 0.08838834764831845f : 1.f;
#pragma unroll
        for (int m = 0; m < MT; ++m) {
            const int row = row0 + wr * 16 * MT + m * 16 + fr;
            const int pos = row % L_;
            const int idx = 32 * wc + 8 * fq;
            u32x4 k1, k2;
#pragma unroll
            for (int pp = 0; pp < 2; ++pp) {
                const f32x4 cv = *(const f32x4*)(p.costab() + pos * 64 + idx + 4 * pp), sv = *(const f32x4*)(p.sintab() + pos * 64 + idx + 4 * pp);
                const f32x4 x1 = acc[m][2 * pp], x2 = acc[m][2 * pp + 1];
                const f32x4 y1 = (x1 * cv - x2 * sv) * sc, y2 = (x2 * cv + x1 * sv) * sc;
                if (pp == 0) { k1.x = pk2(y1[0], y1[1]); k1.y = pk2(y1[2], y1[3]); k2.x = pk2(y2[0], y2[1]); k2.y = pk2(y2[2], y2[3]); }
                else         { k1.z = pk2(y1[0], y1[1]); k1.w = pk2(y1[2], y1[3]); k2.z = pk2(y2[0], y2[1]); k2.w = pk2(y2[2], y2[3]); }
            }
            bf16_t* zp = p.ze() + (size_t)row * 4096 + nt * 128 + idx;
            *(u32x4*)zp = k1; *(u32x4*)(zp + 64) = k2;
            if (MT > 4) __builtin_amdgcn_sched_barrier(0);
        }
    } else {
#pragma unroll
        for (int m = 0; m < MT; ++m) {
            const size_t row = (size_t)row0 + wr * 16 * MT + m * 16 + fr;
#pragma unroll
            for (int pr = 0; pr < 2; ++pr) {
                const f32x4 v0 = acc[m][2 * pr], v1 = acc[m][2 * pr + 1];
                u32x4 pk; pk.x = pk2(v0[0], v0[1]); pk.y = pk2(v0[2], v0[3]); pk.z = pk2(v1[0], v1[1]); pk.w = pk2(v1[2], v1[3]);
                *(u32x4*)(p.ze() + row * 4096 + nt * 128 + wc * 64 + pr * 32 + fq * 8) = pk;
            }
        }
    }
}
__device__ __forceinline__ void phase_even_in(const P& p, int layer, unsigned char* lds, int bid, int nb) {
    const int tid = opaque_tid();
    const int x = bid & 7, l = bid >> 3, nbx = nb >> 3;
    const bf16_t* W = p.WinE() + (size_t)(layer >> 1) * 4096 * 1024;
    const int nt0 = 8 * (x >> 1), par = x & 1;
#if PROBE_GEMM
    for (int rep = 0; rep < 2; ++rep)
#endif
    { Prefetch pf; pf.have = false;
      for (int s = l; s < 320; s += nbx) { const int sn = s + nbx; even_in_unit<6>(p, W, lds, (2 * (s >> 3) + par) * 192, nt0 + (s & 7), tid, pf, sn < 320, (2 * (sn >> 3) + par) * 192, nt0 + (sn & 7)); } }
    for (int s = l; s < 40; s += nbx) { const int m4 = 2 * (s >> 3) + par; Prefetch pf; pf.have = false; if (m4 < 9) even_in_unit<4>(p, W, lds, 15360 + m4 * 128, nt0 + (s & 7), tid, pf); }
}

__device__ __forceinline__ void phase_conv(const P& p, int layer, int bid, int nb) {
    const int tid = opaque_tid(), cg = tid & 127, th = tid >> 7;
    const int c0 = cg * 8;
    const float* w = p.e_conv + (size_t)(layer >> 1) * 5 * 1024 + c0;
    float wv[5][8];
#pragma unroll
    for (int jj = 0; jj < 5; ++jj) { const float4 a = *(const float4*)(w + jj * 1024), b2 = *(const float4*)(w + jj * 1024 + 4);
        wv[jj][0] = a.x; wv[jj][1] = a.y; wv[jj][2] = a.z; wv[jj][3] = a.w; wv[jj][4] = b2.x; wv[jj][5] = b2.y; wv[jj][6] = b2.z; wv[jj][7] = b2.w; }
    const float sc = (c0 >= 512) ? 0.08838834764831845f : 1.f;
    u32x4 rows[12], nrows[12];
    auto request = [&](int it, u32x4 (&rw)[12]) {
        const int tok0 = it * 16 + th * 8;
        const int b = tok0 / L_, t0 = tok0 - b * L_;
#pragma unroll
        for (int r = 0; r < 12; ++r) {
            const int tt = t0 - 2 + r;
            rw[r] = (u32x4){0u, 0u, 0u, 0u};
            if (tt >= 0 && tt < L_) rw[r] = *(const u32x4*)(p.ze() + ((size_t)b * L_ + tt) * 4096 + c0);
        }
    };
    int it = bid;
    if (it < T_ / 16) request(it, nrows);
    for (; it < T_ / 16; it += nb) {
#pragma unroll
        for (int r = 0; r < 12; ++r) rows[r] = nrows[r];
        if (it + nb < T_ / 16) request(it + nb, nrows);
        const int tok0 = it * 16 + th * 8;
        float win[5][8];
#pragma unroll
        for (int r = 0; r < 4; ++r) {
            const u32x4 raw = rows[r];
            win[r + 1][0] = bflo(raw.x); win[r + 1][1] = bfhi(raw.x); win[r + 1][2] = bflo(raw.y); win[r + 1][3] = bfhi(raw.y);
            win[r + 1][4] = bflo(raw.z); win[r + 1][5] = bfhi(raw.z); win[r + 1][6] = bflo(raw.w); win[r + 1][7] = bfhi(raw.w);
        }
#pragma unroll
        for (int i = 0; i < 8; ++i) {
#pragma unroll
            for (int r = 0; r < 4; ++r)
#pragma unroll
                for (int c = 0; c < 8; ++c) win[r][c] = win[r + 1][c];
            const u32x4 raw = rows[i + 4];
            win[4][0] = bflo(raw.x); win[4][1] = bfhi(raw.x); win[4][2] = bflo(raw.y); win[4][3] = bfhi(raw.y);
            win[4][4] = bflo(raw.z); win[4][5] = bfhi(raw.z); win[4][6] = bflo(raw.w); win[4][7] = bfhi(raw.w);
            float o[8];
#pragma unroll
            for (int c = 0; c < 8; ++c) {
                float s = 0.f;
#pragma unroll
                for (int jj = 0; jj < 5; ++jj) s += wv[jj][c] * win[jj][c];
                o[c] = s * frcp(1.f + __expf(-s)) * sc;
            }
            u32x4 pk; pk.x = pk2(o[0], o[1]); pk.y = pk2(o[2], o[3]); pk.z = pk2(o[4], o[5]); pk.w = pk2(o[6], o[7]);
            *(u32x4*)(p.qc() + (size_t)(tok0 + i) * 1024 + c0) = pk;
        }
    }
}

#define SC_QS 0
#define SC_KS 17408
#define SC_VS 34816
#define SC_VW 39936
#define SC_CT 45056
#define SC_NS 53760
#define SC_KW 54272
#define SC_AK 54528
#define SC_CONV 55296
__device__ __forceinline__ void tr_read8(unsigned a0, unsigned a1, unsigned a2, unsigned a3, unsigned a4, unsigned a5, unsigned a6, unsigned a7,
                                         u32x2& r0, u32x2& r1, u32x2& r2, u32x2& r3, u32x2& r4, u32x2& r5, u32x2& r6, u32x2& r7) {
    asm volatile("ds_read_b64_tr_b16 %0, %8\n\tds_read_b64_tr_b16 %1, %9\n\tds_read_b64_tr_b16 %2, %10\n\tds_read_b64_tr_b16 %3, %11\n\t"
                 "ds_read_b64_tr_b16 %4, %12\n\tds_read_b64_tr_b16 %5, %13\n\tds_read_b64_tr_b16 %6, %14\n\tds_read_b64_tr_b16 %7, %15\n\ts_waitcnt lgkmcnt(0)"
                 : "=&v"(r0), "=&v"(r1), "=&v"(r2), "=&v"(r3), "=&v"(r4), "=&v"(r5), "=&v"(r6), "=&v"(r7)
                 : "v"(a0), "v"(a1), "v"(a2), "v"(a3), "v"(a4), "v"(a5), "v"(a6), "v"(a7) : "memory");
}
__device__ __forceinline__ void tr_read4(unsigned a0, unsigned a1, unsigned a2, unsigned a3, u32x2& r0, u32x2& r1, u32x2& r2, u32x2& r3) {
    asm volatile("ds_read_b64_tr_b16 %0, %4\n\tds_read_b64_tr_b16 %1, %5\n\tds_read_b64_tr_b16 %2, %6\n\tds_read_b64_tr_b16 %3, %7\n\ts_waitcnt lgkmcnt(0)"
                 : "=&v"(r0), "=&v"(r1), "=&v"(r2), "=&v"(r3) : "v"(a0), "v"(a1), "v"(a2), "v"(a3) : "memory");
}
__device__ __forceinline__ void tr_read2(unsigned a0, unsigned a1, u32x2& r0, u32x2& r1) {
    asm volatile("ds_read_b64_tr_b16 %0, %2\n\tds_read_b64_tr_b16 %1, %3\n\ts_waitcnt lgkmcnt(0)" : "=&v"(r0), "=&v"(r1) : "v"(a0), "v"(a1) : "memory");
}
__device__ __forceinline__ bf16x8 cat8(u32x2 lo, u32x2 hi) { u32x4 w; w.x = lo.x; w.y = lo.y; w.z = hi.x; w.w = hi.y; return __builtin_bit_cast(bf16x8, w); }
template <bool RET>
__device__ void scan_item(const P& p, int layer, unsigned char* lds, int b, int hh, int dir, int eq, int conv_q0, int conv_stride) {
    const int tid = opaque_tid(), lane = tid & 63, w = tid >> 6, fr = lane & 15, fq = lane >> 4;
    const unsigned lbase = (unsigned)(size_t)lds;
    const size_t tokb = (size_t)b * L_;
    const bf16_t* qsrc = RET ? (p.ze() + 2048 + hh * 128) : (p.qc() + hh * 128);
    const bf16_t* ksrc = RET ? (p.ze() + 2560 + hh * 128) : (p.qc() + 512 + hh * 128);
    const bf16_t* vsrc = p.ze() + (RET ? 3072 : 1024) + hh * 128 + eq * 32;
    const int qld = RET ? 4096 : 1024;
    const float lgam = RET ? logsigmoidf_(p.e_decay[(layer >> 1) * 8 + dir * 4 + hh]) : 0.f;
    const int lr = tid >> 4, lc = tid & 15;
    const int vr = tid >> 2, vc = tid & 3;
    u32x4 rq[4], rk[4], rv; float rli = 0.f, rlf = 0.f;
    auto tok_of = [&](int n, int pp) -> int {
        if (n == 0) return pp < 48 ? -1 : pp - 48;
        const int rr = 64 * (n - 1) + pp;
        return NM + (dir ? 2047 - rr : rr);
    };
    const long tstep = dir ? -64 : 64;
    const bf16_t* pq[4]; const bf16_t* pk[4]; const bf16_t* pv; const float* pg;
#pragma unroll
    for (int i = 0; i < 4; ++i) { const int t1 = tok_of(1, lr + 16 * i); pq[i] = qsrc + (tokb + t1) * qld + lc * 8; pk[i] = ksrc + (tokb + t1) * qld + lc * 8; }
    pv = vsrc + (tokb + tok_of(1, vr)) * 4096 + vc * 8;
    pg = p.gts() + (tokb + tok_of(1, lane)) * 16 + dir * 8 + hh;
    auto load_chunk = [&](int n) {
        if (n == 0) {
#pragma unroll
            for (int i = 0; i < 4; ++i) {
                const int t = max(tok_of(0, lr + 16 * i), 0);
                rq[i] = *(const u32x4*)(qsrc + (tokb + t) * qld + lc * 8); rk[i] = *(const u32x4*)(ksrc + (tokb + t) * qld + lc * 8);
            }
            { const int t = max(tok_of(0, vr), 0); rv = *(const u32x4*)(vsrc + (tokb + t) * 4096 + vc * 8); }
            if (!RET) {
                const int t = tok_of(0, lane); rli = 0.f; rlf = 0.f;
                if (t >= 0) { const float* gp = p.gts() + (tokb + t) * 16 + dir * 8 + hh; rli = gp[0]; rlf = logsigmoidf_(gp[4]); }
            }
        } else {
#pragma unroll
            for (int i = 0; i < 4; ++i) { rq[i] = *(const u32x4*)pq[i]; rk[i] = *(const u32x4*)pk[i]; pq[i] += tstep * qld; pk[i] += tstep * qld; }
            rv = *(const u32x4*)pv; pv += tstep * 4096;
            if (!RET) { rli = pg[0]; rlf = logsigmoidf_(pg[4]); pg += tstep * 16; }
        }
    };
    float bb, a_, cm;
    auto local_scan = [&]() {
        const float lf = RET ? lgam : rlf, li = RET ? 0.f : rli;
        bb = wave_prefix_sum(lf);
        a_ = li - bb; cm = a_;
        if (!RET) cm = wave_prefix_max(a_);
    };
    f32x4 Cacc[2][2];
#pragma unroll
    for (int a = 0; a < 2; ++a)
#pragma unroll
        for (int c = 0; c < 2; ++c) Cacc[a][c] = (f32x4){0.f, 0.f, 0.f, 0.f};
    float m_prev = 0.f, w_state = 0.f;
    f32x4 Cn[2] = {(f32x4){0.f, 0.f, 0.f, 0.f}, (f32x4){0.f, 0.f, 0.f, 0.f}};
    ConvTile cvt;
    load_chunk(0);
    local_scan();
    const int tq = (lane >> 2) & 3, tp = lane & 3;
    const unsigned trK = lbase + SC_KS + (8 * fq + tq) * 272 + (32 * w + 4 * tp) * 2;
    const unsigned trV = lbase + SC_VS + (8 * fq + tq) * 80 + (4 * tp) * 2;
    const int qrow = 16 * w + fr;
    float r_kw = 0.f, r_ws = 0.f, r_winter_q = 0.f, r_b63 = 0.f; f32x4 r_dm[4];
    if (RET) {
        r_b63 = lane_bcast(bb, 63);
        r_kw = __expf(r_b63 + a_); r_ws = __expf(r_b63);
        r_winter_q = __expf(lgam * (float)(qrow + 1));
#pragma unroll
        for (int nn = 0; nn < 4; ++nn)
#pragma unroll
            for (int jj = 0; jj < 4; ++jj) { const int key = 32 * (nn >> 1) + 8 * fq + 4 * (nn & 1) + jj; r_dm[nn][jj] = (key <= qrow) ? __expf(lgam * (float)(qrow - key)) : 0.f; }
    }
    for (int n = 0; n < 33; ++n) {
        float mm, b63, m_new, bm_, winter_, kw_, em_;
        if (RET) { mm = 0.f; b63 = r_b63; m_new = 0.f; bm_ = bb; winter_ = 0.f; em_ = 1.f; kw_ = (n == 0 && lane < 48) ? 0.f : r_kw; }
        else {
            mm = bb + fmaxf(m_prev, cm);
            b63 = lane_bcast(bb, 63); m_new = lane_bcast(mm, 63);
            bm_ = bb - mm; winter_ = __expf(bb + m_prev - mm); kw_ = (n == 0 && lane < 48) ? 0.f : __expf(b63 + a_ - m_new); em_ = __expf(-mm);
        }
        const int kpad = (n == 0) ? 48 : 0;
#pragma unroll
        for (int mt = 0; mt < 2; ++mt)
#pragma unroll
            for (int ne = 0; ne < 2; ++ne) {
                const f32x4 v = Cacc[mt][ne];
                u32x2 pk; pk.x = pk2(v[0], v[1]); pk.y = pk2(v[2], v[3]);
                *(u32x2*)(lds + SC_CT + (16 * ne + fr) * 272 + (32 * w + 16 * mt + 4 * fq) * 2) = pk;
            }
        if (!RET && fr == 0) {
#pragma unroll
            for (int mt = 0; mt < 2; ++mt) { u32x2 pk; pk.x = pk2(Cn[mt][0], Cn[mt][1]); pk.y = pk2(Cn[mt][2], Cn[mt][3]); *(u32x2*)(lds + SC_CT + 32 * 272 + (32 * w + 16 * mt + 4 * fq) * 2) = pk; }
        }
        w_state = RET ? r_ws : __expf(b63 + m_prev - m_new);
#pragma unroll
        for (int i = 0; i < 4; ++i) {
            const int row = lr + 16 * i;
            *(u32x4*)(lds + SC_QS + row * 272 + lc * 16) = rq[i];
            *(u32x4*)(lds + SC_KS + row * 272 + lc * 16) = rk[i];
        }
        {
            const float kwr = __shfl(kw_, vr & 63);
            *(u32x4*)(lds + SC_VS + vr * 80 + vc * 16) = rv;
            u32x4 sv;
            sv.x = pk2(bflo(rv.x) * kwr, bfhi(rv.x) * kwr); sv.y = pk2(bflo(rv.y) * kwr, bfhi(rv.y) * kwr);
            sv.z = pk2(bflo(rv.z) * kwr, bfhi(rv.z) * kwr); sv.w = pk2(bflo(rv.w) * kwr, bfhi(rv.w) * kwr);
            *(u32x4*)(lds + SC_VW + vr * 80 + vc * 16) = sv;
            if (!RET && vc == 0) *(unsigned*)(lds + SC_VW + vr * 80 + 64) = pk2(kwr, 0.f);
            if (!RET && w == 0) ((float*)(lds + SC_AK))[lane] = a_ * 1.4426950408889634f;
        }
        __syncthreads();
        if (n + 1 < 33) load_chunk(n + 1);
        float4 cv[4];
        deferred_load(p, conv_q0 + n * conv_stride, tid, cv, cvt);
        bf16x8 qf[4];
#pragma unroll
        for (int ks = 0; ks < 4; ++ks) qf[ks] = *(const bf16x8*)(lds + SC_QS + qrow * 272 + (32 * ks + 8 * fq) * 2);
        float bm_q = 0.f, winter_q = r_winter_q, em_q = 1.f;
        f32x4 dm[4];
        if (RET) {
#pragma unroll
            for (int nn = 0; nn < 4; ++nn) dm[nn] = r_dm[nn];
            if (n == 0) {
#pragma unroll
                for (int nn = 0; nn < 4; ++nn)
#pragma unroll
                    for (int jj = 0; jj < 4; ++jj) if (32 * (nn >> 1) + 8 * fq + 4 * (nn & 1) + jj < 48) dm[nn][jj] = 0.f;
            }
        } else {
            bm_q = __shfl(bm_, qrow); winter_q = __shfl(winter_, qrow); em_q = __shfl(em_, qrow);
            const float bm2 = bm_q * 1.4426950408889634f;
#pragma unroll
            for (int nn = 0; nn < 4; ++nn) {
                const int key0 = 32 * (nn >> 1) + 8 * fq + 4 * (nn & 1);
                const f32x4 ak = *(const f32x4*)(lds + SC_AK + key0 * 4);
#pragma unroll
                for (int jj = 0; jj < 4; ++jj) dm[nn][jj] = (key0 + jj <= qrow && key0 + jj >= kpad) ? __builtin_amdgcn_exp2f(bm2 + ak[jj]) : 0.f;
            }
        }
        f32x4 S[4];
#pragma unroll
        for (int nn = 0; nn < 4; ++nn) {
            const int krow = 32 * (nn >> 1) + 8 * (fr >> 2) + 4 * (nn & 1) + (fr & 3);
            f32x4 acc = (f32x4){0.f, 0.f, 0.f, 0.f};
#pragma unroll
            for (int ks = 0; ks < 4; ++ks) {
                const bf16x8 kf = *(const bf16x8*)(lds + SC_KS + krow * 272 + (32 * ks + 8 * fq) * 2);
                acc = __builtin_amdgcn_mfma_f32_16x16x32_bf16(kf, qf[ks], acc, 0, 0, 0);
            }
            S[nn] = acc;
        }
        float rsum = 0.f;
#pragma unroll
        for (int nn = 0; nn < 4; ++nn)
#pragma unroll
            for (int jj = 0; jj < 4; ++jj) { const float sv = S[nn][jj] * dm[nn][jj]; S[nn][jj] = sv; rsum += sv; }
        f32x4 O[2], OC[2];
#pragma unroll
        for (int ne = 0; ne < 2; ++ne) { O[ne] = (f32x4){0.f, 0.f, 0.f, 0.f}; OC[ne] = (f32x4){0.f, 0.f, 0.f, 0.f}; }
        {
            u32x2 v00a, v00b, v01a, v01b, v10a, v10b, v11a, v11b;
            tr_read8(trV, trV + 4 * 80, trV + 32, trV + 32 + 4 * 80, trV + 32 * 80, trV + 36 * 80, trV + 32 * 80 + 32, trV + 36 * 80 + 32,
                     v00a, v00b, v01a, v01b, v10a, v10b, v11a, v11b);
            u32x4 pw; bf16x8 pf;
            pw.x = pk2(S[0][0], S[0][1]); pw.y = pk2(S[0][2], S[0][3]); pw.z = pk2(S[1][0], S[1][1]); pw.w = pk2(S[1][2], S[1][3]); pf = __builtin_bit_cast(bf16x8, pw);
            O[0] = __builtin_amdgcn_mfma_f32_16x16x32_bf16(cat8(v00a, v00b), pf, O[0], 0, 0, 0);
            O[1] = __builtin_amdgcn_mfma_f32_16x16x32_bf16(cat8(v01a, v01b), pf, O[1], 0, 0, 0);
            pw.x = pk2(S[2][0], S[2][1]); pw.y = pk2(S[2][2], S[2][3]); pw.z = pk2(S[3][0], S[3][1]); pw.w = pk2(S[3][2], S[3][3]); pf = __builtin_bit_cast(bf16x8, pw);
            O[0] = __builtin_amdgcn_mfma_f32_16x16x32_bf16(cat8(v10a, v10b), pf, O[0], 0, 0, 0);
            O[1] = __builtin_amdgcn_mfma_f32_16x16x32_bf16(cat8(v11a, v11b), pf, O[1], 0, 0, 0);
        }
#pragma unroll
        for (int ks = 0; ks < 4; ++ks)
#pragma unroll
            for (int ne = 0; ne < 2; ++ne) {
                const bf16x8 cf = *(const bf16x8*)(lds + SC_CT + (16 * ne + fr) * 272 + (32 * ks + 8 * fq) * 2);
                OC[ne] = __builtin_amdgcn_mfma_f32_16x16x32_bf16(cf, qf[ks], OC[ne], 0, 0, 0);
            }
        float scC = winter_q, scS = 1.f;
        if (!RET) {
            f32x4 OCn = (f32x4){0.f, 0.f, 0.f, 0.f};
#pragma unroll
            for (int ks = 0; ks < 4; ++ks) {
                const bf16x8 cf = *(const bf16x8*)(lds + SC_CT + (32 + fr) * 272 + (32 * ks + 8 * fq) * 2);
                OCn = __builtin_amdgcn_mfma_f32_16x16x32_bf16(cf, qf[ks], OCn, 0, 0, 0);
            }
            const float qn = row_bcast_w(OCn[0], 0);
            rsum = rows_sum(rsum);
            const float den = winter_q * qn + rsum;
            const float rden = frcp(fmaxf(fabsf(den), em_q));
            scC = winter_q * rden; scS = rden;
        }
        {
            u32x2 pk[2];
#pragma unroll
            for (int ne = 0; ne < 2; ++ne) { const f32x4 o = OC[ne] * scC + O[ne] * scS; pk[ne].x = pk2(o[0], o[1]); pk[ne].y = pk2(o[2], o[3]); }
            const u32x4 wide = widen_pair(pk[0], pk[1]);
            const int t = tok_of(n, qrow);
            if (t >= 0) *(u32x4*)(p.osc() + ((size_t)dir * T_ + tokb + t) * 1024 + (RET ? 512 : 0) + hh * 128 + eq * 32 + 16 * (fq & 1) + 8 * (fq >> 1)) = wide;
        }
#pragma unroll
        for (int mt = 0; mt < 2; ++mt)
#pragma unroll
            for (int ne = 0; ne < 2; ++ne) Cacc[mt][ne] = Cacc[mt][ne] * w_state;
        if (!RET) { Cn[0] = Cn[0] * w_state; Cn[1] = Cn[1] * w_state; }
#pragma unroll
        for (int t = 0; t < 2; ++t) {
            u32x2 k0a, k0b, k1a, k1b, w0a, w0b, w1a, w1b;
            const unsigned ka = trK + 32 * t * 272, wa = trV + (SC_VW - SC_VS) + 32 * t * 80;
            tr_read8(ka, ka + 4 * 272, ka + 32, ka + 32 + 4 * 272, wa, wa + 4 * 80, wa + 32, wa + 32 + 4 * 80, k0a, k0b, k1a, k1b, w0a, w0b, w1a, w1b);
            const bf16x8 kf0 = cat8(k0a, k0b), kf1 = cat8(k1a, k1b), vf0 = cat8(w0a, w0b), vf1 = cat8(w1a, w1b);
            Cacc[0][0] = __builtin_amdgcn_mfma_f32_16x16x32_bf16(kf0, vf0, Cacc[0][0], 0, 0, 0);
            Cacc[0][1] = __builtin_amdgcn_mfma_f32_16x16x32_bf16(kf0, vf1, Cacc[0][1], 0, 0, 0);
            Cacc[1][0] = __builtin_amdgcn_mfma_f32_16x16x32_bf16(kf1, vf0, Cacc[1][0], 0, 0, 0);
            Cacc[1][1] = __builtin_amdgcn_mfma_f32_16x16x32_bf16(kf1, vf1, Cacc[1][1], 0, 0, 0);
            if (!RET) {
                u32x2 n0a, n0b;
                tr_read2(wa + 64, wa + 64 + 4 * 80, n0a, n0b);
                const bf16x8 vfn = cat8(n0a, n0b);
                Cn[0] = __builtin_amdgcn_mfma_f32_16x16x32_bf16(kf0, vfn, Cn[0], 0, 0, 0);
                Cn[1] = __builtin_amdgcn_mfma_f32_16x16x32_bf16(kf1, vfn, Cn[1], 0, 0, 0);
            }
        }
        m_prev = m_new;
        if (!RET && n + 1 < 33) local_scan();
        conv_lds((float*)(lds + SC_CONV), cv, tid);
        __syncthreads();
        conv_store((const float*)(lds + SC_CONV), cvt, tid);
    }
}
__device__ __forceinline__ void phase_scan(const P& p, int layer, unsigned char* lds, int bid, int nb) {
    for (int it = bid; it < 512; it += nb) {
        const int x = it & 7, y = it >> 3;
        const int ch = (y >> 2) * 8 + x, eq = y & 3;
        const int type = ch >> 6, b = (ch >> 3) & 7, hh = (ch >> 1) & 3, dir = ch & 1;
        const int q0 = (layer >> 1) * DEF_PER_SCAN + it;
        if (type == 0) scan_item<false>(p, layer, lds, b, hh, dir, eq, q0, 512);
        else scan_item<true>(p, layer, lds, b, hh, dir, eq, q0, 512);
    }
}

__device__ __forceinline__ void phase_mixfin(const P& p, int layer, int bid, int nb) {
    const int tid = opaque_tid(), lane = tid & 63, wid = tid >> 6, j = layer >> 1;
    float g[2][8];
    ld_f8(p.e_mg + j * 512 + 8 * lane, g[0]); ld_f8(p.e_rg + j * 512 + 8 * lane, g[1]);
    int tok = bid * 4 + wid;
    u32x4 an[2], cn_[2], gzn[2];
    auto ld = [&](int tk) {
#pragma unroll
        for (int i = 0; i < 2; ++i) {
            const int f = 512 * i + 8 * lane;
            const int gcol = (i == 0) ? (1536 + 8 * lane) : (3584 + 8 * lane);
            an[i] = ldnt_u4(p.osc() + (size_t)tk * 1024 + f);
            cn_[i] = ldnt_u4(p.osc() + ((size_t)T_ + tk) * 1024 + f);
            gzn[i] = ldnt_u4(p.ze() + (size_t)tk * 4096 + gcol);
        }
    };
    if (tok < T_) ld(tok);
#pragma unroll 1
    for (; tok < T_; tok += nb * 4) {
        u32x4 a[2], c[2], gz[2];
#pragma unroll
        for (int i = 0; i < 2; ++i) { a[i] = an[i]; c[i] = cn_[i]; gz[i] = gzn[i]; }
        if (tok + nb * 4 < T_) ld(tok + nb * 4);
#pragma unroll
        for (int i = 0; i < 2; ++i) {
            const float v[8] = {bflo(a[i].x) + bflo(c[i].x), bfhi(a[i].x) + bfhi(c[i].x), bflo(a[i].y) + bflo(c[i].y), bfhi(a[i].y) + bfhi(c[i].y),
                                bflo(a[i].z) + bflo(c[i].z), bfhi(a[i].z) + bfhi(c[i].z), bflo(a[i].w) + bflo(c[i].w), bfhi(a[i].w) + bfhi(c[i].w)};
            const float gzv[8] = {bflo(gz[i].x), bfhi(gz[i].x), bflo(gz[i].y), bfhi(gz[i].y), bflo(gz[i].z), bfhi(gz[i].z), bflo(gz[i].w), bfhi(gz[i].w)};
            float ss = 0.f;
#pragma unroll
            for (int c2 = 0; c2 < 8; ++c2) ss += v[c2] * v[c2];
            ss += __shfl_xor(ss, 8); ss += __shfl_xor(ss, 4); ss += __shfl_xor(ss, 2); ss += __shfl_xor(ss, 1);
            const float r = frsq(ss * (1.f / 128.f) + 1e-6f);
            float o8[8];
#pragma unroll
            for (int c2 = 0; c2 < 8; ++c2) {
                const float sg = frcp(1.f + __expf(-gzv[c2]));
                const float gate = (i == 0) ? sg : gzv[c2] * sg;
                o8[c2] = gate * (v[c2] * r * g[i][c2]);
            }
            st_bf8(p.mix() + (size_t)tok * 1024 + 512 * i + 8 * lane, o8);
        }
    }
}

__device__ __forceinline__ void phase_cn(const P& p, int nl, unsigned char* lds, int bid, int nb, bool dry = false) {
    const int tid = opaque_tid(), lane = tid & 63, wid = tid >> 6;
    const bool even = (nl & 1) == 0 && nl < 4;
    const float* g = p.attn_g + (nl < 4 ? nl : 0) * D_;
    if (even) {
        __syncthreads();
        stage_proj16(lds, p.e_win + (size_t)(nl >> 1) * D_ * EVEN_IN + 2048, EVEN_IN, g, tid);
        __syncthreads();
    }
    Row16 gg; ld_f8(g + 8 * lane, gg.v[0]); ld_f8(g + 512 + 8 * lane, gg.v[1]);
    const int eme = e_of_lane(lane);
    const float gbias = p.e_gb[(nl < 4 ? (nl >> 1) : 0) * 16 + eme];
    auto ld_row = [&](int tk, Row16& dst) {
        if (nl != 0) {
            const bf16_t* hr = p.h() + (size_t)tk * D_;
            const u32x4 r0 = ldnt_u4(hr + 8 * lane), r1 = ldnt_u4(hr + 512 + 8 * lane);
            dst.v[0][0] = bflo(r0.x); dst.v[0][1] = bfhi(r0.x); dst.v[0][2] = bflo(r0.y); dst.v[0][3] = bfhi(r0.y); dst.v[0][4] = bflo(r0.z); dst.v[0][5] = bfhi(r0.z); dst.v[0][6] = bflo(r0.w); dst.v[0][7] = bfhi(r0.w);
            dst.v[1][0] = bflo(r1.x); dst.v[1][1] = bfhi(r1.x); dst.v[1][2] = bflo(r1.y); dst.v[1][3] = bfhi(r1.y); dst.v[1][4] = bflo(r1.z); dst.v[1][5] = bfhi(r1.z); dst.v[1][6] = bflo(r1.w); dst.v[1][7] = bfhi(r1.w);
        }
        else {
            const int b2 = tk / L_, t2 = tk - b2 * L_;
            const float* src = t2 < NM ? p.meta + (size_t)t2 * D_ : p.x + ((size_t)b2 * 2048 + (t2 - NM)) * D_;
#pragma unroll
            for (int i = 0; i < 2; ++i) {
                const float4 a = ldnt_f4(src + 512 * i + 8 * lane), b4 = ldnt_f4(src + 512 * i + 8 * lane + 4);
                dst.v[i][0] = a.x; dst.v[i][1] = a.y; dst.v[i][2] = a.z; dst.v[i][3] = a.w; dst.v[i][4] = b4.x; dst.v[i][5] = b4.y; dst.v[i][6] = b4.z; dst.v[i][7] = b4.w;
            }
        }
    };
    int tok = bid * 4 + wid;
    Row16 hn; int seln = -1;
    if (tok < T_) {
        ld_row(tok, hn);
        if (nl != 0) seln = p.sel()[(size_t)tok * 16 + (lane & 15)];
    }
#pragma unroll 1
    for (; tok < T_; tok += nb * 4) {
        const int b = tok / L_, t = tok - b * L_;
        Row16 hv = hn;
        const int sel_l = seln;
        {
            const int tn = tok + nb * 4;
            if (tn < T_) {
                ld_row(tn, hn);
                if (nl != 0) seln = p.sel()[(size_t)tn * 16 + (lane & 15)];
            }
        }
        if (nl != 0) {
            unsigned long long msk = __ballot(sel_l >= 0 && lane < 16);
            while (msk) {
                const int e0 = __builtin_ctzll(msk); msk &= msk - 1;
                int e1 = -1; if (msk) { e1 = __builtin_ctzll(msk); msk &= msk - 1; }
                const int s0 = __shfl(sel_l, e0), s1 = __shfl(sel_l, e1 < 0 ? e0 : e1);
                const bf16_t* y0 = p.ys() + ((size_t)(e0 * B_ + b) * CAP + s0) * D_;
                const bf16_t* y1 = p.ys() + ((size_t)((e1 < 0 ? e0 : e1) * B_ + b) * CAP + s1) * D_;
                Row16 a0, a1;
                {
                    const u32x4 r00 = ldnt_u4(y0 + 8 * lane), r01 = ldnt_u4(y0 + 512 + 8 * lane), r10 = ldnt_u4(y1 + 8 * lane), r11 = ldnt_u4(y1 + 512 + 8 * lane);
                    const u32x4 rr[2][2] = {{r00, r01}, {r10, r11}};
#pragma unroll
                    for (int i = 0; i < 2; ++i) {
                        a0.v[i][0] = bflo(rr[0][i].x); a0.v[i][1] = bfhi(rr[0][i].x); a0.v[i][2] = bflo(rr[0][i].y); a0.v[i][3] = bfhi(rr[0][i].y);
                        a0.v[i][4] = bflo(rr[0][i].z); a0.v[i][5] = bfhi(rr[0][i].z); a0.v[i][6] = bflo(rr[0][i].w); a0.v[i][7] = bfhi(rr[0][i].w);
                        a1.v[i][0] = bflo(rr[1][i].x); a1.v[i][1] = bfhi(rr[1][i].x); a1.v[i][2] = bflo(rr[1][i].y); a1.v[i][3] = bfhi(rr[1][i].y);
                        a1.v[i][4] = bflo(rr[1][i].z); a1.v[i][5] = bfhi(rr[1][i].z); a1.v[i][6] = bflo(rr[1][i].w); a1.v[i][7] = bfhi(rr[1][i].w);
                    }
                }
                const float w1 = e1 < 0 ? 0.f : 1.f;
#pragma unroll
                for (int i = 0; i < 2; ++i)
#pragma unroll
                    for (int c = 0; c < 8; ++c) hv.v[i][c] += a0.v[i][c] + w1 * a1.v[i][c];
            }
        }
        if (nl == 4) {
            if (t >= NM) {
                float* op = p.out + ((size_t)b * 2048 + (t - NM)) * D_;
#pragma unroll
                for (int i = 0; i < 2; ++i) {
                    stnt_f4(op + 512 * i + 8 * lane, hv.v[i][0], hv.v[i][1], hv.v[i][2], hv.v[i][3]);
                    stnt_f4(op + 512 * i + 8 * lane + 4, hv.v[i][4], hv.v[i][5], hv.v[i][6], hv.v[i][7]);
                }
            }
            continue;
        }
        if (!dry) {
#pragma unroll
            for (int i = 0; i < 2; ++i) st_bf8(p.h() + (size_t)tok * D_ + 512 * i + 8 * lane, hv.v[i]);
        }
        const float r = frsq(wave_sum(row_sumsq(hv)) * (1.f / D_) + 1e-6f);
#pragma unroll
        for (int i = 0; i < 2; ++i) {
            float uu[8];
#pragma unroll
            for (int c = 0; c < 8; ++c) uu[c] = hv.v[i][c] * r * gg.v[i][c];
            st_bf8(p.u() + (size_t)tok * D_ + 512 * i + 8 * lane, uu);
        }
        if (even) {
            float acc[16];
            proj16_accum(lds, hv, lane, acc);
            const float gv = reduce_scatter16(acc, lane) * r + gbias;
            if ((lane & 3) == 0) p.gts()[(size_t)tok * 16 + eme] = gv;
        }
    }
}

#define XB_TMO      128
#define XB_XCNT(j)  (256  + 64 * (j))
#define XB_XSUB(j)  (1280 + 64 * (j))
#define XB_XGEN(j)  (2304 + 64 * (j))
#define XB_TOP      3328
#define XB_TOPGEN   3392
#define XB_SPIN_CAP (1u << 22)
#define LAS __attribute__((address_space(3)))
__device__ __forceinline__ unsigned xb_ld(unsigned* p)              { return __hip_atomic_load(p, __ATOMIC_RELAXED, __HIP_MEMORY_SCOPE_AGENT); }
__device__ __forceinline__ unsigned xb_add(unsigned* p, unsigned v) { return __hip_atomic_fetch_add(p, v, __ATOMIC_RELAXED, __HIP_MEMORY_SCOPE_AGENT); }
__device__ __forceinline__ unsigned xb_xcc_id() { return (unsigned)__builtin_amdgcn_s_getreg((3 << 11) | 20) & 0xFu; }
#define XB_SPIN(cond, bar) do { unsigned _sp = 0; while (cond) { __builtin_amdgcn_s_sleep(1); \
    if ((++_sp & 255u) == 0u) { if (xb_ld(&(bar)[XB_TMO])) break; if (_sp > XB_SPIN_CAP) { atomicAdd(&(bar)[XB_TMO], 1u); break; } } } } while (0)
struct XcdBarrier { unsigned* bar; unsigned x; unsigned nloc, nx, epoch; };
__device__ __forceinline__ XcdBarrier xcd_barrier_post(unsigned* bar) {
    XcdBarrier b; b.bar = bar; b.x = xb_xcc_id(); b.nloc = 0u; b.nx = 0u; b.epoch = 0u;
    if (threadIdx.x == 0) (void)xb_add(&bar[XB_XCNT(b.x)], 1u);
    return b;
}
__device__ __forceinline__ void xcd_barrier_complete(unsigned* bar, unsigned x, unsigned& nloc, unsigned& nx) {
    const unsigned G = gridDim.x * gridDim.y * gridDim.z;
    unsigned sum, cnt, mine, sp = 0u;
    for (;;) {
        sum = 0u; cnt = 0u; mine = 0u;
#pragma unroll
        for (unsigned j = 0; j < 16; ++j) { const unsigned c = xb_ld(&bar[XB_XCNT(j)]); sum += c; cnt += (c > 0u) ? 1u : 0u; mine = (j == x) ? c : mine; }
        if (sum == G) break;
        __builtin_amdgcn_s_sleep(1);
        if ((++sp & 255u) == 0u) { if (xb_ld(&bar[XB_TMO])) break; if (sp > XB_SPIN_CAP) { atomicAdd(&bar[XB_TMO], 1u); break; } }
    }
    nloc = mine > 0u ? mine : 1u; nx = cnt > 0u ? cnt : 1u;
}
__device__ __forceinline__ void xcd_barrier(XcdBarrier& b) {
    asm volatile("s_waitcnt vmcnt(0)" ::: "memory");
    __syncthreads();
    if (threadIdx.x == 0) {
        unsigned* bar = b.bar; unsigned bx = b.x;
        asm volatile("" : "+s"(bar), "+s"(bx));
        __builtin_amdgcn_s_waitcnt(0);
        const unsigned nloc = b.nloc, nx = b.nx;
        const unsigned old = xb_add(&bar[XB_XSUB(bx)], 1u);
        const unsigned gen = b.epoch;
        if (old + 1u == (gen + 1u) * nloc) {
            __builtin_amdgcn_fence(__ATOMIC_RELEASE, "agent");
            asm volatile("s_waitcnt vmcnt(0)" ::: "memory");
            const unsigned og = xb_add(&bar[XB_TOP], 1u);
            const unsigned tg = b.epoch;
            if (og + 1u == (tg + 1u) * nx) xb_add(&bar[XB_TOPGEN], 1u);
            else XB_SPIN(xb_ld(&bar[XB_TOPGEN]) == tg, bar);
            __builtin_amdgcn_fence(__ATOMIC_ACQUIRE, "agent");
            asm volatile("s_waitcnt vmcnt(0)" ::: "memory");
            xb_add(&bar[XB_XGEN(bx)], 1u);
            asm volatile("s_waitcnt vmcnt(0)" ::: "memory");
        } else {
            XB_SPIN(xb_ld(&bar[XB_XGEN(bx)]) == gen, bar);
            asm volatile("s_waitcnt vmcnt(0) lgkmcnt(0)\n\tbuffer_inv sc0\n\ts_waitcnt vmcnt(0)" ::: "memory");
        }
    }
    b.epoch += 1u;
    __syncthreads();
}

typedef const __attribute__((address_space(4))) unsigned long long* KArg;
__device__ __forceinline__ P load_args(KArg k) {
    asm volatile("" : "+s"(k));
    P p;
#define GP(T, i) ((T*)(__attribute__((address_space(1))) T*)k[i])
    p.x = GP(const float, 0); p.meta = GP(const float, 1); p.attn_g = GP(const float, 2); p.ffn_g = GP(const float, 3); p.e_win = GP(const float, 4);
    p.e_conv = GP(const float, 5); p.e_gb = GP(const float, 6); p.e_mg = GP(const float, 7); p.e_decay = GP(const float, 8); p.e_rg = GP(const float, 9);
    p.e_wout = GP(const float, 10); p.o_win = GP(const float, 11); p.o_qg = GP(const float, 12); p.o_kg = GP(const float, 13); p.o_rpb = GP(const float, 14);
    p.o_wout = GP(const float, 15); p.router_w = GP(const float, 16); p.w_gate = GP(const float, 17); p.w_up = GP(const float, 18); p.w_down = GP(const float, 19);
    p.out = GP(float, 20); p.ws = GP(unsigned char, 21);
#undef GP
    return p;
}
#define PH(call) { const P p = load_args(kp); int bid = bid_, nb = nb_; asm volatile("" : "+s"(bid), "+s"(nb)); call; }
__global__ void __launch_bounds__(NTHR, 2) k_mega(P p_unused) {
    extern __shared__ __attribute__((aligned(16))) unsigned char lds_raw[];
    unsigned char* lds = lds_raw;
    const KArg kp = (KArg)__builtin_amdgcn_kernarg_segment_ptr();
    const int bid_ = blockIdx.x, nb_ = gridDim.x;
    XcdBarrier xb;
    { const P p = load_args(kp); xb = xcd_barrier_post(p.bar()); }
#define GB() xcd_barrier(xb)
    PH(phase_tables(p, bid, nb));
    PH(router_frags(p, bid, nb));
    PH(phase_convert(p, lds, bid, nb));
    PH(phase_cn(p, 0, lds, bid, nb));
    __syncthreads();
    if (threadIdx.x == 0) { unsigned nloc, nx; xcd_barrier_complete(xb.bar, xb.x, nloc, nx); ((volatile unsigned*)lds)[0] = nloc; ((volatile unsigned*)lds)[1] = nx; }
    __syncthreads();
    xb.nloc = (unsigned)__builtin_amdgcn_readfirstlane((int)((volatile unsigned*)lds)[0]);
    xb.nx = (unsigned)__builtin_amdgcn_readfirstlane((int)((volatile unsigned*)lds)[1]);
    __syncthreads();
    GB();
#if PROBE_BARRIER
    for (int i = 0; i < 100; ++i) GB();
#endif
#pragma nounroll
    for (int layer = 0; layer < 4; ++layer) {
        if ((layer & 1) == 0) {
            PH(phase_even_in(p, layer, lds, bid, nb)); GB();
            PH(phase_conv(p, layer, bid, nb)); GB();
#if PROBE_CONV
            PH(phase_conv(p, layer, bid, nb)); GB();
#endif
            PH(phase_scan(p, layer, lds, bid, nb)); GB();
#if PROBE_SCAN
            PH(phase_scan(p, layer, lds, bid, nb)); GB();
#endif
            PH(phase_mixfin(p, layer, bid, nb)); GB();
#if PROBE_MIXFIN
            PH(phase_mixfin(p, layer, bid, nb)); GB();
#endif
            PH(phase_outproj(p, p.WoutE() + (size_t)(layer >> 1) * 1024 * 1024, lds, bid, nb)); GB();
        } else {
            PH(phase_odd_in(p, layer, lds, bid, nb)); GB();
            PH(phase_natten(p, layer, lds, bid, nb)); GB();
            PH(phase_outproj(p, p.WoutO() + (size_t)(layer >> 1) * 1024 * 1024, lds, bid, nb)); GB();
        }
        PH(phase_router(p, layer, lds, bid, nb)); GB();
        PH(phase_topk(p, layer, lds, bid, nb)); GB();
        PH(phase_gateup(p, layer, lds, bid, nb)); GB();
        PH(phase_down(p, layer, lds, bid, nb)); GB();
#if PROBE_CN
        PH(phase_cn(p, layer + 1, lds, bid, nb, true)); GB();
#endif
        PH(phase_cn(p, layer + 1, lds, bid, nb));
        if (layer < 3) GB();
    }
}

static inline size_t al256(size_t x) { return (x + 255) & ~(size_t)255; }

extern "C" void kernel_launch(void* const* d_in, const int* in_sizes, int n_in, void* d_out, int out_size, void* d_ws, size_t ws_size, hipStream_t stream) {
    P p; memset(&p, 0, sizeof(p));
    p.x = (const float*)d_in[0]; p.meta = (const float*)d_in[1]; p.attn_g = (const float*)d_in[2]; p.ffn_g = (const float*)d_in[3];
    p.e_win = (const float*)d_in[4]; p.e_conv = (const float*)d_in[5]; p.e_gb = (const float*)d_in[6]; p.e_mg = (const float*)d_in[7];
    p.e_decay = (const float*)d_in[8]; p.e_rg = (const float*)d_in[9]; p.e_wout = (const float*)d_in[10]; p.o_win = (const float*)d_in[11];
    p.o_qg = (const float*)d_in[12]; p.o_kg = (const float*)d_in[13]; p.o_rpb = (const float*)d_in[14]; p.o_wout = (const float*)d_in[15];
    p.router_w = (const float*)d_in[16]; p.w_gate = (const float*)d_in[17]; p.w_up = (const float*)d_in[18]; p.w_down = (const float*)d_in[19];
    p.out = (float*)d_out;

    p.ws = (unsigned char*)d_ws;
    if (WS_NEEDED > ws_size) return;

    static int grid_blocks = 0;
    if (!grid_blocks) {
        int dev = 0, cus = 0, per_cu = 0;
        if (hipGetDevice(&dev) != hipSuccess) return;
        if (hipDeviceGetAttribute(&cus, hipDeviceAttributeMultiprocessorCount, dev) != hipSuccess) return;
        if (hipFuncSetAttribute((const void*)k_mega, hipFuncAttributeMaxDynamicSharedMemorySize, LDS_BYTES) != hipSuccess) return;
        if (hipOccupancyMaxActiveBlocksPerMultiprocessor(&per_cu, (const void*)k_mega, NTHR, LDS_BYTES) != hipSuccess || per_cu < 1) return;
        if (per_cu > 2) per_cu = 2;
        cus &= ~7;
        if (cus < 8) return;
        grid_blocks = cus * per_cu;
    }
    (void)hipMemsetAsync(p.ws + OFF_BAR, 0, 16384, stream);
    hipLaunchKernelGGL(k_mega, dim3(grid_blocks), dim3(NTHR), LDS_BYTES, stream, p);
}
```
